# Optimizing an MI355X kernel written in HIP

```python
import math
import jax, jax.numpy as jnp
from jax import lax
import numpy as np

D_MODEL = 4096
BATCH = 2
SEQ = 8192
DEPTH = 2
DEC_BATCH = 4
DEC_SEQ = 2048
PAST_LEN = 128

HEAD_DIM = 128
GRID_W = 64
NA_HEADS = D_MODEL // 2 // HEAD_DIM
NA_WIDTH = NA_HEADS * HEAD_DIM
NA_ROWS = 8
NA_COLS = 16
FNET_GROUPS = 4
FNET_GROUP_DIM = D_MODEL // 2 // FNET_GROUPS
FNET_WIDTH = FNET_GROUPS * FNET_GROUP_DIM
EVEN_IN = 3 * NA_WIDTH + FNET_WIDTH
DIFF_HEADS = D_MODEL // (2 * HEAD_DIM)
DIFF_WIDTH = DIFF_HEADS * 2 * HEAD_DIM
ODD_IN = 3 * DIFF_WIDTH
Q_BLOCK = 128
T5_BUCKETS = 32
T5_MAX_DIST = 128
FFN_HIDDEN = ((8 * D_MODEL + 3 * 256 - 1) // (3 * 256)) * 256
N_EVEN = (DEPTH + 1) // 2
N_ODD = DEPTH // 2
RMS_EPS = 1e-6
SUBLN_EPS = 1e-5

kernel_name = 'hybrid_natten_fnet_diffattn_encoder'


def rmsnorm(x, g, eps=RMS_EPS):
    xf = x.astype(jnp.float32)
    y = xf * lax.rsqrt(jnp.mean(xf * xf, axis=-1, keepdims=True) + eps)
    return (y * g.astype(jnp.float32)).astype(x.dtype)


def lambda_init_fn(layer):
    return 0.8 - 0.6 * math.exp(-0.3 * layer)


def t5_bucket(rel):
    nb = T5_BUCKETS // 2
    max_exact = nb // 2
    ret = (rel > 0).astype(jnp.int32) * nb
    n = jnp.abs(rel)
    nf = jnp.maximum(n, 1).astype(jnp.float32)
    large = max_exact + (jnp.log(nf / max_exact) / math.log(T5_MAX_DIST / max_exact)
                         * (nb - max_exact)).astype(jnp.int32)
    large = jnp.minimum(large, nb - 1)
    return ret + jnp.where(n < max_exact, n, large)


def neighbourhood_attention(q, k, v, rpb):
    B, S, H, d = q.shape
    rows = S // GRID_W
    kh = min(NA_ROWS, rows)
    kw = NA_COLS
    qg = q.reshape(B, rows, GRID_W, H, d).transpose(1, 0, 2, 3, 4)
    kg = k.reshape(B, rows, GRID_W, H, d)
    vg = v.reshape(B, rows, GRID_W, H, d)
    row_ids = jnp.arange(rows, dtype=jnp.int32)
    row_start = jnp.clip(row_ids - kh // 2, 0, rows - kh)
    col_ids = jnp.arange(GRID_W, dtype=jnp.int32)
    col_start = jnp.clip(col_ids - kw // 2, 0, GRID_W - kw)
    col_idx = col_start[:, None] + jnp.arange(kw, dtype=jnp.int32)[None, :]
    col_bias_idx = col_idx - col_ids[:, None] + (NA_COLS - 1)
    scale = HEAD_DIM ** -0.5

    def row_block(args):
        q_row, r, rs = args
        k_rows = lax.dynamic_slice_in_dim(kg, rs, kh, axis=1)
        v_rows = lax.dynamic_slice_in_dim(vg, rs, kh, axis=1)
        k_win = k_rows[:, :, col_idx]
        v_win = v_rows[:, :, col_idx]
        s = jnp.einsum('bchd,bicjhd->bhcij', q_row, k_win,
                       preferred_element_type=jnp.float32) * scale
        dr = rs + jnp.arange(kh, dtype=jnp.int32) - r + (NA_ROWS - 1)
        bias = rpb[:, dr][:, :, col_bias_idx]
        s = s + jnp.transpose(bias, (0, 2, 1, 3)).astype(jnp.float32)[None]
        p = jax.nn.softmax(s.reshape(B, H, GRID_W, kh * kw), axis=-1)
        p = p.reshape(B, H, GRID_W, kh, kw).astype(v.dtype)
        return jnp.einsum('bhcij,bicjhe->bche', p, v_win)

    out = lax.map(row_block, (qg, row_ids, row_start))
    return out.transpose(1, 0, 2, 3, 4).reshape(B, S, H, d)


def fourier_mix(u):
    B, S, _ = u.shape
    ug = u.reshape(B, S, FNET_GROUPS, FNET_GROUP_DIM).astype(jnp.float32)
    f = jnp.fft.fft2(ug, axes=(1, 3), norm='ortho')
    return jnp.real(f).astype(u.dtype).reshape(B, S, FNET_WIDTH)


def differential_attention(q1, q2, k1, k2, v, t5_bias, lam):
    B, S, H, d = q1.shape
    nblk = S // Q_BLOCK
    qb1 = q1.reshape(B, nblk, Q_BLOCK, H, d).transpose(1, 0, 2, 3, 4)
    qb2 = q2.reshape(B, nblk, Q_BLOCK, H, d).transpose(1, 0, 2, 3, 4)
    starts = jnp.arange(nblk, dtype=jnp.int32) * Q_BLOCK
    kpos = jnp.arange(S, dtype=jnp.int32)
    scale = HEAD_DIM ** -0.5

    def block(args):
        qa, qb, start = args
        qpos = start + jnp.arange(Q_BLOCK, dtype=jnp.int32)
        bias = t5_bias[t5_bucket(kpos[None, :] - qpos[:, None])]
        bias = jnp.transpose(bias, (2, 0, 1)).astype(jnp.float32)[None]
        s1 = jnp.einsum('bqhd,bkhd->bhqk', qa, k1, preferred_element_type=jnp.float32) * scale + bias
        s2 = jnp.einsum('bqhd,bkhd->bhqk', qb, k2, preferred_element_type=jnp.float32) * scale + bias
        p = jax.nn.softmax(s1, axis=-1) - lam * jax.nn.softmax(s2, axis=-1)
        return jnp.einsum('bhqk,bkhe->bqhe', p.astype(v.dtype), v)

    out = lax.map(block, (qb1, qb2, starts))
    return out.transpose(1, 0, 2, 3, 4).reshape(B, S, H, 2 * d)


def trunk(x, norm_mix, norm_ffn, w_in_even, rpb_na, w_out_even, w_in_odd,
          lambda_q1, lambda_k1, lambda_q2, lambda_k2, subln_w, w_out_odd, t5_bias,
          w_gate, w_up, w_down, norm_final):
    B, S, _ = x.shape
    for layer in range(DEPTH):
        h = rmsnorm(x, norm_mix[layer])
        if layer % 2 == 0:
            e = layer // 2
            proj = h @ w_in_even[e]
            qa = proj[..., :NA_WIDTH].reshape(B, S, NA_HEADS, HEAD_DIM)
            ka = proj[..., NA_WIDTH:2 * NA_WIDTH].reshape(B, S, NA_HEADS, HEAD_DIM)
            va = proj[..., 2 * NA_WIDTH:3 * NA_WIDTH].reshape(B, S, NA_HEADS, HEAD_DIM)
            ub = proj[..., 3 * NA_WIDTH:]
            oa = neighbourhood_attention(qa, ka, va, rpb_na[e]).reshape(B, S, NA_WIDTH)
            ob = fourier_mix(ub)
            x = x + jnp.concatenate([oa, ob], axis=-1) @ w_out_even[e]
        else:
            o = layer // 2
            proj = h @ w_in_odd[o]
            q = proj[..., :DIFF_WIDTH].reshape(B, S, DIFF_HEADS, 2, HEAD_DIM)
            k = proj[..., DIFF_WIDTH:2 * DIFF_WIDTH].reshape(B, S, DIFF_HEADS, 2, HEAD_DIM)
            v = proj[..., 2 * DIFF_WIDTH:].reshape(B, S, DIFF_HEADS, 2 * HEAD_DIM)
            lam_init = lambda_init_fn(layer)
            lam = (jnp.exp(jnp.sum(lambda_q1[o].astype(jnp.float32) * lambda_k1[o].astype(jnp.float32)))
                   - jnp.exp(jnp.sum(lambda_q2[o].astype(jnp.float32) * lambda_k2[o].astype(jnp.float32)))
                   + lam_init)
            att = differential_attention(q[..., 0, :], q[..., 1, :], k[..., 0, :], k[..., 1, :],
                                         v, t5_bias, lam)
            att = rmsnorm(att, subln_w[o], eps=SUBLN_EPS) * (1.0 - lam_init)
            x = x + att.reshape(B, S, DIFF_WIDTH) @ w_out_odd[o]
        h = rmsnorm(x, norm_ffn[layer])
        x = x + (jax.nn.silu(h @ w_gate[layer]) * (h @ w_up[layer])) @ w_down[layer]
    return rmsnorm(x, norm_final)


def setup_inputs(seed: int = 0) -> dict:
    key = jax.random.key(seed)
    ks = jax.random.split(key, 20)
    f32 = jnp.float32

    def nrm(k, shape, scale):
        return jax.random.normal(k, shape, f32) * scale

    return {
        'x_prompt': nrm(ks[0], (BATCH, SEQ, D_MODEL), 1.0),
        'x_sample': nrm(ks[1], (DEC_BATCH, DEC_SEQ, D_MODEL), 1.0),
        'norm_mix': 1.0 + nrm(ks[2], (DEPTH, D_MODEL), 0.01),
        'norm_ffn': 1.0 + nrm(ks[3], (DEPTH, D_MODEL), 0.01),
        'w_in_even': nrm(ks[4], (N_EVEN, D_MODEL, EVEN_IN), D_MODEL ** -0.5),
        'rpb_na': nrm(ks[5], (N_EVEN, NA_HEADS, 2 * NA_ROWS - 1, 2 * NA_COLS - 1), 0.1),
        'w_out_even': nrm(ks[6], (N_EVEN, NA_WIDTH + FNET_WIDTH, D_MODEL), (NA_WIDTH + FNET_WIDTH) ** -0.5),
        'w_in_odd': nrm(ks[7], (N_ODD, D_MODEL, ODD_IN), D_MODEL ** -0.5),
        'lambda_q1': nrm(ks[8], (N_ODD, HEAD_DIM), 0.1),
        'lambda_k1': nrm(ks[9], (N_ODD, HEAD_DIM), 0.1),
        'lambda_q2': nrm(ks[10], (N_ODD, HEAD_DIM), 0.1),
        'lambda_k2': nrm(ks[11], (N_ODD, HEAD_DIM), 0.1),
        'subln_w': 1.0 + nrm(ks[12], (N_ODD, 2 * HEAD_DIM), 0.01),
        'w_out_odd': nrm(ks[13], (N_ODD, DIFF_WIDTH, D_MODEL), DIFF_WIDTH ** -0.5),
        't5_bias': nrm(ks[14], (T5_BUCKETS, DIFF_HEADS), 0.1),
        'w_gate': nrm(ks[15], (DEPTH, D_MODEL, FFN_HIDDEN), D_MODEL ** -0.5),
        'w_up': nrm(ks[16], (DEPTH, D_MODEL, FFN_HIDDEN), D_MODEL ** -0.5),
        'w_down': nrm(ks[17], (DEPTH, FFN_HIDDEN, D_MODEL), FFN_HIDDEN ** -0.5),
        'norm_final': 1.0 + nrm(ks[18], (D_MODEL,), 0.01),
    }


def reference(x_prompt, x_sample, norm_mix, norm_ffn, w_in_even, rpb_na, w_out_even, w_in_odd,
              lambda_q1, lambda_k1, lambda_q2, lambda_k2, subln_w, w_out_odd, t5_bias,
              w_gate, w_up, w_down, norm_final):
    y_prompt = trunk(x_prompt, norm_mix, norm_ffn, w_in_even, rpb_na, w_out_even, w_in_odd,
                     lambda_q1, lambda_k1, lambda_q2, lambda_k2, subln_w, w_out_odd, t5_bias,
                     w_gate, w_up, w_down, norm_final)
    y_sample = trunk(x_sample, norm_mix, norm_ffn, w_in_even, rpb_na, w_out_even, w_in_odd,
                     lambda_q1, lambda_k1, lambda_q2, lambda_k2, subln_w, w_out_odd, t5_bias,
                     w_gate, w_up, w_down, norm_final)
    return (y_prompt, y_sample)
```

```cpp
#include <hip/hip_runtime.h>
#include <cstdio>
#include <cstdint>

#define GAS __attribute__((address_space(1)))
#define LAS __attribute__((address_space(3)))
typedef unsigned short bf16;
typedef short bf16x8 __attribute__((ext_vector_type(8)));
typedef short s16x4 __attribute__((ext_vector_type(4)));
typedef float f32x4 __attribute__((ext_vector_type(4)));
typedef float f32x16 __attribute__((ext_vector_type(16)));
typedef unsigned u32x4 __attribute__((ext_vector_type(4)));
typedef unsigned u32x2 __attribute__((ext_vector_type(2)));

constexpr int DM = 4096, NTOK = 24576, NTOK_P = 16384, FF = 11008;
constexpr int EVEN_IN = 8192, ODD_IN = 12288;
constexpr float RMS_EPS = 1e-6f, SUBLN_EPS = 1e-5f;
constexpr float LOG2E = 1.4426950408889634f;
constexpr float ATT_C = 0.088388347648318440f * LOG2E;
constexpr float LAM_INIT = 0.35550906759f;

constexpr size_t MiB = 1u << 20;
constexpr size_t WS_CTL = 0, CTL_ZERO_BYTES = 1 * MiB;
constexpr size_t WS_WIE = 2 * MiB, WS_WOE = 66 * MiB, WS_WIO = 98 * MiB, WS_WOO = 194 * MiB;
constexpr size_t WS_WGU0 = 226 * MiB, WS_WGU1 = 398 * MiB, WS_WD0 = 570 * MiB, WS_WD1 = 656 * MiB;
constexpr size_t WS_XB = 742 * MiB, WS_MIX = 934 * MiB, WS_PROJ = 1126 * MiB, WS_VT = WS_PROJ + 384 * MiB, WS_END = 1702 * MiB;
constexpr size_t DO_A8 = 0, DO_A2 = 256 * MiB, DO_FC = 272 * MiB;
constexpr int CW_BAR = 4096;
constexpr int CW_LAM = 64;
constexpr size_t CTL_SSQ = 65536;
static_assert(CTL_SSQ + 5 * (size_t)NTOK * 4 <= CTL_ZERO_BYTES, "ctl");

constexpr int RING_BYTES = 131072;
constexpr int EX_OFF = RING_BYTES, EX_MISC = EX_OFF, EX_WS = EX_OFF + 256, EX_TAB = EX_OFF + 2304;
constexpr int LDS_BYTES = 147456;

#define LDS_WAIT() asm volatile("s_waitcnt lgkmcnt(0)" ::: "memory")
#define VM_WAIT() asm volatile("s_waitcnt vmcnt(0)" ::: "memory")
#define SBAR() __builtin_amdgcn_sched_barrier(0)

__device__ __forceinline__ unsigned cvt_pk_bf16(float lo, float hi) { unsigned r; asm volatile("v_cvt_pk_bf16_f32 %0, %1, %2" : "=v"(r) : "v"(lo), "v"(hi)); return r; }

#define XB_TMO      128
#define XB_XCNT(j)  (256  + 64 * (j))
#define XB_XSUB(j)  (1280 + 64 * (j))
#define XB_XGEN(j)  (2304 + 64 * (j))
#define XB_TOP      3328
#define XB_TOPGEN   3392
#define XCD_BAR_WORDS 3456
#define XB_SPIN_CAP (1u << 20)
__device__ __forceinline__ unsigned xb_ld(unsigned* p)              { return __hip_atomic_load(p, __ATOMIC_RELAXED, __HIP_MEMORY_SCOPE_AGENT); }
__device__ __forceinline__ unsigned xb_add(unsigned* p, unsigned v) { return __hip_atomic_fetch_add(p, v, __ATOMIC_RELAXED, __HIP_MEMORY_SCOPE_AGENT); }
__device__ __forceinline__ unsigned xb_xcc_id() { return (unsigned)__builtin_amdgcn_s_getreg((3 << 11) | 20) & 0xFu; }
#define XB_SPIN(cond, bar) do { unsigned _sp = 0; while (cond) { __builtin_amdgcn_s_sleep(1); \
    if ((++_sp & 255u) == 0u) { if (xb_ld(&(bar)[XB_TMO])) break; if (_sp > XB_SPIN_CAP) { atomicAdd(&(bar)[XB_TMO], 1u); break; } } } } while (0)
struct XcdBarrier { unsigned* bar; unsigned x; volatile LAS unsigned* st; };
__device__ __forceinline__ XcdBarrier xcd_barrier_post(unsigned* bar, volatile LAS unsigned* st) {
    XcdBarrier b; b.bar = bar; b.x = xb_xcc_id(); b.st = st;
    if (threadIdx.x == 0) (void)xb_add(&bar[XB_XCNT(b.x)], 1u);
    return b;
}
__device__ __forceinline__ void xcd_barrier_complete(unsigned* bar, unsigned x, unsigned& nloc, unsigned& nx) {
    const unsigned G = gridDim.x * gridDim.y * gridDim.z;
    unsigned sum, cnt, mine, sp = 0u;
    for (;;) {
        sum = 0u; cnt = 0u; mine = 0u;
#pragma unroll
        for (unsigned j = 0; j < 16; ++j) { const unsigned c = xb_ld(&bar[XB_XCNT(j)]); sum += c; cnt += (c > 0u) ? 1u : 0u; mine = (j == x) ? c : mine; }
        if (sum == G) break;
        __builtin_amdgcn_s_sleep(1);
        if ((++sp & 255u) == 0u) { if (xb_ld(&bar[XB_TMO])) break; if (sp > XB_SPIN_CAP) { atomicAdd(&bar[XB_TMO], 1u); break; } }
    }
    nloc = mine > 0u ? mine : 1u; nx = cnt > 0u ? cnt : 1u;
}
__device__ __forceinline__ void xcd_barrier(const XcdBarrier& b) {
    asm volatile("s_waitcnt vmcnt(0)" ::: "memory");
    __syncthreads();
    if (threadIdx.x == 0) {
        unsigned* bar = b.bar;
        __builtin_amdgcn_s_waitcnt(0);
        unsigned nloc = b.st[0], nx = b.st[1];
        if (nloc == 0u) { xcd_barrier_complete(bar, b.x, nloc, nx); b.st[0] = nloc; b.st[1] = nx; }
        const unsigned old = xb_add(&bar[XB_XSUB(b.x)], 1u);
        const unsigned gen = old / nloc;
        if (old + 1u == (gen + 1u) * nloc) {
            __builtin_amdgcn_fence(__ATOMIC_RELEASE, "agent");
            asm volatile("s_waitcnt vmcnt(0)" ::: "memory");
            const unsigned og = xb_add(&bar[XB_TOP], 1u);
            const unsigned tg = og / nx;
            if (og + 1u == (tg + 1u) * nx) xb_add(&bar[XB_TOPGEN], 1u);
            else XB_SPIN(xb_ld(&bar[XB_TOPGEN]) == tg, bar);
            __builtin_amdgcn_fence(__ATOMIC_ACQUIRE, "agent");
            xb_add(&bar[XB_XGEN(b.x)], 1u);
            asm volatile("s_waitcnt vmcnt(0)" ::: "memory");
        } else {
            XB_SPIN(xb_ld(&bar[XB_XGEN(b.x)]) == gen, bar);
            __builtin_amdgcn_fence(__ATOMIC_ACQUIRE, "agent");
            asm volatile("s_waitcnt vmcnt(0)" ::: "memory");
        }
    }
    __syncthreads();
}

__device__ __forceinline__ int lane_id_opaque() { int l = (int)__builtin_amdgcn_mbcnt_hi(~0u, __builtin_amdgcn_mbcnt_lo(~0u, 0u)); asm volatile("" : "+v"(l)); return l & 63; }

namespace gm {
constexpr int BM = 256, BK = 64, HALF = 128, HTB = HALF * BK * 2, NXCD = 8, WGM = 8;
__host__ __device__ __forceinline__ int lds_byte(int r, int c) { const int st = (r >> 4) * 2 + (c >> 5), rr = r & 15, cc = c & 31, ob = rr * 64 + cc * 2; return st * 1024 + (ob ^ (((ob >> 9) & 1) << 5)); }
__host__ __device__ __forceinline__ void stage_rc(int b, int& R, int& C) { const int st = b / 1024, sb = b % 1024, swz = sb ^ (((sb >> 9) & 1) << 5); R = (st >> 1) * 16 + swz / 64; C = (st & 1) * 32 + (swz % 64) / 2; }
__host__ __device__ __forceinline__ int perm32(int rho) { const int n = rho >> 4, i = rho & 15; return 8 * (i >> 2) + 4 * n + (i & 3); }

struct Unit { const char* A; const char* B; char* C; int ldc; int row0; int col0; };

struct GridOrder {
    int nM, nN, nwg, G, c; const char* A; const char* B; char* C; size_t atile, btile; int ldc, esz;
    __device__ __forceinline__ void init(int M, int N, int G_, int c_, const void* A_, size_t lda_bytes, const void* B_, size_t ldb_bytes, void* C_, int ldc_, int esz_) {
        nM = M / BM; nN = N / BM; nwg = nM * nN; G = G_; c = c_; A = (const char*)A_; B = (const char*)B_; C = (char*)C_; atile = lda_bytes * BM; btile = ldb_bytes * BM; ldc = ldc_; esz = esz_; }
    __device__ __forceinline__ bool next(int i, Unit& u) const {
        const long L = (long)i * G + c; if (L >= nwg) return false;
        int wgid = (int)L; { const int q = nwg / NXCD, r = nwg % NXCD, xcd = wgid % NXCD, off = wgid / NXCD; wgid = (xcd < r ? xcd * (q + 1) : r * (q + 1) + (xcd - r) * q) + off; }
        const int nig = WGM * nN, gid = wgid / nig, fm = gid * WGM, gsz = (nM - fm) < WGM ? (nM - fm) : WGM;
        const int pm = fm + ((wgid % nig) % gsz), pn = (wgid % nig) / gsz;
        u.A = A + (size_t)pm * atile; u.B = B + (size_t)pn * btile; u.row0 = pm * BM; u.col0 = pn * BM; u.ldc = ldc;
        u.C = C + ((size_t)u.row0 * ldc + u.col0) * esz; return true;
    }
};

struct EpiBf16 {
    static constexpr bool PERM = true;
    const float* ssq; float scale;
    __device__ __forceinline__ void operator()(const f32x4 (&acc)[2][2][4][2], const Unit& u, int wr, int wc, int fr, int fq) const {
        bf16* base = (bf16*)u.C + wc * 32 + 8 * fq;
#pragma unroll
        for (int ai = 0; ai < 2; ++ai)
#pragma unroll
            for (int m = 0; m < 4; ++m) { const int r = ai * HALF + wr * 64 + m * 16 + fr;
                float s = scale; if (ssq) s *= __builtin_amdgcn_rsqf(ssq[u.row0 + r] * (1.0f / DM) + RMS_EPS);
                bf16* rowp = base + (size_t)r * u.ldc;
#pragma unroll
                for (int bj = 0; bj < 2; ++bj) { const f32x4 v0 = acc[ai][bj][m][0] * s, v1 = acc[ai][bj][m][1] * s;
                    u32x4 w; w.x = cvt_pk_bf16(v0[0], v0[1]); w.y = cvt_pk_bf16(v0[2], v0[3]); w.z = cvt_pk_bf16(v1[0], v1[1]); w.w = cvt_pk_bf16(v1[2], v1[3]);
                    *(u32x4*)(rowp + bj * HALF) = w; } }
    }
};
struct EpiSwiglu {
    static constexpr bool PERM = true;
    const float* ssq; bf16* H;
    __device__ __forceinline__ void operator()(const f32x4 (&acc)[2][2][4][2], const Unit& u, int wr, int wc, int fr, int fq) const {
        bf16* base = H + (size_t)u.row0 * FF + (u.col0 >> 1) + wc * 32 + 8 * fq;
#pragma unroll
        for (int ai = 0; ai < 2; ++ai)
#pragma unroll
            for (int m = 0; m < 4; ++m) { const int r = ai * HALF + wr * 64 + m * 16 + fr;
                const float s = __builtin_amdgcn_rsqf(ssq[u.row0 + r] * (1.0f / DM) + RMS_EPS);
                float hv[8];
#pragma unroll
                for (int n = 0; n < 2; ++n)
#pragma unroll
                    for (int j = 0; j < 4; ++j) { const float g = acc[ai][0][m][n][j] * s, up = acc[ai][1][m][n][j] * s;
                        const float e = __builtin_amdgcn_exp2f(-g * LOG2E); hv[n * 4 + j] = g * __builtin_amdgcn_rcpf(1.0f + e) * up; }
                u32x4 w; w.x = cvt_pk_bf16(hv[0], hv[1]); w.y = cvt_pk_bf16(hv[2], hv[3]); w.z = cvt_pk_bf16(hv[4], hv[5]); w.w = cvt_pk_bf16(hv[6], hv[7]);
                *(u32x4*)(base + (size_t)r * FF) = w; }
    }
};
struct EpiResid {
    static constexpr bool PERM = false;
    const float* xp; const float* xs; int from_input;
    float* X; bf16* XB; float* ssq; int write_xb;
    __device__ __forceinline__ void operator()(const f32x4 (&acc)[2][2][4][2], const Unit& u, int wr, int wc, int fr, int fq) const {
        const float* rbase = from_input ? (u.row0 < NTOK_P ? xp + (size_t)u.row0 * DM : xs + (size_t)(u.row0 - NTOK_P) * DM) : X + (size_t)u.row0 * DM;
        const int c0 = u.col0 + wc * 32 + 4 * fq;
#pragma unroll
        for (int ai = 0; ai < 2; ++ai)
#pragma unroll
            for (int m = 0; m < 4; ++m) { const int r = ai * HALF + wr * 64 + m * 16 + fr; const size_t off = (size_t)r * DM + c0;
                float s = 0.f;
#pragma unroll
                for (int bj = 0; bj < 2; ++bj)
#pragma unroll
                    for (int n = 0; n < 2; ++n) { const f32x4 rv = *(const f32x4*)(rbase + off + bj * HALF + n * 16); const f32x4 v = rv + acc[ai][bj][m][n];
                        *(f32x4*)(X + (size_t)u.row0 * DM + off + bj * HALF + n * 16) = v;
                        s += (v[0] * v[0] + v[1] * v[1]) + (v[2] * v[2] + v[3] * v[3]);
                        if (write_xb) { u32x2 w; w.x = cvt_pk_bf16(v[0], v[1]); w.y = cvt_pk_bf16(v[2], v[3]); *(u32x2*)(XB + (size_t)u.row0 * DM + off + bj * HALF + n * 16) = w; } }
                s += __shfl_xor(s, 16); s += __shfl_xor(s, 32);
                if (fq == 0) unsafeAtomicAdd(ssq + u.row0 + r, s);
                asm volatile("" ::: "memory"); }
    }
};

template <class Epi, class Sched>
__device__ __forceinline__ void gemm_phase(LAS unsigned char* lds, const int wave, const int K, const int lda, const int ldb, const Sched& S, const Epi& E) {
    const int lane = lane_id_opaque(), wid = wave, tid = wid * 64 + lane, wr = wid >> 2, wc = wid & 3, fr = lane & 15, fq = lane >> 4;
    const int nt = K / BK;
    unsigned voffA[2], voffB[2];
#pragma unroll
    for (int i = 0; i < 2; ++i) { int R, C; stage_rc(tid * 16 + i * 8192, R, C); const int Rb = Epi::PERM ? ((R & ~31) + perm32(R & 31)) : R;
        voffA[i] = (unsigned)(R * lda + C) * 2u; voffB[i] = (unsigned)(Rb * ldb + C) * 2u; }
    const size_t kstep = (size_t)(BK * 2);
    const size_t hstepA = (size_t)HALF * lda * 2, hstepB = (size_t)HALF * ldb * 2;
    const unsigned ldsw = (unsigned)wid * 1024u;
    const int aoff = lds_byte(wr * 64 + fr, fq * 8), boff = lds_byte(wc * 32 + fr, fq * 8);
#define PG8_SA(b, h) (((b) * 2 + (h)) * HTB)
#define PG8_SB(b, h) ((4 + (b) * 2 + (h)) * HTB)
#define PG8_STAGE(bufoff, gbase, voff) do { _Pragma("unroll") for (int _i = 0; _i < 2; ++_i) \
        __builtin_amdgcn_global_load_lds((const unsigned*)((const char*)(gbase) + (voff)[_i]), (LAS unsigned*)(lds + (bufoff) + ldsw + _i * 8192), 16, 0, 0); } while (0)
#define PG8_LDA(dst, b, h) do { _Pragma("unroll") for (int m = 0; m < 4; ++m) _Pragma("unroll") for (int k = 0; k < 2; ++k) dst[m][k] = *(const LAS bf16x8*)(lds + PG8_SA(b, h) + aoff + m * 2048 + k * 1024); } while (0)
#define PG8_LDB(dst, b, h) do { _Pragma("unroll") for (int n = 0; n < 2; ++n) _Pragma("unroll") for (int k = 0; k < 2; ++k) dst[n][k] = *(const LAS bf16x8*)(lds + PG8_SB(b, h) + boff + n * 2048 + k * 1024); } while (0)
#define PG8_MMA(ai, bj, At, Bt) do { __builtin_amdgcn_s_setprio(1); _Pragma("unroll") for (int m = 0; m < 4; ++m) _Pragma("unroll") for (int n = 0; n < 2; ++n) _Pragma("unroll") for (int k = 0; k < 2; ++k) \
        acc[ai][bj][m][n] = __builtin_amdgcn_mfma_f32_16x16x32_bf16(Bt[n][k], At[m][k], acc[ai][bj][m][n], 0, 0, 0); __builtin_amdgcn_s_setprio(0); } while (0)
#define PG8_WAIT_V(n) asm volatile("s_waitcnt vmcnt(" #n ")" ::: "memory")
#define PG8_WAIT_L(n) asm volatile("s_waitcnt lgkmcnt(" #n ")" ::: "memory")
#define PG8_BAR __builtin_amdgcn_s_barrier()
#define PG8_SCHED __builtin_amdgcn_sched_barrier(0)
    Unit cur, nxt; int ui = 0;
    if (!S.next(0, cur)) return;
    f32x4 acc[2][2][4][2];
#pragma unroll
    for (int a = 0; a < 2; ++a)
#pragma unroll
        for (int b = 0; b < 2; ++b)
#pragma unroll
            for (int m = 0; m < 4; ++m)
#pragma unroll
                for (int n = 0; n < 2; ++n) acc[a][b][m][n] = (f32x4){0.f, 0.f, 0.f, 0.f};
    bf16x8 At[4][2], B0[2][2], B1[2][2];
    const char* cA = cur.A; const char* cB = cur.B;
    PG8_STAGE(PG8_SB(0, 0), cB, voffB); PG8_STAGE(PG8_SB(0, 1), cB + hstepB, voffB); PG8_STAGE(PG8_SA(0, 0), cA, voffA); PG8_STAGE(PG8_SA(0, 1), cA + hstepA, voffA);
    if (wr == 1) PG8_BAR;
    PG8_WAIT_V(2); PG8_BAR;
    PG8_STAGE(PG8_SB(1, 0), cB + kstep, voffB); PG8_STAGE(PG8_SA(1, 0), cA + kstep, voffA); PG8_STAGE(PG8_SB(1, 1), cB + hstepB + kstep, voffB);
    PG8_WAIT_V(6); PG8_BAR;
    for (;;) {
        const bool has_next = S.next(ui + 1, nxt);
        const char* nA = has_next ? nxt.A : cA; const char* nB = has_next ? nxt.B : cB;
        for (int t = 0; t < nt; t += 2) {
            const bool last = (t == nt - 2);
            const char* a1 = cA + (size_t)(t + 1) * kstep;
            const char* a2 = last ? nA : cA + (size_t)(t + 2) * kstep; const char* b2 = last ? nB : cB + (size_t)(t + 2) * kstep;
            const char* a3 = a2 + kstep; const char* b3 = b2 + kstep;
            PG8_LDB(B0, 0, 0); PG8_LDB(B1, 0, 1); PG8_SCHED; PG8_LDA(At, 0, 0); PG8_STAGE(PG8_SA(1, 1), a1 + hstepA, voffA);
            PG8_WAIT_V(8); PG8_WAIT_L(0); PG8_BAR; PG8_MMA(0, 0, At, B0); PG8_MMA(0, 1, At, B1); PG8_BAR; PG8_SCHED;
            PG8_LDA(At, 0, 1); PG8_STAGE(PG8_SB(0, 0), b2, voffB); PG8_STAGE(PG8_SB(0, 1), b2 + hstepB, voffB); PG8_STAGE(PG8_SA(0, 0), a2, voffA);
            PG8_WAIT_V(8); PG8_WAIT_L(0); PG8_BAR; PG8_MMA(1, 0, At, B0); PG8_MMA(1, 1, At, B1); PG8_BAR; PG8_SCHED;
            PG8_LDB(B0, 1, 0); PG8_LDB(B1, 1, 1); PG8_SCHED; PG8_LDA(At, 1, 0); PG8_STAGE(PG8_SA(0, 1), a2 + hstepA, voffA);
            PG8_WAIT_V(8); PG8_WAIT_L(0); PG8_BAR; PG8_MMA(0, 0, At, B0); PG8_MMA(0, 1, At, B1); PG8_BAR; PG8_SCHED;
            PG8_LDA(At, 1, 1); PG8_STAGE(PG8_SB(1, 0), b3, voffB); PG8_STAGE(PG8_SB(1, 1), b3 + hstepB, voffB); PG8_STAGE(PG8_SA(1, 0), a3, voffA);
            PG8_WAIT_V(8); PG8_WAIT_L(0); PG8_BAR; PG8_MMA(1, 0, At, B0); PG8_MMA(1, 1, At, B1); PG8_BAR; PG8_SCHED;
        }
        if (wr == 0) PG8_BAR;
        E(acc, cur, wr, wc, fr, fq);
        if (!has_next) break;
#pragma unroll
        for (int a = 0; a < 2; ++a)
#pragma unroll
            for (int b = 0; b < 2; ++b)
#pragma unroll
                for (int m = 0; m < 4; ++m)
#pragma unroll
                    for (int n = 0; n < 2; ++n) acc[a][b][m][n] = (f32x4){0.f, 0.f, 0.f, 0.f};
        cur = nxt; cA = nA; cB = nB; ++ui;
        if (wr == 1) PG8_BAR;
    }
    PG8_WAIT_V(0);
    PG8_BAR;
#undef PG8_SA
#undef PG8_SB
#undef PG8_STAGE
#undef PG8_LDA
#undef PG8_LDB
#undef PG8_MMA
#undef PG8_WAIT_V
#undef PG8_WAIT_L
#undef PG8_BAR
#undef PG8_SCHED
}
}

struct Frame {
    LAS unsigned char* lds;
    int wave, vcu, G;
};
struct SeqInfo { int row0, S; };
__device__ __forceinline__ SeqInfo seq_info(int q) { SeqInfo s; if (q < 2) { s.row0 = q * 8192; s.S = 8192; } else { s.row0 = NTOK_P + (q - 2) * 2048; s.S = 2048; } return s; }

__device__ __forceinline__ float wave_sum(float v) {
#pragma unroll
    for (int o = 1; o < 64; o <<= 1) v += __shfl_xor(v, o);
    return v;
}

__device__ __forceinline__ void p0_item(const float* W, int K, int N, const float* g, bf16* WT, int k0, int n0, int drow0, LAS float* scr, int lane) {
    const int n4 = (lane & 7) * 4;
#pragma unroll
    for (int i = 0; i < 8; ++i) { const int kk = (lane >> 3) + 8 * i;
        f32x4 v = *(const f32x4*)(W + (size_t)(k0 + kk) * N + n0 + n4);
        if (g) v = v * g[k0 + kk];
        scr[kk * 33 + n4 + 0] = v[0]; scr[kk * 33 + n4 + 1] = v[1]; scr[kk * 33 + n4 + 2] = v[2]; scr[kk * 33 + n4 + 3] = v[3]; }
    LDS_WAIT(); asm volatile("" ::: "memory");
    const int c = lane & 7;
#pragma unroll
    for (int j = 0; j < 4; ++j) { const int n = (lane >> 3) + 8 * j; const LAS float* s = scr + (8 * c) * 33 + n;
        u32x4 o; o.x = cvt_pk_bf16(s[0 * 33], s[1 * 33]); o.y = cvt_pk_bf16(s[2 * 33], s[3 * 33]); o.z = cvt_pk_bf16(s[4 * 33], s[5 * 33]); o.w = cvt_pk_bf16(s[6 * 33], s[7 * 33]);
        *(u32x4*)(WT + (size_t)(drow0 + n) * K + k0 + 8 * c) = o; }
    LDS_WAIT(); asm volatile("" ::: "memory");
}
struct WJob { const float* W; const float* g; bf16* WT; int K, N, mode; };

#define KSWZ(row, colB) ((row) * 256 + ((colB) ^ (((row) & 7) << 4)))
__device__ __forceinline__ int crow(int r, int hi) { return (r & 3) + 8 * (r >> 2) + 4 * hi; }
__device__ __forceinline__ int swap23(int k) { return (k & ~0xC) | ((k & 4) << 1) | ((k & 8) >> 1); }
__device__ __forceinline__ int v_rd_base(int lane) { return ((lane & 3) << 3) | (((lane >> 2) & 3) << 6) | (((lane >> 4) & 1) << 5) | (((lane >> 5) & 1) << 8); }
template <int OFF> __device__ __forceinline__ s16x4 tr_read(unsigned vb) {
    s16x4 r; asm volatile("ds_read_b64_tr_b16 %0, %1 offset:%2" : "=&v"(r) : "v"(vb), "i"(OFF) : "memory"); return r;
}
__device__ __forceinline__ void qkt(f32x16& p0, f32x16& p1, const LAS unsigned char* Ks, const bf16x8 (&qr)[8], int r32, int hi) {
    p0 = (f32x16){0.f, 0.f, 0.f, 0.f, 0.f, 0.f, 0.f, 0.f, 0.f, 0.f, 0.f, 0.f, 0.f, 0.f, 0.f, 0.f}; p1 = p0;
    const LAS unsigned char* k0p = Ks + r32 * 256; const LAS unsigned char* k1p = Ks + (32 + r32) * 256; const int sw = (r32 & 7) << 4;
    bf16x8 a0 = *(const LAS bf16x8*)(k0p + ((hi * 16) ^ sw)), a1 = *(const LAS bf16x8*)(k1p + ((hi * 16) ^ sw));
#pragma unroll
    for (int d0 = 0; d0 < 8; ++d0) {
        bf16x8 n0 = a0, n1 = a1;
        if (d0 < 7) { const int cb = ((d0 + 1) * 32 + hi * 16) ^ sw; n0 = *(const LAS bf16x8*)(k0p + cb); n1 = *(const LAS bf16x8*)(k1p + cb); }
        p0 = __builtin_amdgcn_mfma_f32_32x32x16_bf16(a0, qr[d0], p0, 0, 0, 0);
        p1 = __builtin_amdgcn_mfma_f32_32x32x16_bf16(a1, qr[d0], p1, 0, 0, 0);
        a0 = n0; a1 = n1;
        SBAR();
    }
}
template <int D0, int NCB> __device__ __forceinline__ void pv_one(f32x16& od, unsigned vb, bf16x8 pa0, bf16x8 pa1, bf16x8 pa2, bf16x8 pa3) {
#define VRO(ks, half) (D0 * 512 + (ks) * (NCB * 1024) + (half) * (NCB * 512))
    const s16x4 l0 = tr_read<VRO(0, 0)>(vb), h0 = tr_read<VRO(0, 1)>(vb), l1 = tr_read<VRO(1, 0)>(vb), h1 = tr_read<VRO(1, 1)>(vb);
    const s16x4 l2 = tr_read<VRO(2, 0)>(vb), h2 = tr_read<VRO(2, 1)>(vb), l3 = tr_read<VRO(3, 0)>(vb), h3 = tr_read<VRO(3, 1)>(vb);
#undef VRO
    asm volatile("s_waitcnt lgkmcnt(0)" ::: "memory"); SBAR();
#define PK(L, H) (bf16x8){L[0], L[1], L[2], L[3], H[0], H[1], H[2], H[3]}
    od = __builtin_amdgcn_mfma_f32_32x32x16_bf16(pa0, PK(l0, h0), od, 0, 0, 0);
    od = __builtin_amdgcn_mfma_f32_32x32x16_bf16(pa1, PK(l1, h1), od, 0, 0, 0);
    od = __builtin_amdgcn_mfma_f32_32x32x16_bf16(pa2, PK(l2, h2), od, 0, 0, 0);
    od = __builtin_amdgcn_mfma_f32_32x32x16_bf16(pa3, PK(l3, h3), od, 0, 0, 0);
#undef PK
}
__device__ __forceinline__ void softmax_tile(f32x16& p0, f32x16& p1, float& m_reg, float& l_reg, float& alpha, bf16x8& pa0, bf16x8& pa1, bf16x8& pa2, bf16x8& pa3) {
    float pmax = p0[0];
#pragma unroll
    for (int r = 1; r < 16; ++r) pmax = fmaxf(pmax, p0[r]);
#pragma unroll
    for (int r = 0; r < 16; ++r) pmax = fmaxf(pmax, p1[r]);
    { auto rr = __builtin_amdgcn_permlane32_swap(__float_as_uint(pmax), __float_as_uint(pmax), false, false);
      pmax = fmaxf(__uint_as_float(rr[0]), __uint_as_float(rr[1])); }
    const float mn = fmaxf(m_reg, pmax);
    alpha = __builtin_amdgcn_exp2f(m_reg - mn); m_reg = mn;
#pragma unroll
    for (int r = 0; r < 16; ++r) p0[r] = __builtin_amdgcn_exp2f(p0[r] - mn);
#pragma unroll
    for (int r = 0; r < 16; ++r) p1[r] = __builtin_amdgcn_exp2f(p1[r] - mn);
    float ps = 0.f;
#pragma unroll
    for (int r = 0; r < 16; ++r) ps += p0[r];
#pragma unroll
    for (int r = 0; r < 16; ++r) ps += p1[r];
    { auto rr = __builtin_amdgcn_permlane32_swap(__float_as_uint(ps), __float_as_uint(ps), false, false);
      ps = __uint_as_float(rr[0]) + __uint_as_float(rr[1]); }
    l_reg = l_reg * alpha + ps;
#define PK4(P, BASE, OUT) do { unsigned a0 = cvt_pk_bf16(P[BASE + 0], P[BASE + 1]), a1 = cvt_pk_bf16(P[BASE + 2], P[BASE + 3]);   \
    unsigned b0 = cvt_pk_bf16(P[BASE + 4], P[BASE + 5]), b1 = cvt_pk_bf16(P[BASE + 6], P[BASE + 7]);                              \
    auto r0 = __builtin_amdgcn_permlane32_swap(a0, b0, false, false); auto r1 = __builtin_amdgcn_permlane32_swap(a1, b1, false, false); \
    u32x4 w = {r0[0], r1[0], r0[1], r1[1]}; OUT = *reinterpret_cast<bf16x8*>(&w); } while (0)
    PK4(p0, 0, pa0); PK4(p0, 8, pa1); PK4(p1, 0, pa2); PK4(p1, 8, pa3);
#undef PK4
}
__device__ __forceinline__ void k_src(int b, int& row, int& col) { row = b >> 8; const int cb = (b & 255) ^ ((row & 7) << 4); col = cb >> 1; }
template <int NCB> __device__ __forceinline__ void v_src(int b, int& key, int& col) {
    const int st = b >> 9, e = (b & 511) >> 1; const int kk = (st / NCB) * 8 + (e >> 5); key = swap23(kk); col = (st % NCB) * 32 + (e & 31);
}
__device__ __forceinline__ void glds16(const void* g, LAS unsigned char* l) { __builtin_amdgcn_global_load_lds((const unsigned*)g, (LAS unsigned*)l, 16, 0, 0); }

__device__ __forceinline__ const void* karg_ptr(int off) {
    asm volatile("" : "+s"(off));
    const __attribute__((address_space(4))) char* ka = (const __attribute__((address_space(4))) char*)__builtin_amdgcn_kernarg_segment_ptr();
    return *(const void* const __attribute__((address_space(4)))*)(ka + off);
}
#define KIN(i) ((const float*)karg_ptr(8 * (i)))
#define KOUT() ((float*)karg_ptr(152))
#define KWS() ((unsigned char*)karg_ptr(160))

struct Args { const float* in[19]; float* out; unsigned char* ws; };

__global__ void __launch_bounds__(512, 2) mega_fwd(Args args) {
    extern __shared__ __attribute__((aligned(16))) unsigned char lds_raw[];
    Frame F; F.lds = (LAS unsigned char*)lds_raw;
    F.wave = __builtin_amdgcn_readfirstlane(threadIdx.x >> 6);
    F.G = gridDim.x; { const int bx = blockIdx.x; F.vcu = (F.G % 8 == 0) ? (bx % 8) * (F.G / 8) + bx / 8 : bx; }
    volatile LAS unsigned* MISC = (volatile LAS unsigned*)(F.lds + EX_MISC);
    if (threadIdx.x < 64) MISC[threadIdx.x] = 0u;
    __syncthreads();
    (void)xcd_barrier_post((unsigned*)KWS() + CW_BAR, MISC + 8);
#ifndef PH_MASK
#define PH_MASK 0x1FFF
#endif
#define IN(k) ((PH_MASK >> (k)) & 1)
#define SEAM(k) do { if (IN(k) && IN((k) + 1)) { XcdBarrier b_; b_.bar = (unsigned*)KWS() + CW_BAR; b_.x = xb_xcc_id(); b_.st = MISC + 8; xcd_barrier(b_); } } while (0)
#define P_XPROMPT KIN(0)
#define P_XSAMPLE KIN(1)
#define P_SSQ ((float*)(KWS() + WS_CTL + CTL_SSQ))
#define P_X KOUT()
#define P_WS(off) ((bf16*)(KWS() + (off)))

    if (IN(0)) {
        const float* x_prompt = KIN(0); const float* x_sample = KIN(1); const float* norm_mix = KIN(2); const float* norm_ffn = KIN(3);
        const float* w_in_even = KIN(4); const float* w_out_even = KIN(6); const float* w_in_odd = KIN(7); const float* w_out_odd = KIN(13);
        const float* w_gate = KIN(15); const float* w_up = KIN(16); const float* w_down = KIN(17);
        unsigned char* ws = KWS(); float* ssq = (float*)(ws + WS_CTL + CTL_SSQ); unsigned* ctl = (unsigned*)ws;
        bf16* WIE = (bf16*)(ws + WS_WIE); bf16* WOE = (bf16*)(ws + WS_WOE); bf16* WIO = (bf16*)(ws + WS_WIO); bf16* WOO = (bf16*)(ws + WS_WOO);
        bf16* WGU0 = (bf16*)(ws + WS_WGU0); bf16* WGU1 = (bf16*)(ws + WS_WGU1); bf16* WD0 = (bf16*)(ws + WS_WD0); bf16* WD1 = (bf16*)(ws + WS_WD1);
        bf16* XB = (bf16*)(ws + WS_XB);
        unsigned char* outb = (unsigned char*)KOUT(); bf16* A8 = (bf16*)(outb + DO_A8); bf16* A2 = (bf16*)(outb + DO_A2); bf16* FC = (bf16*)(outb + DO_FC);
        const int p0lane = lane_id_opaque(), p0tid = F.wave * 64 + p0lane;
        LAS float* scr = (LAS float*)(F.lds + F.wave * 16384);
        const int gw = F.vcu * 8 + F.wave, NGW = F.G * 8;
        const size_t WFF = (size_t)DM * FF;
        {
            constexpr int I0 = 64 * 256, I1 = 64 * 128, I2 = 64 * 384, I3 = 64 * 128, IG = 64 * 344, ID = 172 * 128;
            constexpr int NITEMS = I0 + I1 + I2 + I3 + 4 * IG + 2 * ID;
            for (int it = gw; it < NITEMS; it += NGW) {
                int r = it; WJob j;
                if (r < I0) j = WJob{w_in_even, norm_mix, WIE, DM, EVEN_IN, 0};
                else if ((r -= I0) < I1) j = WJob{w_out_even, nullptr, WOE, DM, DM, 0};
                else if ((r -= I1) < I2) j = WJob{w_in_odd, norm_mix + DM, WIO, DM, ODD_IN, 0};
                else if ((r -= I2) < I3) j = WJob{w_out_odd, nullptr, WOO, DM, DM, 0};
                else if ((r -= I3) < IG) j = WJob{w_gate, norm_ffn, WGU0, DM, FF, 1};
                else if ((r -= IG) < IG) j = WJob{w_up, norm_ffn, WGU0, DM, FF, 2};
                else if ((r -= IG) < IG) j = WJob{w_gate + WFF, norm_ffn + DM, WGU1, DM, FF, 1};
                else if ((r -= IG) < IG) j = WJob{w_up + WFF, norm_ffn + DM, WGU1, DM, FF, 2};
                else if ((r -= IG) < ID) j = WJob{w_down, nullptr, WD0, FF, DM, 0};
                else { r -= ID; j = WJob{w_down + WFF, nullptr, WD1, FF, DM, 0}; }
                const int nblk = j.N / 32, kb = r / nblk, nb = r % nblk, n0 = nb * 32;
                const int drow0 = j.mode == 0 ? n0 : (256 * (n0 >> 7) + (n0 & 127) + (j.mode == 2 ? 128 : 0));
                p0_item(j.W, j.K, j.N, j.g, j.WT, kb * 64, n0, drow0, scr, p0lane);
            }
        }
        for (int m = gw; m < NTOK; m += NGW) {
            const float* xr = (m < NTOK_P ? x_prompt + (size_t)m * DM : x_sample + (size_t)(m - NTOK_P) * DM);
            float s = 0.f;
#pragma unroll 4
            for (int j = 0; j < 16; ++j) { const f32x4 v = *(const f32x4*)(xr + j * 256 + p0lane * 4);
                s += (v[0] * v[0] + v[1] * v[1]) + (v[2] * v[2] + v[3] * v[3]);
                u32x2 w; w.x = cvt_pk_bf16(v[0], v[1]); w.y = cvt_pk_bf16(v[2], v[3]); *(u32x2*)(XB + (size_t)m * DM + j * 256 + p0lane * 4) = w; }
            s = wave_sum(s);
            if (p0lane == 0) ssq[m] = s;
        }
        {
            const long gt = (long)F.vcu * 512 + p0tid, NGT = (long)F.G * 512;
            constexpr long C8 = 8192L * 16384 / 8, C2 = 2048L * 4096 / 8, CF = 1024L * 512 / 8;
            for (long ch = gt; ch < C8 + C2 + CF; ch += NGT) {
                bf16* dst; int k, j0, S, mode;
                if (ch < C8) { k = (int)(ch / 2048); j0 = (int)(ch % 2048) * 8; S = 8192; dst = A8 + (size_t)k * 16384 + j0; mode = 0; }
                else if (ch < C8 + C2) { const long c = ch - C8; k = (int)(c / 512); j0 = (int)(c % 512) * 8; S = 2048; dst = A2 + (size_t)k * 4096 + j0; mode = 0; }
                else { const long c = ch - C8 - C2; k = (int)(c / 64); j0 = (int)(c % 64) * 8; S = 512; dst = FC + (size_t)k * 512 + j0; mode = 1; }
                float v[8];
#pragma unroll
                for (int e = 0; e < 8; ++e) { int j = j0 + e; bool sn; int kk = k;
                    if (mode == 0) { sn = j >= S; if (sn) j -= S; } else { sn = k >= 512; if (sn) kk = k - 512; }
                    const int r = (kk * j) & (S - 1); const float fr = (float)r / (float)S;
                    v[e] = sn ? (mode == 0 ? -__builtin_amdgcn_sinf(fr) : __builtin_amdgcn_sinf(fr)) : __builtin_amdgcn_cosf(fr); }
                u32x4 w; w.x = cvt_pk_bf16(v[0], v[1]); w.y = cvt_pk_bf16(v[2], v[3]); w.z = cvt_pk_bf16(v[4], v[5]); w.w = cvt_pk_bf16(v[6], v[7]);
                *(u32x4*)dst = w;
            }
        }
        if (blockIdx.x == 0 && F.wave == 0) {
            float a = 0.f, b = 0.f;
            const float* lambda_q1 = KIN(8); const float* lambda_k1 = KIN(9); const float* lambda_q2 = KIN(10); const float* lambda_k2 = KIN(11);
            for (int i = p0lane; i < 128; i += 64) { a += lambda_q1[i] * lambda_k1[i]; b += lambda_q2[i] * lambda_k2[i]; }
            a = wave_sum(a); b = wave_sum(b);
            if (p0lane == 0) ((float*)ctl)[CW_LAM] = __expf(a) - __expf(b) + LAM_INIT;
        }
    }
    SEAM(0);

    if (IN(1)) {
        unsigned char* ws = KWS(); float* ssq = (float*)(ws + WS_CTL + CTL_SSQ); bf16* XB = (bf16*)(ws + WS_XB); bf16* WIE = (bf16*)(ws + WS_WIE); bf16* PROJ = (bf16*)(ws + WS_PROJ);
        gm::GridOrder S; S.init(NTOK, EVEN_IN, F.G, (int)blockIdx.x, XB, (size_t)DM * 2, WIE, (size_t)DM * 2, PROJ, EVEN_IN, 2);
        gm::EpiBf16 E{ssq, 1.0f};
        gm::gemm_phase(F.lds, F.wave, DM, DM, DM, S, E);
    }
    SEAM(1);

    if (IN(2)) {
        unsigned char* ws = KWS(); bf16* PROJ = (bf16*)(ws + WS_PROJ); bf16* VT = (bf16*)(ws + WS_VT); bf16* MIX = (bf16*)(ws + WS_MIX);
        bf16* FC = (bf16*)((unsigned char*)KOUT() + DO_FC); const float* rpb_na = KIN(5);
        {
            struct Sch { int G, c; const bf16* FC; const bf16* PROJ; bf16* VT;
                __device__ __forceinline__ bool next(int i, gm::Unit& u) const {
                    const int L = i * G + c; if (L >= 1536) return false;
                    int q, g, pm, pn;
                    if (L < 1024) { q = L >> 9; const int r = L & 511; g = r >> 7; pm = (r >> 5) & 3; pn = r & 31; }
                    else { const int l2 = L - 1024; q = 2 + (l2 >> 7); const int r = l2 & 127; g = r >> 5; pm = (r >> 3) & 3; pn = r & 7; }
                    const SeqInfo si = seq_info(q);
                    u.A = (const char*)(FC + (size_t)pm * 256 * 512);
                    u.B = (const char*)(PROJ + (size_t)(si.row0 + pn * 256) * EVEN_IN + 6144 + g * 512);
                    u.ldc = 2 * si.S; u.row0 = 0; u.col0 = 0;
                    u.C = (char*)(VT + (size_t)4096 * si.row0 + (size_t)(g * 512 + (pm & 1) * 256) * (2 * si.S) + (size_t)(pm >> 1) * si.S + pn * 256);
                    return true; } };
            Sch S{F.G, (int)blockIdx.x, FC, PROJ, VT};
            gm::EpiBf16 E{nullptr, 1.0f};
            gm::gemm_phase(F.lds, F.wave, 512, 512, EVEN_IN, S, E);
        }
        {
            const int w = F.wave, lane = lane_id_opaque(), tid = w * 64 + lane, r32 = lane & 31, hi = lane >> 5, hh = w >> 1, c0 = 32 * (w & 1);
            LAS float* tab = (LAS float*)(F.lds + EX_TAB);
            LAS float* wsl = (LAS float*)(F.lds + EX_WS) + w * 64;
            const LAS unsigned char* Kl = F.lds + hh * 16384; const unsigned vb = (unsigned)(uintptr_t)(F.lds + 65536 + hh * 16384) + v_rd_base(lane);
            const int upw = 1536 / F.G;
            for (int U = F.vcu * upw; U < (F.vcu + 1) * upw && U < 1536; ++U) {
                int q, hq, r;
                if (U < 1024) { q = U >> 9; const int t = U & 511; hq = t >> 7; r = t & 127; } else { const int t2 = U - 1024; q = 2 + (t2 >> 7); const int t = t2 & 127; hq = t >> 5; r = t & 31; }
                const SeqInfo si = seq_info(q); const int rows = si.S >> 6;
                int rs = r - 4; rs = rs < 0 ? 0 : (rs > rows - 8 ? rows - 8 : rs);
                const int h = 4 * hq + hh;
                __syncthreads();
                for (int e = tid; e < 4 * 8 * 32; e += 512) { const int dc = e & 31, i = (e >> 5) & 7, hd = e >> 8; const int dr = rs + i - r + 7;
                    tab[e] = dc < 31 ? rpb_na[((size_t)(4 * hq + hd) * 15 + dr) * 31 + dc] * LOG2E : 0.f; }
                bf16x8 qr[8];
                { const bf16* Qw = PROJ + (size_t)(si.row0 + r * 64 + c0 + r32) * EVEN_IN + h * 128 + hi * 8;
#pragma unroll
                  for (int d0 = 0; d0 < 8; ++d0) qr[d0] = *(const bf16x8*)(Qw + d0 * 16); }
                float m_reg = -1e30f, l_reg = 0.f; f32x16 o[4];
#pragma unroll
                for (int d = 0; d < 4; ++d) o[d] = (f32x16){0.f, 0.f, 0.f, 0.f, 0.f, 0.f, 0.f, 0.f, 0.f, 0.f, 0.f, 0.f, 0.f, 0.f, 0.f, 0.f};
                const int c = c0 + r32; int cs = c - 8; cs = cs < 0 ? 0 : (cs > 48 ? 48 : cs);
                for (int i = 0; i < 8; ++i) {
                    __syncthreads();
                    {
                        const bf16* src = PROJ + (size_t)(si.row0 + (rs + i) * 64) * EVEN_IN + (w < 4 ? 2048 + (4 * hq + w) * 128 : 4096 + (4 * hq + w - 4) * 128);
                        LAS unsigned char* dst = F.lds + w * 16384;
#pragma unroll 4
                        for (int j = 0; j < 16; ++j) { const int b = j * 1024 + lane * 16; int row, col;
                            if (w < 4) k_src(b, row, col); else v_src<4>(b, row, col);
                            glds16(src + (size_t)row * EVEN_IN + col, dst + j * 1024); }
                    }
                    VM_WAIT(); __syncthreads();
                    f32x16 p0, p1; qkt(p0, p1, Kl, qr, r32, hi);
                    const LAS float* tb = tab + (hh * 8 + i) * 32;
#pragma unroll
                    for (int rr = 0; rr < 16; ++rr) {
                        { const int kc = crow(rr, hi); const bool ok = (unsigned)(kc - cs) < 16u; const int dc = kc - c + 15; const float bv = tb[ok ? dc : 0];
                          p0[rr] = ok ? fmaf(p0[rr], ATT_C, bv) : -1e30f; }
                        { const int kc = 32 + crow(rr, hi); const bool ok = (unsigned)(kc - cs) < 16u; const int dc = kc - c + 15; const float bv = tb[ok ? dc : 0];
                          p1[rr] = ok ? fmaf(p1[rr], ATT_C, bv) : -1e30f; }
                    }
                    float alpha; bf16x8 pa0, pa1, pa2, pa3;
                    softmax_tile(p0, p1, m_reg, l_reg, alpha, pa0, pa1, pa2, pa3);
                    if (hi == 0) wsl[r32] = alpha; LDS_WAIT();
#pragma unroll
                    for (int d = 0; d < 4; ++d)
#pragma unroll
                        for (int rr = 0; rr < 16; ++rr) o[d][rr] *= wsl[crow(rr, hi)];
                    pv_one<0, 4>(o[0], vb, pa0, pa1, pa2, pa3); pv_one<1, 4>(o[1], vb, pa0, pa1, pa2, pa3); pv_one<2, 4>(o[2], vb, pa0, pa1, pa2, pa3); pv_one<3, 4>(o[3], vb, pa0, pa1, pa2, pa3);
                }
                if (hi == 0) wsl[32 + r32] = l_reg; LDS_WAIT();
                bf16* Ow = MIX + (size_t)(si.row0 + r * 64 + c0) * DM + h * 128 + r32;
#pragma unroll
                for (int rr = 0; rr < 16; ++rr) { const int orow = crow(rr, hi); const float rl = __builtin_amdgcn_rcpf(wsl[32 + orow]);
#pragma unroll
                    for (int d = 0; d < 4; ++d) Ow[(size_t)orow * DM + d * 32] = (bf16)(cvt_pk_bf16(o[d][rr] * rl, 0.f) & 0xffffu); }
            }
            __syncthreads();
        }
    }
    SEAM(2);

    if (IN(3)) {
        unsigned char* ws = KWS(); bf16* VT = (bf16*)(ws + WS_VT); bf16* MIX = (bf16*)(ws + WS_MIX);
        unsigned char* outb = (unsigned char*)KOUT(); bf16* A8 = (bf16*)(outb + DO_A8); bf16* A2 = (bf16*)(outb + DO_A2);
        {
            struct Sch { int G, c; const bf16* A8; const bf16* VT; bf16* MIX;
                __device__ __forceinline__ bool next(int i, gm::Unit& u) const {
                    if (i >= 2 || G != 256) { if (G == 256) return false; const int L = i * G + c; if (L >= 512) return false; const int q = L >> 8, pm = (L >> 3) & 31, pn = L & 7; return fill(u, q, pm, pn); }
                    const int xcd = c & 7, j = c >> 3; return fill(u, i, 4 * xcd + (j >> 3), j & 7); }
                __device__ __forceinline__ bool fill(gm::Unit& u, int q, int pm, int pn) const {
                    u.A = (const char*)(A8 + (size_t)pm * 256 * 16384); u.B = (const char*)(VT + (size_t)4096 * (q * 8192) + (size_t)pn * 256 * 16384);
                    u.ldc = DM; u.row0 = 0; u.col0 = 0; u.C = (char*)(MIX + (size_t)(q * 8192 + pm * 256) * DM + 2048 + pn * 256); return true; } };
            Sch S{F.G, (int)blockIdx.x, A8, VT, MIX};
            gm::EpiBf16 E{nullptr, 1.0f / 2048.0f};
            gm::gemm_phase(F.lds, F.wave, 16384, 16384, 16384, S, E);
        }
        {
            struct Sch { int G, c; const bf16* A2; const bf16* VT; bf16* MIX;
                __device__ __forceinline__ bool next(int i, gm::Unit& u) const {
                    int q, pm, pn;
                    if (G == 256) { if (i >= 1) return false; const int xcd = c & 7, j = c >> 3; q = xcd >> 1; pm = 4 * (xcd & 1) + (j >> 3); pn = j & 7; }
                    else { const int L = i * G + c; if (L >= 256) return false; q = L >> 6; pm = (L >> 3) & 7; pn = L & 7; }
                    const int row0 = NTOK_P + q * 2048;
                    u.A = (const char*)(A2 + (size_t)pm * 256 * 4096); u.B = (const char*)(VT + (size_t)4096 * row0 + (size_t)pn * 256 * 4096);
                    u.ldc = DM; u.row0 = 0; u.col0 = 0; u.C = (char*)(MIX + (size_t)(row0 + pm * 256) * DM + 2048 + pn * 256); return true; } };
            Sch S{F.G, (int)blockIdx.x, A2, VT, MIX};
            gm::EpiBf16 E{nullptr, 1.0f / 1024.0f};
            gm::gemm_phase(F.lds, F.wave, 4096, 4096, 4096, S, E);
        }
    }
    SEAM(3);

    if (IN(4)) {
        unsigned char* ws = KWS(); float* ssq = (float*)(ws + WS_CTL + CTL_SSQ); bf16* XB = (bf16*)(ws + WS_XB); bf16* MIX = (bf16*)(ws + WS_MIX); bf16* HMID = (bf16*)(ws + WS_PROJ); bf16* PROJ = HMID;
        float* X = KOUT(); const float* x_prompt = KIN(0); const float* x_sample = KIN(1);
        bf16* WOE = (bf16*)(ws + WS_WOE); bf16* WIO = (bf16*)(ws + WS_WIO); bf16* WOO = (bf16*)(ws + WS_WOO);
        bf16* WGU0 = (bf16*)(ws + WS_WGU0); bf16* WGU1 = (bf16*)(ws + WS_WGU1); bf16* WD0 = (bf16*)(ws + WS_WD0); bf16* WD1 = (bf16*)(ws + WS_WD1);
        (void)ssq; (void)XB; (void)MIX; (void)HMID; (void)PROJ; (void)X; (void)x_prompt; (void)x_sample; (void)WOE; (void)WIO; (void)WOO; (void)WGU0; (void)WGU1; (void)WD0; (void)WD1;
        gm::GridOrder S; S.init(NTOK, DM, F.G, (int)blockIdx.x, MIX, (size_t)DM * 2, WOE, (size_t)DM * 2, X, DM, 4);
        gm::EpiResid E{x_prompt, x_sample, 1, X, XB, ssq + NTOK, 1};
        gm::gemm_phase(F.lds, F.wave, DM, DM, DM, S, E);
    }
    SEAM(4);
    if (IN(5)) {
        unsigned char* ws = KWS(); float* ssq = (float*)(ws + WS_CTL + CTL_SSQ); bf16* XB = (bf16*)(ws + WS_XB); bf16* MIX = (bf16*)(ws + WS_MIX); bf16* HMID = (bf16*)(ws + WS_PROJ); bf16* PROJ = HMID;
        float* X = KOUT(); const float* x_prompt = KIN(0); const float* x_sample = KIN(1);
        bf16* WOE = (bf16*)(ws + WS_WOE); bf16* WIO = (bf16*)(ws + WS_WIO); bf16* WOO = (bf16*)(ws + WS_WOO);
        bf16* WGU0 = (bf16*)(ws + WS_WGU0); bf16* WGU1 = (bf16*)(ws + WS_WGU1); bf16* WD0 = (bf16*)(ws + WS_WD0); bf16* WD1 = (bf16*)(ws + WS_WD1);
        (void)ssq; (void)XB; (void)MIX; (void)HMID; (void)PROJ; (void)X; (void)x_prompt; (void)x_sample; (void)WOE; (void)WIO; (void)WOO; (void)WGU0; (void)WGU1; (void)WD0; (void)WD1;
        gm::GridOrder S; S.init(NTOK, 2 * FF, F.G, (int)blockIdx.x, XB, (size_t)DM * 2, WGU0, (size_t)DM * 2, HMID, FF, 2);
        gm::EpiSwiglu E{ssq + NTOK, HMID};
        gm::gemm_phase(F.lds, F.wave, DM, DM, DM, S, E);
    }
    SEAM(5);
    if (IN(6)) {
        unsigned char* ws = KWS(); float* ssq = (float*)(ws + WS_CTL + CTL_SSQ); bf16* XB = (bf16*)(ws + WS_XB); bf16* MIX = (bf16*)(ws + WS_MIX); bf16* HMID = (bf16*)(ws + WS_PROJ); bf16* PROJ = HMID;
        float* X = KOUT(); const float* x_prompt = KIN(0); const float* x_sample = KIN(1);
        bf16* WOE = (bf16*)(ws + WS_WOE); bf16* WIO = (bf16*)(ws + WS_WIO); bf16* WOO = (bf16*)(ws + WS_WOO);
        bf16* WGU0 = (bf16*)(ws + WS_WGU0); bf16* WGU1 = (bf16*)(ws + WS_WGU1); bf16* WD0 = (bf16*)(ws + WS_WD0); bf16* WD1 = (bf16*)(ws + WS_WD1);
        (void)ssq; (void)XB; (void)MIX; (void)HMID; (void)PROJ; (void)X; (void)x_prompt; (void)x_sample; (void)WOE; (void)WIO; (void)WOO; (void)WGU0; (void)WGU1; (void)WD0; (void)WD1;
        gm::GridOrder S; S.init(NTOK, DM, F.G, (int)blockIdx.x, HMID, (size_t)FF * 2, WD0, (size_t)FF * 2, X, DM, 4);
        gm::EpiResid E{x_prompt, x_sample, 0, X, XB, ssq + 2 * NTOK, 1};
        gm::gemm_phase(F.lds, F.wave, FF, FF, FF, S, E);
    }
    SEAM(6);
    if (IN(7)) {
        unsigned char* ws = KWS(); float* ssq = (float*)(ws + WS_CTL + CTL_SSQ); bf16* XB = (bf16*)(ws + WS_XB); bf16* MIX = (bf16*)(ws + WS_MIX); bf16* HMID = (bf16*)(ws + WS_PROJ); bf16* PROJ = HMID;
        float* X = KOUT(); const float* x_prompt = KIN(0); const float* x_sample = KIN(1);
        bf16* WOE = (bf16*)(ws + WS_WOE); bf16* WIO = (bf16*)(ws + WS_WIO); bf16* WOO = (bf16*)(ws + WS_WOO);
        bf16* WGU0 = (bf16*)(ws + WS_WGU0); bf16* WGU1 = (bf16*)(ws + WS_WGU1); bf16* WD0 = (bf16*)(ws + WS_WD0); bf16* WD1 = (bf16*)(ws + WS_WD1);
        (void)ssq; (void)XB; (void)MIX; (void)HMID; (void)PROJ; (void)X; (void)x_prompt; (void)x_sample; (void)WOE; (void)WIO; (void)WOO; (void)WGU0; (void)WGU1; (void)WD0; (void)WD1;
        gm::GridOrder S; S.init(NTOK, ODD_IN, F.G, (int)blockIdx.x, XB, (size_t)DM * 2, WIO, (size_t)DM * 2, PROJ, ODD_IN, 2);
        gm::EpiBf16 E{ssq + 2 * NTOK, 1.0f};
        gm::gemm_phase(F.lds, F.wave, DM, DM, DM, S, E);
    }
    SEAM(7);

    if (IN(8)) {
        unsigned char* ws = KWS(); bf16* PROJ = (bf16*)(ws + WS_PROJ); bf16* MIX = (bf16*)(ws + WS_MIX); const unsigned* ctl = (const unsigned*)ws;
        const float* subln_w = KIN(12); const float* t5_bias = KIN(14);
        const int w = F.wave, lane = lane_id_opaque(), tid = w * 64 + lane, r32 = lane & 31, hi = lane >> 5, mp = w >> 2, wq = w & 3;
        LAS float* tab = (LAS float*)(F.lds + EX_TAB);
        LAS float* wsl = (LAS float*)(F.lds + EX_WS) + w * 64;
        const float lam = ((const float*)ctl)[CW_LAM];
        const int NU = 3072;
        for (int uix = 0; ; ++uix) {
            int U;
            if (F.G == 256) { if (uix >= 12) break; U = uix < 8 ? F.vcu * 8 + uix : 2048 + F.vcu * 4 + (uix - 8); }
            else { U = uix * F.G + F.vcu; if (U >= NU) break; }
            int q, h, qb;
            if (U < 2048) { q = U >> 10; const int t = U & 1023; h = t >> 6; qb = t & 63; } else { const int t2 = U - 2048; q = 2 + (t2 >> 8); const int t = t2 & 255; h = t >> 4; qb = t & 15; }
            const SeqInfo si = seq_info(q); const int NT = si.S >> 6;
            __syncthreads();
            for (int e = tid; e < 257; e += 512) { const int rel = e - 128; const int n = rel < 0 ? -rel : rel; int bk = rel > 0 ? 16 : 0;
                if (n < 8) bk += n; else { int lg = 2 + (31 - __builtin_clz((unsigned)(n * n))); bk += lg > 15 ? 15 : lg; }
                tab[e] = t5_bias[bk * 16 + h] * LOG2E; }
            const int qpos0 = 128 * qb + 32 * wq;
            bf16x8 qr[8];
            { const bf16* Qw = PROJ + (size_t)(si.row0 + qpos0 + r32) * ODD_IN + h * 256 + mp * 128 + hi * 8;
#pragma unroll
              for (int d0 = 0; d0 < 8; ++d0) qr[d0] = *(const bf16x8*)(Qw + d0 * 16); }
            float m_reg = -1e30f, l_reg = 0.f; f32x16 o[8];
#pragma unroll
            for (int d = 0; d < 8; ++d) o[d] = (f32x16){0.f, 0.f, 0.f, 0.f, 0.f, 0.f, 0.f, 0.f, 0.f, 0.f, 0.f, 0.f, 0.f, 0.f, 0.f, 0.f};
            const bf16* kvbase = PROJ + (size_t)si.row0 * ODD_IN + h * 256;
#define DA_DMA(tile, bsel) do { const bf16* tb_ = kvbase + (size_t)((tile) * 64) * ODD_IN; LAS unsigned char* dst_ = F.lds + (bsel) * 65536 + w * 8192; \
            int ln_ = lane; asm volatile("" : "+v"(ln_));     \
            _Pragma("unroll") for (int j_ = 0; j_ < 8; ++j_) { const int pc_ = w * 8 + j_; int row_, col_; \
                if (pc_ < 32) { k_src((pc_ & 15) * 1024 + ln_ * 16, row_, col_); col_ += 4096 + (pc_ >> 4) * 128; } else { v_src<8>((pc_ - 32) * 1024 + ln_ * 16, row_, col_); col_ += 8192; } \
                glds16(tb_ + (unsigned)(row_ * ODD_IN + col_), dst_ + j_ * 1024); } } while (0)
            DA_DMA(0, 0); VM_WAIT(); __syncthreads();
            for (int j = 0; j < NT; ++j) {
                const int bsel = j & 1;
                if (j + 1 < NT) DA_DMA(j + 1, bsel ^ 1);
                const LAS unsigned char* Kl = F.lds + bsel * 65536 + mp * 16384;
                const unsigned vb = (unsigned)(uintptr_t)(F.lds + bsel * 65536 + 32768) + v_rd_base(lane);
                f32x16 p0, p1; qkt(p0, p1, Kl, qr, r32, hi);
                const int relb = 64 * j - (qpos0 + r32) + 128 + 4 * hi;
                SBAR();
#pragma unroll
                for (int g4 = 0; g4 < 4; ++g4) {
#pragma unroll
                    for (int r4 = 0; r4 < 4; ++r4) { const int rr = g4 * 4 + r4;
                        { int ix = relb + (rr & 3) + 8 * (rr >> 2); ix = ix < 0 ? 0 : (ix > 256 ? 256 : ix); p0[rr] = fmaf(p0[rr], ATT_C, tab[ix]); }
                        { int ix = relb + 32 + (rr & 3) + 8 * (rr >> 2); ix = ix < 0 ? 0 : (ix > 256 ? 256 : ix); p1[rr] = fmaf(p1[rr], ATT_C, tab[ix]); } }
                    SBAR();
                }
                float alpha; bf16x8 pa0, pa1, pa2, pa3;
                softmax_tile(p0, p1, m_reg, l_reg, alpha, pa0, pa1, pa2, pa3);
                SBAR();
                if (__any(alpha < 1.f)) {
                    if (hi == 0) wsl[r32] = alpha; LDS_WAIT();
#pragma unroll
                    for (int g4 = 0; g4 < 4; ++g4) {
#pragma unroll
                        for (int r4 = 0; r4 < 4; ++r4) { const int rr = g4 * 4 + r4; const float a = wsl[crow(rr, hi)];
#pragma unroll
                            for (int d = 0; d < 8; ++d) o[d][rr] *= a; }
                        SBAR();
                    }
                }
                SBAR();
                pv_one<0, 8>(o[0], vb, pa0, pa1, pa2, pa3); pv_one<1, 8>(o[1], vb, pa0, pa1, pa2, pa3); pv_one<2, 8>(o[2], vb, pa0, pa1, pa2, pa3); pv_one<3, 8>(o[3], vb, pa0, pa1, pa2, pa3);
                pv_one<4, 8>(o[4], vb, pa0, pa1, pa2, pa3); pv_one<5, 8>(o[5], vb, pa0, pa1, pa2, pa3); pv_one<6, 8>(o[6], vb, pa0, pa1, pa2, pa3); pv_one<7, 8>(o[7], vb, pa0, pa1, pa2, pa3);
                VM_WAIT(); __syncthreads();
            }
#undef DA_DMA
            if (hi == 0) wsl[32 + r32] = l_reg; LDS_WAIT();
            LAS float* xch = (LAS float*)(F.lds + wq * 32768);
            const float lsc = mp ? lam : 1.0f;
#pragma unroll
            for (int rr = 0; rr < 16; ++rr) { const float rl = __builtin_amdgcn_rcpf(wsl[32 + crow(rr, hi)]) * lsc;
#pragma unroll
                for (int d = 0; d < 8; ++d) o[d][rr] *= rl;
                if ((rr & 3) == 3) SBAR(); }
            if (mp == 1) {
#pragma unroll
                for (int d = 0; d < 8; ++d) {
#pragma unroll
                    for (int rr = 0; rr < 16; ++rr) xch[(d * 16 + rr) * 64 + lane] = o[d][rr];
                    SBAR(); }
            }
            __syncthreads();
            if (mp == 0) {
#pragma unroll
                for (int d = 0; d < 8; ++d) {
#pragma unroll
                    for (int rr = 0; rr < 16; ++rr) o[d][rr] -= xch[(d * 16 + rr) * 64 + lane];
                    SBAR(); }
                bf16* Ow = MIX + (size_t)(si.row0 + qpos0) * DM + h * 256 + r32;
                float gw_[8];
#pragma unroll
                for (int d = 0; d < 8; ++d) gw_[d] = subln_w[d * 32 + r32] * (1.0f - LAM_INIT);
#pragma unroll
                for (int rr = 0; rr < 16; ++rr) { float s = 0.f;
#pragma unroll
                    for (int d = 0; d < 8; ++d) s += o[d][rr] * o[d][rr];
                    s += __shfl_xor(s, 1); s += __shfl_xor(s, 2); s += __shfl_xor(s, 4); s += __shfl_xor(s, 8); s += __shfl_xor(s, 16);
                    const float rs_ = __builtin_amdgcn_rsqf(s * (1.0f / 256.0f) + SUBLN_EPS);
#pragma unroll
                    for (int d = 0; d < 8; ++d) Ow[(size_t)crow(rr, hi) * DM + d * 32] = (bf16)(cvt_pk_bf16(o[d][rr] * rs_ * gw_[d], 0.f) & 0xffffu);
                    if ((rr & 3) == 3) SBAR(); }
            }
        }
        __syncthreads();
    }
    SEAM(8);

    if (IN(9)) {
        unsigned char* ws = KWS(); float* ssq = (float*)(ws + WS_CTL + CTL_SSQ); bf16* XB = (bf16*)(ws + WS_XB); bf16* MIX = (bf16*)(ws + WS_MIX); bf16* HMID = (bf16*)(ws + WS_PROJ); bf16* PROJ = HMID;
        float* X = KOUT(); const float* x_prompt = KIN(0); const float* x_sample = KIN(1);
        bf16* WOE = (bf16*)(ws + WS_WOE); bf16* WIO = (bf16*)(ws + WS_WIO); bf16* WOO = (bf16*)(ws + WS_WOO);
        bf16* WGU0 = (bf16*)(ws + WS_WGU0); bf16* WGU1 = (bf16*)(ws + WS_WGU1); bf16* WD0 = (bf16*)(ws + WS_WD0); bf16* WD1 = (bf16*)(ws + WS_WD1);
        (void)ssq; (void)XB; (void)MIX; (void)HMID; (void)PROJ; (void)X; (void)x_prompt; (void)x_sample; (void)WOE; (void)WIO; (void)WOO; (void)WGU0; (void)WGU1; (void)WD0; (void)WD1;
        gm::GridOrder S; S.init(NTOK, DM, F.G, (int)blockIdx.x, MIX, (size_t)DM * 2, WOO, (size_t)DM * 2, X, DM, 4);
        gm::EpiResid E{x_prompt, x_sample, 0, X, XB, ssq + 3 * NTOK, 1};
        gm::gemm_phase(F.lds, F.wave, DM, DM, DM, S, E);
    }
    SEAM(9);
    if (IN(10)) {
        unsigned char* ws = KWS(); float* ssq = (float*)(ws + WS_CTL + CTL_SSQ); bf16* XB = (bf16*)(ws + WS_XB); bf16* MIX = (bf16*)(ws + WS_MIX); bf16* HMID = (bf16*)(ws + WS_PROJ); bf16* PROJ = HMID;
        float* X = KOUT(); const float* x_prompt = KIN(0); const float* x_sample = KIN(1);
        bf16* WOE = (bf16*)(ws + WS_WOE); bf16* WIO = (bf16*)(ws + WS_WIO); bf16* WOO = (bf16*)(ws + WS_WOO);
        bf16* WGU0 = (bf16*)(ws + WS_WGU0); bf16* WGU1 = (bf16*)(ws + WS_WGU1); bf16* WD0 = (bf16*)(ws + WS_WD0); bf16* WD1 = (bf16*)(ws + WS_WD1);
        (void)ssq; (void)XB; (void)MIX; (void)HMID; (void)PROJ; (void)X; (void)x_prompt; (void)x_sample; (void)WOE; (void)WIO; (void)WOO; (void)WGU0; (void)WGU1; (void)WD0; (void)WD1;
        gm::GridOrder S; S.init(NTOK, 2 * FF, F.G, (int)blockIdx.x, XB, (size_t)DM * 2, WGU1, (size_t)DM * 2, HMID, FF, 2);
        gm::EpiSwiglu E{ssq + 3 * NTOK, HMID};
        gm::gemm_phase(F.lds, F.wave, DM, DM, DM, S, E);
    }
    SEAM(10);
    if (IN(11)) {
        unsigned char* ws = KWS(); float* ssq = (float*)(ws + WS_CTL + CTL_SSQ); bf16* XB = (bf16*)(ws + WS_XB); bf16* MIX = (bf16*)(ws + WS_MIX); bf16* HMID = (bf16*)(ws + WS_PROJ); bf16* PROJ = HMID;
        float* X = KOUT(); const float* x_prompt = KIN(0); const float* x_sample = KIN(1);
        bf16* WOE = (bf16*)(ws + WS_WOE); bf16* WIO = (bf16*)(ws + WS_WIO); bf16* WOO = (bf16*)(ws + WS_WOO);
        bf16* WGU0 = (bf16*)(ws + WS_WGU0); bf16* WGU1 = (bf16*)(ws + WS_WGU1); bf16* WD0 = (bf16*)(ws + WS_WD0); bf16* WD1 = (bf16*)(ws + WS_WD1);
        (void)ssq; (void)XB; (void)MIX; (void)HMID; (void)PROJ; (void)X; (void)x_prompt; (void)x_sample; (void)WOE; (void)WIO; (void)WOO; (void)WGU0; (void)WGU1; (void)WD0; (void)WD1;
        gm::GridOrder S; S.init(NTOK, DM, F.G, (int)blockIdx.x, HMID, (size_t)FF * 2, WD1, (size_t)FF * 2, X, DM, 4);
        gm::EpiResid E{x_prompt, x_sample, 0, X, XB, ssq + 4 * NTOK, 0};
        gm::gemm_phase(F.lds, F.wave, FF, FF, FF, S, E);
    }
    SEAM(11);
    if (IN(12)) {
        float* X = KOUT(); const float* norm_final = KIN(18); float* ssq = (float*)(KWS() + WS_CTL + CTL_SSQ);
        const int gw = F.vcu * 8 + F.wave, NGW = F.G * 8, fl = lane_id_opaque();
        for (int m = gw; m < NTOK; m += NGW) {
            const float rs = __builtin_amdgcn_rsqf(ssq[4 * NTOK + m] * (1.0f / DM) + RMS_EPS);
            float* xr = X + (size_t)m * DM;
#pragma unroll 4
            for (int j = 0; j < 16; ++j) { const int cidx = j * 256 + fl * 4; const f32x4 v = *(const f32x4*)(xr + cidx); const f32x4 g = *(const f32x4*)(norm_final + cidx);
                *(f32x4*)(xr + cidx) = v * rs * g; }
        }
    }
#undef IN
#undef SEAM
}

extern "C" void kernel_launch(void* const* d_in, const int* in_sizes, int n_in, void* d_out, int out_size, void* d_ws, size_t ws_size, hipStream_t stream) {
    static int grid = 0;
    if (grid == 0) {
        if (n_in != 19 || out_size != NTOK * DM || ws_size < WS_END) { fprintf(stderr, "kernel_launch: unexpected shapes: n_in %d out %d ws %zu (need %zu)\n", n_in, out_size, ws_size, (size_t)WS_END); grid = -1; return; }
        int dev = 0, cus = 0, per_cu = 0;
        if (hipGetDevice(&dev) != hipSuccess || hipDeviceGetAttribute(&cus, hipDeviceAttributeMultiprocessorCount, dev) != hipSuccess) { grid = -1; return; }
        if (hipFuncSetAttribute((const void*)mega_fwd, hipFuncAttributeMaxDynamicSharedMemorySize, LDS_BYTES) != hipSuccess) { fprintf(stderr, "kernel_launch: hipFuncSetAttribute failed\n"); grid = -1; return; }
        if (hipOccupancyMaxActiveBlocksPerMultiprocessor(&per_cu, (const void*)mega_fwd, 512, LDS_BYTES) != hipSuccess || per_cu < 1)
            fprintf(stderr, "kernel_launch: occupancy query reports %d\n", per_cu);
        (void)hipGetLastError();
        grid = cus;
    }
    if (grid < 0) return;
    (void)hipMemsetAsync((char*)d_ws + WS_CTL, 0, CTL_ZERO_BYTES, stream);
    Args a{};
    for (int i = 0; i < 19; ++i) a.in[i] = (const float*)d_in[i];
    a.out = (float*)d_out; a.ws = (unsigned char*)d_ws;
    hipLaunchKernelGGL(mega_fwd, dim3(grid), dim3(512), LDS_BYTES, stream, a);
    const hipError_t le = hipPeekAtLastError();
    if (le != hipSuccess) fprintf(stderr, "kernel_launch: launch failed: %s\n", hipGetErrorName(le));
}
```

```cpp
#include <hip/hip_runtime.h>
#include <cstdio>
#include <cstdint>

#define GAS __attribute__((address_space(1)))
#define LAS __attribute__((address_space(3)))
typedef unsigned short bf16;
typedef short bf16x8 __attribute__((ext_vector_type(8)));
typedef short s16x4 __attribute__((ext_vector_type(4)));
typedef float f32x4 __attribute__((ext_vector_type(4)));
typedef float f32x16 __attribute__((ext_vector_type(16)));
typedef unsigned u32x4 __attribute__((ext_vector_type(4)));
typedef unsigned u32x2 __attribute__((ext_vector_type(2)));

constexpr int DM = 4096, NTOK = 24576, NTOK_P = 16384, FF = 11008;
constexpr int LDX = DM + 128;
constexpr int EVEN_IN = 8192, ODD_IN = 12288;
constexpr float RMS_EPS = 1e-6f, SUBLN_EPS = 1e-5f;
constexpr float LOG2E = 1.4426950408889634f;
constexpr float ATT_C = 0.088388347648318440f * LOG2E;
constexpr float LAM_INIT = 0.35550906759f;

constexpr size_t MiB = 1u << 20;
constexpr size_t WS_CTL = 0, CTL_ZERO_BYTES = 1 * MiB;
constexpr size_t WROW = (size_t)LDX * 2;
constexpr size_t WS_WIE = 2 * MiB, WS_WOE = WS_WIE + 8192 * WROW, WS_WIO = WS_WOE + 4096 * WROW, WS_WOO = WS_WIO + 12288 * WROW;
constexpr size_t WS_WGU0 = WS_WOO + 4096 * WROW, WS_WGU1 = WS_WGU0 + 22016 * WROW, WS_WD0 = WS_WGU1 + 22016 * WROW, WS_WD1 = WS_WD0 + 86 * MiB;
constexpr size_t WS_XB = WS_WD1 + 86 * MiB, WS_MIX = WS_XB + (size_t)NTOK * WROW, WS_PROJ = WS_MIX + (size_t)NTOK * WROW, WS_VT = WS_PROJ + 384 * MiB, WS_END = WS_PROJ + 576 * MiB;
static_assert(WS_END <= (size_t)1864 * MiB && WS_WGU0 % 256 == 0 && WS_XB % 256 == 0 && WS_PROJ % 256 == 0, "workspace map");
constexpr size_t DO_A8 = 0, DO_A2 = 256 * MiB, DO_FC = 272 * MiB;
constexpr int CW_BAR = 4096;
constexpr int CW_LAM = 64;
constexpr size_t CTL_SSQ = 65536;
static_assert(CTL_SSQ + 5 * (size_t)NTOK * 4 <= CTL_ZERO_BYTES, "ctl");

constexpr int RING_BYTES = 131072;
constexpr int EX_OFF = RING_BYTES, EX_MISC = EX_OFF, EX_WS = EX_OFF + 256, EX_TAB = EX_OFF + 2304;
constexpr int LDS_BYTES = 147456;

#define LDS_WAIT() asm volatile("s_waitcnt lgkmcnt(0)" ::: "memory")
#define VM_WAIT() asm volatile("s_waitcnt vmcnt(0)" ::: "memory")
#define SBAR() __builtin_amdgcn_sched_barrier(0)

__device__ __forceinline__ unsigned cvt_pk_bf16(float lo, float hi) { unsigned r; asm volatile("v_cvt_pk_bf16_f32 %0, %1, %2" : "=v"(r) : "v"(lo), "v"(hi)); return r; }

#define XB_TMO      128
#define XB_XCNT(j)  (256  + 64 * (j))
#define XB_XSUB(j)  (1280 + 64 * (j))
#define XB_XGEN(j)  (2304 + 64 * (j))
#define XB_TOP      3328
#define XB_TOPGEN   3392
#define XCD_BAR_WORDS 3456
#define XB_SPIN_CAP (1u << 20)
__device__ __forceinline__ unsigned xb_ld(unsigned* p)              { return __hip_atomic_load(p, __ATOMIC_RELAXED, __HIP_MEMORY_SCOPE_AGENT); }
__device__ __forceinline__ unsigned xb_add(unsigned* p, unsigned v) { return __hip_atomic_fetch_add(p, v, __ATOMIC_RELAXED, __HIP_MEMORY_SCOPE_AGENT); }
__device__ __forceinline__ unsigned xb_xcc_id() { return (unsigned)__builtin_amdgcn_s_getreg((3 << 11) | 20) & 0xFu; }
#define XB_SPIN(cond, bar) do { unsigned _sp = 0; while (cond) { __builtin_amdgcn_s_sleep(1); \
    if ((++_sp & 255u) == 0u) { if (xb_ld(&(bar)[XB_TMO])) break; if (_sp > XB_SPIN_CAP) { atomicAdd(&(bar)[XB_TMO], 1u); break; } } } } while (0)
struct XcdBarrier { unsigned* bar; unsigned x; volatile LAS unsigned* st; };
__device__ __forceinline__ XcdBarrier xcd_barrier_post(unsigned* bar, volatile LAS unsigned* st) {
    XcdBarrier b; b.bar = bar; b.x = xb_xcc_id(); b.st = st;
    if (threadIdx.x == 0) (void)xb_add(&bar[XB_XCNT(b.x)], 1u);
    return b;
}
__device__ __forceinline__ void xcd_barrier_complete(unsigned* bar, unsigned x, unsigned& nloc, unsigned& nx) {
    const unsigned G = gridDim.x * gridDim.y * gridDim.z;
    unsigned sum, cnt, mine, sp = 0u;
    for (;;) {
        sum = 0u; cnt = 0u; mine = 0u;
#pragma unroll
        for (unsigned j = 0; j < 16; ++j) { const unsigned c = xb_ld(&bar[XB_XCNT(j)]); sum += c; cnt += (c > 0u) ? 1u : 0u; mine = (j == x) ? c : mine; }
        if (sum == G) break;
        __builtin_amdgcn_s_sleep(1);
        if ((++sp & 255u) == 0u) { if (xb_ld(&bar[XB_TMO])) break; if (sp > XB_SPIN_CAP) { atomicAdd(&bar[XB_TMO], 1u); break; } }
    }
    nloc = mine > 0u ? mine : 1u; nx = cnt > 0u ? cnt : 1u;
}
__device__ __forceinline__ void xcd_barrier(const XcdBarrier& b) {
    asm volatile("s_waitcnt vmcnt(0)" ::: "memory");
    __syncthreads();
    if (threadIdx.x == 0) {
        unsigned* bar = b.bar;
        __builtin_amdgcn_s_waitcnt(0);
        unsigned nloc = b.st[0], nx = b.st[1];
        if (nloc == 0u) { xcd_barrier_complete(bar, b.x, nloc, nx); b.st[0] = nloc; b.st[1] = nx; }
        const unsigned old = xb_add(&bar[XB_XSUB(b.x)], 1u);
        const unsigned gen = old / nloc;
        if (old + 1u == (gen + 1u) * nloc) {
            __builtin_amdgcn_fence(__ATOMIC_RELEASE, "agent");
            asm volatile("s_waitcnt vmcnt(0)" ::: "memory");
            const unsigned og = xb_add(&bar[XB_TOP], 1u);
            const unsigned tg = og / nx;
            if (og + 1u == (tg + 1u) * nx) xb_add(&bar[XB_TOPGEN], 1u);
            else XB_SPIN(xb_ld(&bar[XB_TOPGEN]) == tg, bar);
            __builtin_amdgcn_fence(__ATOMIC_ACQUIRE, "agent");
            xb_add(&bar[XB_XGEN(b.x)], 1u);
            asm volatile("s_waitcnt vmcnt(0)" ::: "memory");
        } else {
            XB_SPIN(xb_ld(&bar[XB_XGEN(b.x)]) == gen, bar);
            __builtin_amdgcn_fence(__ATOMIC_ACQUIRE, "agent");
            asm volatile("s_waitcnt vmcnt(0)" ::: "memory");
        }
    }
    __syncthreads();
}

__device__ __forceinline__ int lane_id_opaque() { int l = (int)__builtin_amdgcn_mbcnt_hi(~0u, __builtin_amdgcn_mbcnt_lo(~0u, 0u)); asm volatile("" : "+v"(l)); return l & 63; }

namespace gm {
constexpr int BM = 256, BK = 64, HALF = 128, HTB = HALF * BK * 2, NXCD = 8, WGM = 8;
__host__ __device__ __forceinline__ int lds_byte(int r, int c) { const int st = (r >> 4) * 2 + (c >> 5), rr = r & 15, cc = c & 31, ob = rr * 64 + cc * 2; return st * 1024 + (ob ^ (((ob >> 9) & 1) << 5)); }
__host__ __device__ __forceinline__ void stage_rc(int b, int& R, int& C) { const int st = b / 1024, sb = b % 1024, swz = sb ^ (((sb >> 9) & 1) << 5); R = (st >> 1) * 16 + swz / 64; C = (st & 1) * 32 + (swz % 64) / 2; }
__host__ __device__ __forceinline__ int perm32(int rho) { const int n = rho >> 4, i = rho & 15; return 8 * (i >> 2) + 4 * n + (i & 3); }

struct Unit { const char* A; const char* B; char* C; int ldc; int row0; int col0; };

struct GridOrder {
    int nM, nN, nwg, G, c; const char* A; const char* B; char* C; size_t atile, btile; int ldc, esz;
    __device__ __forceinline__ void init(int M, int N, int G_, int c_, const void* A_, size_t lda_bytes, const void* B_, size_t ldb_bytes, void* C_, int ldc_, int esz_) {
        nM = M / BM; nN = N / BM; nwg = nM * nN; G = G_; c = c_; A = (const char*)A_; B = (const char*)B_; C = (char*)C_; atile = lda_bytes * BM; btile = ldb_bytes * BM; ldc = ldc_; esz = esz_; }
    __device__ __forceinline__ bool next(int i, Unit& u) const {
        const long L = (long)i * G + c; if (L >= nwg) return false;
        int wgid = (int)L; { const int q = nwg / NXCD, r = nwg % NXCD, xcd = wgid % NXCD, off = wgid / NXCD; wgid = (xcd < r ? xcd * (q + 1) : r * (q + 1) + (xcd - r) * q) + off; }
        const int nig = WGM * nN, gid = wgid / nig, fm = gid * WGM, gsz = (nM - fm) < WGM ? (nM - fm) : WGM;
        const int pm = fm + ((wgid % nig) % gsz), pn = (wgid % nig) / gsz;
        u.A = A + (size_t)pm * atile; u.B = B + (size_t)pn * btile; u.row0 = pm * BM; u.col0 = pn * BM; u.ldc = ldc;
        u.C = C + ((size_t)u.row0 * ldc + u.col0) * esz; return true;
    }
};

__device__ __forceinline__ void load_rstd8(float (&rs)[8], const float* ssq, int row0, int wr, int fr, float scale) {
    if (ssq) {
#pragma unroll
        for (int g = 0; g < 8; ++g) rs[g] = ssq[row0 + (g >> 2) * HALF + wr * 64 + (g & 3) * 16 + fr];
#pragma unroll
        for (int g = 0; g < 8; ++g) rs[g] = __builtin_amdgcn_rsqf(rs[g] * (1.0f / DM) + RMS_EPS) * scale;
    } else {
#pragma unroll
        for (int g = 0; g < 8; ++g) rs[g] = scale;
    }
}
struct EpiBf16 {
    static constexpr bool PERM = true;
    const float* ssq; float scale;
    __device__ __forceinline__ void operator()(const f32x4 (&acc)[2][2][4][2], const Unit& u, int wr, int wc, int fr, int fq) const {
        bf16* base = (bf16*)u.C + wc * 32 + 8 * fq;
        float rs[8]; load_rstd8(rs, ssq, u.row0, wr, fr, scale);
#pragma unroll
        for (int ai = 0; ai < 2; ++ai)
#pragma unroll
            for (int m = 0; m < 4; ++m) { int r = ai * HALF + wr * 64 + m * 16 + fr; asm volatile("" : "+v"(r));
                const float s = rs[ai * 4 + m];
                bf16* rowp = base + (size_t)r * u.ldc;
#pragma unroll
                for (int bj = 0; bj < 2; ++bj) { const f32x4 v0 = acc[ai][bj][m][0] * s, v1 = acc[ai][bj][m][1] * s;
                    u32x4 w; w.x = cvt_pk_bf16(v0[0], v0[1]); w.y = cvt_pk_bf16(v0[2], v0[3]); w.z = cvt_pk_bf16(v1[0], v1[1]); w.w = cvt_pk_bf16(v1[2], v1[3]);
                    *(u32x4*)(rowp + bj * HALF) = w; } }
    }
};
struct EpiSwiglu {
    static constexpr bool PERM = true;
    const float* ssq; bf16* H;
    __device__ __forceinline__ void operator()(const f32x4 (&acc)[2][2][4][2], const Unit& u, int wr, int wc, int fr, int fq) const {
        bf16* base = H + (size_t)u.row0 * FF + (u.col0 >> 1) + wc * 32 + 8 * fq;
        float rs[8]; load_rstd8(rs, ssq, u.row0, wr, fr, 1.0f);
#pragma unroll
        for (int ai = 0; ai < 2; ++ai)
#pragma unroll
            for (int m = 0; m < 4; ++m) { int r = ai * HALF + wr * 64 + m * 16 + fr; asm volatile("" : "+v"(r));
                const float s = rs[ai * 4 + m];
                float hv[8];
#pragma unroll
                for (int n = 0; n < 2; ++n)
#pragma unroll
                    for (int j = 0; j < 4; ++j) { const float g = acc[ai][0][m][n][j] * s, up = acc[ai][1][m][n][j] * s;
                        const float e = __builtin_amdgcn_exp2f(-g * LOG2E); hv[n * 4 + j] = g * __builtin_amdgcn_rcpf(1.0f + e) * up; }
                u32x4 w; w.x = cvt_pk_bf16(hv[0], hv[1]); w.y = cvt_pk_bf16(hv[2], hv[3]); w.z = cvt_pk_bf16(hv[4], hv[5]); w.w = cvt_pk_bf16(hv[6], hv[7]);
                *(u32x4*)(base + (size_t)r * FF) = w; }
    }
};
struct EpiResid {
    static constexpr bool PERM = false;
    const float* xp; const float* xs; int from_input;
    float* X; bf16* XB; float* ssq; int write_xb;
    __device__ __forceinline__ void operator()(const f32x4 (&acc)[2][2][4][2], const Unit& u, int wr, int wc, int fr, int fq) const {
        const float* rbase = from_input ? (u.row0 < NTOK_P ? xp + (size_t)u.row0 * DM : xs + (size_t)(u.row0 - NTOK_P) * DM) : X + (size_t)u.row0 * DM;
        const int c0 = u.col0 + wc * 32 + 4 * fq;
        f32x4 rv[4], rn[4];
        { int r = wr * 64 + fr; asm volatile("" : "+v"(r)); const unsigned off = (unsigned)r * DM + c0;
#pragma unroll
          for (int q = 0; q < 4; ++q) rv[q] = *(const f32x4*)(rbase + off + (q >> 1) * HALF + (q & 1) * 16); }
#pragma unroll
        for (int g = 0; g < 8; ++g) { const int ai = g >> 2, m = g & 3;
            if (g < 7) { int r2 = ((g + 1) >> 2) * HALF + wr * 64 + ((g + 1) & 3) * 16 + fr; asm volatile("" : "+v"(r2)); const unsigned off2 = (unsigned)r2 * DM + c0;
#pragma unroll
                for (int q = 0; q < 4; ++q) rn[q] = *(const f32x4*)(rbase + off2 + (q >> 1) * HALF + (q & 1) * 16); }
            int r = ai * HALF + wr * 64 + m * 16 + fr; asm volatile("" : "+v"(r));
            const unsigned off = (unsigned)r * DM + c0, offx = (unsigned)r * LDX + c0;
            float s = 0.f;
#pragma unroll
            for (int bj = 0; bj < 2; ++bj)
#pragma unroll
                for (int n = 0; n < 2; ++n) { const f32x4 v = rv[bj * 2 + n] + acc[ai][bj][m][n];
                    *(f32x4*)(X + (size_t)u.row0 * DM + off + bj * HALF + n * 16) = v;
                    s += (v[0] * v[0] + v[1] * v[1]) + (v[2] * v[2] + v[3] * v[3]);
                    if (write_xb) { u32x2 w; w.x = cvt_pk_bf16(v[0], v[1]); w.y = cvt_pk_bf16(v[2], v[3]); *(u32x2*)(XB + (size_t)u.row0 * LDX + offx + bj * HALF + n * 16) = w; } }
            s += __shfl_xor(s, 16); s += __shfl_xor(s, 32);
            if (fq == 0) unsafeAtomicAdd(ssq + u.row0 + r, s);
#pragma unroll
            for (int q = 0; q < 4; ++q) rv[q] = rn[q];
        }
    }
};

template <class Epi, class Sched>
__device__ __forceinline__ void gemm_phase(LAS unsigned char* lds, const int wave, const int K, const int lda, const int ldb, const Sched& S, const Epi& E) {
    const int lane = lane_id_opaque(), wid = wave, tid = wid * 64 + lane, wr = wid >> 2, wc = wid & 3, fr = lane & 15, fq = lane >> 4;
    const int nt = K / BK;
    unsigned voffA[2], voffB[2];
#pragma unroll
    for (int i = 0; i < 2; ++i) { int R, C; stage_rc(tid * 16 + i * 8192, R, C); const int Rb = Epi::PERM ? ((R & ~31) + perm32(R & 31)) : R;
        voffA[i] = (unsigned)(R * lda + C) * 2u; voffB[i] = (unsigned)(Rb * ldb + C) * 2u; }
    const size_t kstep = (size_t)(BK * 2);
    const size_t hstepA = (size_t)HALF * lda * 2, hstepB = (size_t)HALF * ldb * 2;
    const unsigned ldsw = (unsigned)wid * 1024u;
    const int aoff = lds_byte(wr * 64 + fr, fq * 8), boff = lds_byte(wc * 32 + fr, fq * 8);
#define PG8_SA(b, h) (((b) * 2 + (h)) * HTB)
#define PG8_SB(b, h) ((4 + (b) * 2 + (h)) * HTB)
#define PG8_STAGE(bufoff, gbase, voff) do { _Pragma("unroll") for (int _i = 0; _i < 2; ++_i) \
        __builtin_amdgcn_global_load_lds((const unsigned*)((const char*)(gbase) + (voff)[_i]), (LAS unsigned*)(lds + (bufoff) + ldsw + _i * 8192), 16, 0, 0); } while (0)
#define PG8_LDA(dst, b, h) do { _Pragma("unroll") for (int m = 0; m < 4; ++m) _Pragma("unroll") for (int k = 0; k < 2; ++k) dst[m][k] = *(const LAS bf16x8*)(lds + PG8_SA(b, h) + aoff + m * 2048 + k * 1024); } while (0)
#define PG8_LDB(dst, b, h) do { _Pragma("unroll") for (int n = 0; n < 2; ++n) _Pragma("unroll") for (int k = 0; k < 2; ++k) dst[n][k] = *(const LAS bf16x8*)(lds + PG8_SB(b, h) + boff + n * 2048 + k * 1024); } while (0)
#define PG8_MMA(ai, bj, At, Bt) do { __builtin_amdgcn_s_setprio(1); _Pragma("unroll") for (int m = 0; m < 4; ++m) _Pragma("unroll") for (int n = 0; n < 2; ++n) _Pragma("unroll") for (int k = 0; k < 2; ++k) \
        acc[ai][bj][m][n] = __builtin_amdgcn_mfma_f32_16x16x32_bf16(Bt[n][k], At[m][k], acc[ai][bj][m][n], 0, 0, 0); __builtin_amdgcn_s_setprio(0); } while (0)
#define PG8_WAIT_V(n) asm volatile("s_waitcnt vmcnt(" #n ")" ::: "memory")
#define PG8_WAIT_L(n) asm volatile("s_waitcnt lgkmcnt(" #n ")" ::: "memory")
#define PG8_BAR __builtin_amdgcn_s_barrier()
#define PG8_SCHED __builtin_amdgcn_sched_barrier(0)
    Unit cur, nxt; int ui = 0;
    if (!S.next(0, cur)) return;
    f32x4 acc[2][2][4][2];
#pragma unroll
    for (int a = 0; a < 2; ++a)
#pragma unroll
        for (int b = 0; b < 2; ++b)
#pragma unroll
            for (int m = 0; m < 4; ++m)
#pragma unroll
                for (int n = 0; n < 2; ++n) acc[a][b][m][n] = (f32x4){0.f, 0.f, 0.f, 0.f};
    bf16x8 At[4][2], B0[2][2], B1[2][2];
    const char* cA = cur.A; const char* cB = cur.B;
    PG8_STAGE(PG8_SB(0, 0), cB, voffB); PG8_STAGE(PG8_SB(0, 1), cB + hstepB, voffB); PG8_STAGE(PG8_SA(0, 0), cA, voffA); PG8_STAGE(PG8_SA(0, 1), cA + hstepA, voffA);
    if (wr == 1) PG8_BAR;
    PG8_WAIT_V(2); PG8_BAR;
    PG8_STAGE(PG8_SB(1, 0), cB + kstep, voffB); PG8_STAGE(PG8_SA(1, 0), cA + kstep, voffA); PG8_STAGE(PG8_SB(1, 1), cB + hstepB + kstep, voffB);
    PG8_WAIT_V(6); PG8_BAR;
    for (;;) {
        const bool has_next = S.next(ui + 1, nxt);
        const char* nA = has_next ? nxt.A : cA; const char* nB = has_next ? nxt.B : cB;
        for (int t = 0; t < nt; t += 2) {
            const bool last = (t == nt - 2);
            const char* a1 = cA + (size_t)(t + 1) * kstep;
            const char* a2 = last ? nA : cA + (size_t)(t + 2) * kstep; const char* b2 = last ? nB : cB + (size_t)(t + 2) * kstep;
            const char* a3 = a2 + kstep; const char* b3 = b2 + kstep;
            PG8_LDB(B0, 0, 0); PG8_LDB(B1, 0, 1); PG8_SCHED; PG8_LDA(At, 0, 0); PG8_STAGE(PG8_SA(1, 1), a1 + hstepA, voffA);
            PG8_WAIT_V(8); PG8_WAIT_L(0); PG8_BAR; PG8_MMA(0, 0, At, B0); PG8_MMA(0, 1, At, B1); PG8_BAR; PG8_SCHED;
            PG8_LDA(At, 0, 1); PG8_STAGE(PG8_SB(0, 0), b2, voffB); PG8_STAGE(PG8_SB(0, 1), b2 + hstepB, voffB); PG8_STAGE(PG8_SA(0, 0), a2, voffA);
            PG8_WAIT_V(8); PG8_WAIT_L(0); PG8_BAR; PG8_MMA(1, 0, At, B0); PG8_MMA(1, 1, At, B1); PG8_BAR; PG8_SCHED;
            PG8_LDB(B0, 1, 0); PG8_LDB(B1, 1, 1); PG8_SCHED; PG8_LDA(At, 1, 0); PG8_STAGE(PG8_SA(0, 1), a2 + hstepA, voffA);
            PG8_WAIT_V(8); PG8_WAIT_L(0); PG8_BAR; PG8_MMA(0, 0, At, B0); PG8_MMA(0, 1, At, B1); PG8_BAR; PG8_SCHED;
            PG8_LDA(At, 1, 1); PG8_STAGE(PG8_SB(1, 0), b3, voffB); PG8_STAGE(PG8_SB(1, 1), b3 + hstepB, voffB); PG8_STAGE(PG8_SA(1, 0), a3, voffA);
            PG8_WAIT_V(8); PG8_WAIT_L(0); PG8_BAR; PG8_MMA(1, 0, At, B0); PG8_MMA(1, 1, At, B1); PG8_BAR; PG8_SCHED;
        }
        if (wr == 0) PG8_BAR;
        E(acc, cur, wr, wc, fr, fq);
        if (!has_next) break;
#pragma unroll
        for (int a = 0; a < 2; ++a)
#pragma unroll
            for (int b = 0; b < 2; ++b)
#pragma unroll
                for (int m = 0; m < 4; ++m)
#pragma unroll
                    for (int n = 0; n < 2; ++n) acc[a][b][m][n] = (f32x4){0.f, 0.f, 0.f, 0.f};
        cur = nxt; cA = nA; cB = nB; ++ui;
        if (wr == 1) PG8_BAR;
    }
    PG8_WAIT_V(0);
    PG8_BAR;
#undef PG8_SA
#undef PG8_SB
#undef PG8_STAGE
#undef PG8_LDA
#undef PG8_LDB
#undef PG8_MMA
#undef PG8_WAIT_V
#undef PG8_WAIT_L
#undef PG8_BAR
#undef PG8_SCHED
}
}

struct Frame {
    LAS unsigned char* lds;
    int wave, vcu, G;
};
struct SeqInfo { int row0, S; };
__device__ __forceinline__ SeqInfo seq_info(int q) { SeqInfo s; if (q < 2) { s.row0 = q * 8192; s.S = 8192; } else { s.row0 = NTOK_P + (q - 2) * 2048; s.S = 2048; } return s; }

__device__ __forceinline__ float wave_sum(float v) {
#pragma unroll
    for (int o = 1; o < 64; o <<= 1) v += __shfl_xor(v, o);
    return v;
}

__device__ __forceinline__ void p0_item(const float* W, int K, int N, const float* g, bf16* WT, int ldw, int k0, int n0, int drow0, LAS float* scr, int lane) {
    const int n4 = (lane & 7) * 4;
#pragma unroll
    for (int i = 0; i < 8; ++i) { const int kk = (lane >> 3) + 8 * i;
        f32x4 v = *(const f32x4*)(W + (size_t)(k0 + kk) * N + n0 + n4);
        if (g) v = v * g[k0 + kk];
        scr[kk * 33 + n4 + 0] = v[0]; scr[kk * 33 + n4 + 1] = v[1]; scr[kk * 33 + n4 + 2] = v[2]; scr[kk * 33 + n4 + 3] = v[3]; }
    LDS_WAIT(); asm volatile("" ::: "memory");
    const int c = lane & 7;
#pragma unroll
    for (int j = 0; j < 4; ++j) { const int n = (lane >> 3) + 8 * j; const LAS float* s = scr + (8 * c) * 33 + n;
        u32x4 o; o.x = cvt_pk_bf16(s[0 * 33], s[1 * 33]); o.y = cvt_pk_bf16(s[2 * 33], s[3 * 33]); o.z = cvt_pk_bf16(s[4 * 33], s[5 * 33]); o.w = cvt_pk_bf16(s[6 * 33], s[7 * 33]);
        *(u32x4*)(WT + (size_t)(drow0 + n) * ldw + k0 + 8 * c) = o; }
    LDS_WAIT(); asm volatile("" ::: "memory");
}
struct WJob { const float* W; const float* g; bf16* WT; int K, N, mode; };

#define KSWZ(row, colB) ((row) * 256 + ((colB) ^ (((row) & 7) << 4)))
__device__ __forceinline__ int crow(int r, int hi) { return (r & 3) + 8 * (r >> 2) + 4 * hi; }
__device__ __forceinline__ int swap23(int k) { return (k & ~0xC) | ((k & 4) << 1) | ((k & 8) >> 1); }
__device__ __forceinline__ int v_rd_base(int lane) { return ((lane & 3) << 3) | (((lane >> 2) & 3) << 6) | (((lane >> 4) & 1) << 5) | (((lane >> 5) & 1) << 8); }
template <int OFF> __device__ __forceinline__ s16x4 tr_read(unsigned vb) {
    s16x4 r; asm volatile("ds_read_b64_tr_b16 %0, %1 offset:%2" : "=&v"(r) : "v"(vb), "i"(OFF) : "memory"); return r;
}
__device__ __forceinline__ void qkt(f32x16& p0, f32x16& p1, const LAS unsigned char* Ks, const bf16x8 (&qr)[8], int r32, int hi) {
    p0 = (f32x16){0.f, 0.f, 0.f, 0.f, 0.f, 0.f, 0.f, 0.f, 0.f, 0.f, 0.f, 0.f, 0.f, 0.f, 0.f, 0.f}; p1 = p0;
    const LAS unsigned char* k0p = Ks + r32 * 256; const LAS unsigned char* k1p = Ks + (32 + r32) * 256; const int sw = (r32 & 7) << 4;
    bf16x8 a0 = *(const LAS bf16x8*)(k0p + ((hi * 16) ^ sw)), a1 = *(const LAS bf16x8*)(k1p + ((hi * 16) ^ sw));
#pragma unroll
    for (int d0 = 0; d0 < 8; ++d0) {
        bf16x8 n0 = a0, n1 = a1;
        if (d0 < 7) { const int cb = ((d0 + 1) * 32 + hi * 16) ^ sw; n0 = *(const LAS bf16x8*)(k0p + cb); n1 = *(const LAS bf16x8*)(k1p + cb); }
        p0 = __builtin_amdgcn_mfma_f32_32x32x16_bf16(a0, qr[d0], p0, 0, 0, 0);
        p1 = __builtin_amdgcn_mfma_f32_32x32x16_bf16(a1, qr[d0], p1, 0, 0, 0);
        a0 = n0; a1 = n1;
        SBAR();
    }
}
template <int D0, int NCB> __device__ __forceinline__ void pv_one(f32x16& od, unsigned vb, bf16x8 pa0, bf16x8 pa1, bf16x8 pa2, bf16x8 pa3) {
#define VRO(ks, half) (D0 * 512 + (ks) * (NCB * 1024) + (half) * (NCB * 512))
    const s16x4 l0 = tr_read<VRO(0, 0)>(vb), h0 = tr_read<VRO(0, 1)>(vb), l1 = tr_read<VRO(1, 0)>(vb), h1 = tr_read<VRO(1, 1)>(vb);
    const s16x4 l2 = tr_read<VRO(2, 0)>(vb), h2 = tr_read<VRO(2, 1)>(vb), l3 = tr_read<VRO(3, 0)>(vb), h3 = tr_read<VRO(3, 1)>(vb);
#undef VRO
    asm volatile("s_waitcnt lgkmcnt(0)" ::: "memory"); SBAR();
#define PK(L, H) (bf16x8){L[0], L[1], L[2], L[3], H[0], H[1], H[2], H[3]}
    od = __builtin_amdgcn_mfma_f32_32x32x16_bf16(pa0, PK(l0, h0), od, 0, 0, 0);
    od = __builtin_amdgcn_mfma_f32_32x32x16_bf16(pa1, PK(l1, h1), od, 0, 0, 0);
    od = __builtin_amdgcn_mfma_f32_32x32x16_bf16(pa2, PK(l2, h2), od, 0, 0, 0);
    od = __builtin_amdgcn_mfma_f32_32x32x16_bf16(pa3, PK(l3, h3), od, 0, 0, 0);
#undef PK
}
__device__ __forceinline__ void softmax_tile(f32x16& p0, f32x16& p1, float& m_reg, float& l_reg, float& alpha, bf16x8& pa0, bf16x8& pa1, bf16x8& pa2, bf16x8& pa3) {
    float pmax = p0[0];
#pragma unroll
    for (int r = 1; r < 16; ++r) pmax = fmaxf(pmax, p0[r]);
#pragma unroll
    for (int r = 0; r < 16; ++r) pmax = fmaxf(pmax, p1[r]);
    { auto rr = __builtin_amdgcn_permlane32_swap(__float_as_uint(pmax), __float_as_uint(pmax), false, false);
      pmax = fmaxf(__uint_as_float(rr[0]), __uint_as_float(rr[1])); }
    if (__all(pmax - m_reg <= 6.0f)) { alpha = 1.0f; }
    else { const float mn_ = fmaxf(m_reg, pmax); alpha = __builtin_amdgcn_exp2f(m_reg - mn_); m_reg = mn_; }
    const float mn = m_reg;
#pragma unroll
    for (int r = 0; r < 16; ++r) p0[r] = __builtin_amdgcn_exp2f(p0[r] - mn);
#pragma unroll
    for (int r = 0; r < 16; ++r) p1[r] = __builtin_amdgcn_exp2f(p1[r] - mn);
    float ps = 0.f;
#pragma unroll
    for (int r = 0; r < 16; ++r) ps += p0[r];
#pragma unroll
    for (int r = 0; r < 16; ++r) ps += p1[r];
    { auto rr = __builtin_amdgcn_permlane32_swap(__float_as_uint(ps), __float_as_uint(ps), false, false);
      ps = __uint_as_float(rr[0]) + __uint_as_float(rr[1]); }
    l_reg = l_reg * alpha + ps;
#define PK4(P, BASE, OUT) do { unsigned a0 = cvt_pk_bf16(P[BASE + 0], P[BASE + 1]), a1 = cvt_pk_bf16(P[BASE + 2], P[BASE + 3]);   \
    unsigned b0 = cvt_pk_bf16(P[BASE + 4], P[BASE + 5]), b1 = cvt_pk_bf16(P[BASE + 6], P[BASE + 7]);                              \
    auto r0 = __builtin_amdgcn_permlane32_swap(a0, b0, false, false); auto r1 = __builtin_amdgcn_permlane32_swap(a1, b1, false, false); \
    u32x4 w = {r0[0], r1[0], r0[1], r1[1]}; OUT = *reinterpret_cast<bf16x8*>(&w); } while (0)
    PK4(p0, 0, pa0); PK4(p0, 8, pa1); PK4(p1, 0, pa2); PK4(p1, 8, pa3);
#undef PK4
}
constexpr float SM_THR = 6.0f;
__device__ __forceinline__ void softmax_far(f32x16& p0, f32x16& p1, const float b, float& m_reg, float& l_reg, float& alpha, bf16x8& pa0, bf16x8& pa1, bf16x8& pa2, bf16x8& pa3) {
    float pmax = p0[0];
#pragma unroll
    for (int r = 1; r < 16; ++r) pmax = fmaxf(pmax, p0[r]);
#pragma unroll
    for (int r = 0; r < 16; ++r) pmax = fmaxf(pmax, p1[r]);
    { auto rr = __builtin_amdgcn_permlane32_swap(__float_as_uint(pmax), __float_as_uint(pmax), false, false);
      pmax = fmaxf(__uint_as_float(rr[0]), __uint_as_float(rr[1])); }
    const float pm = fmaf(pmax, ATT_C, b);
    if (__all(pm - m_reg <= SM_THR)) { alpha = 1.0f; }
    else { const float mn = fmaxf(m_reg, pm); alpha = __builtin_amdgcn_exp2f(m_reg - mn); m_reg = mn; }
    const float c = b - m_reg;
#pragma unroll
    for (int r = 0; r < 16; ++r) p0[r] = __builtin_amdgcn_exp2f(fmaf(p0[r], ATT_C, c));
#pragma unroll
    for (int r = 0; r < 16; ++r) p1[r] = __builtin_amdgcn_exp2f(fmaf(p1[r], ATT_C, c));
    float ps = 0.f;
#pragma unroll
    for (int r = 0; r < 16; ++r) ps += p0[r];
#pragma unroll
    for (int r = 0; r < 16; ++r) ps += p1[r];
    { auto rr = __builtin_amdgcn_permlane32_swap(__float_as_uint(ps), __float_as_uint(ps), false, false);
      ps = __uint_as_float(rr[0]) + __uint_as_float(rr[1]); }
    l_reg = l_reg * alpha + ps;
#define PK4(P, BASE, OUT) do { unsigned a0 = cvt_pk_bf16(P[BASE + 0], P[BASE + 1]), a1 = cvt_pk_bf16(P[BASE + 2], P[BASE + 3]);   \
    unsigned b0 = cvt_pk_bf16(P[BASE + 4], P[BASE + 5]), b1 = cvt_pk_bf16(P[BASE + 6], P[BASE + 7]);                              \
    auto r0 = __builtin_amdgcn_permlane32_swap(a0, b0, false, false); auto r1 = __builtin_amdgcn_permlane32_swap(a1, b1, false, false); \
    u32x4 w = {r0[0], r1[0], r0[1], r1[1]}; OUT = *reinterpret_cast<bf16x8*>(&w); } while (0)
    PK4(p0, 0, pa0); PK4(p0, 8, pa1); PK4(p1, 0, pa2); PK4(p1, 8, pa3);
#undef PK4
}
__device__ __forceinline__ bf16x8 lds_rd128(unsigned a) { bf16x8 r; asm volatile("ds_read_b128 %0, %1" : "=&v"(r) : "v"(a) : "memory"); return r; }
__device__ __forceinline__ void qkt_h(f32x16& p, const LAS unsigned char* Ks32, const bf16x8 (&qr)[8], int r32, int hi) {
    p = (f32x16){0.f, 0.f, 0.f, 0.f, 0.f, 0.f, 0.f, 0.f, 0.f, 0.f, 0.f, 0.f, 0.f, 0.f, 0.f, 0.f};
    const unsigned kb = (unsigned)(uintptr_t)Ks32 + (unsigned)r32 * 256u; const unsigned sw = (unsigned)(r32 & 7) << 4, h16 = (unsigned)hi * 16u;
#define KA(d0) (kb + ((((unsigned)(d0)) * 32u + h16) ^ sw))
#define WTK(N, F) asm volatile("s_waitcnt lgkmcnt(" #N ")" : "+v"(F) :: "memory")
#define MMK(F, d0) p = __builtin_amdgcn_mfma_f32_32x32x16_bf16(F, qr[d0], p, 0, 0, 0)
    bf16x8 f0 = lds_rd128(KA(0)), f1 = lds_rd128(KA(1)), f2 = lds_rd128(KA(2));
    WTK(2, f0); MMK(f0, 0); f0 = lds_rd128(KA(3));
    WTK(2, f1); MMK(f1, 1); f1 = lds_rd128(KA(4));
    WTK(2, f2); MMK(f2, 2); f2 = lds_rd128(KA(5));
    WTK(2, f0); MMK(f0, 3); f0 = lds_rd128(KA(6));
    WTK(2, f1); MMK(f1, 4); f1 = lds_rd128(KA(7));
    WTK(2, f2); MMK(f2, 5);
    WTK(1, f0); MMK(f0, 6);
    WTK(0, f1); MMK(f1, 7);
#undef KA
#undef WTK
#undef MMK
}
#define PK4H(P, BASE, OUT) do { unsigned a0_ = cvt_pk_bf16(P[BASE + 0], P[BASE + 1]), a1_ = cvt_pk_bf16(P[BASE + 2], P[BASE + 3]);   \
    unsigned b0_ = cvt_pk_bf16(P[BASE + 4], P[BASE + 5]), b1_ = cvt_pk_bf16(P[BASE + 6], P[BASE + 7]);                              \
    auto r0_ = __builtin_amdgcn_permlane32_swap(a0_, b0_, false, false); auto r1_ = __builtin_amdgcn_permlane32_swap(a1_, b1_, false, false); \
    u32x4 w_ = {r0_[0], r1_[0], r0_[1], r1_[1]}; OUT = *reinterpret_cast<bf16x8*>(&w_); } while (0)
__device__ __forceinline__ void sm_tail_h(f32x16& p, const float alpha, float& l_reg, bf16x8& pa0, bf16x8& pa1) {
#pragma unroll
    for (int r = 0; r < 16; ++r) p[r] = __builtin_amdgcn_exp2f(p[r]);
    float ps = 0.f;
#pragma unroll
    for (int r = 0; r < 16; ++r) ps += p[r];
    { auto rr = __builtin_amdgcn_permlane32_swap(__float_as_uint(ps), __float_as_uint(ps), false, false);
      ps = __uint_as_float(rr[0]) + __uint_as_float(rr[1]); }
    l_reg = l_reg * alpha + ps;
    PK4H(p, 0, pa0); PK4H(p, 8, pa1);
}
__device__ __forceinline__ float rowmax_h(const f32x16& p) {
    float pmax = p[0];
#pragma unroll
    for (int r = 1; r < 16; ++r) pmax = fmaxf(pmax, p[r]);
    auto rr = __builtin_amdgcn_permlane32_swap(__float_as_uint(pmax), __float_as_uint(pmax), false, false);
    return fmaxf(__uint_as_float(rr[0]), __uint_as_float(rr[1]));
}
__device__ __forceinline__ float sm_decide(const float pm, float& m_reg) {
    if (__all(pm - m_reg <= SM_THR)) return 1.0f;
    const float mn = fmaxf(m_reg, pm); const float alpha = __builtin_amdgcn_exp2f(m_reg - mn); m_reg = mn; return alpha;
}
__device__ __forceinline__ void softmax_far_h(f32x16& p, const float b, float& m_reg, float& l_reg, float& alpha, bf16x8& pa0, bf16x8& pa1) {
    const float pm = fmaf(rowmax_h(p), ATT_C, b);
    alpha = sm_decide(pm, m_reg);
    const float c = b - m_reg;
#pragma unroll
    for (int r = 0; r < 16; ++r) p[r] = fmaf(p[r], ATT_C, c);
    sm_tail_h(p, alpha, l_reg, pa0, pa1);
}
__device__ __forceinline__ void softmax_near_h(f32x16& p, float& m_reg, float& l_reg, float& alpha, bf16x8& pa0, bf16x8& pa1) {
    alpha = sm_decide(rowmax_h(p), m_reg);
#pragma unroll
    for (int r = 0; r < 16; ++r) p[r] = p[r] - m_reg;
    sm_tail_h(p, alpha, l_reg, pa0, pa1);
}
template <int D0, int NCB, int HF> __device__ __forceinline__ void pv_half(f32x16& od, unsigned vb, bf16x8 pa0, bf16x8 pa1) {
#define VRO(ks, half) (D0 * 512 + (ks) * (NCB * 1024) + (half) * (NCB * 512))
    const s16x4 l0 = tr_read<VRO(2 * HF, 0)>(vb), h0 = tr_read<VRO(2 * HF, 1)>(vb), l1 = tr_read<VRO(2 * HF + 1, 0)>(vb), h1 = tr_read<VRO(2 * HF + 1, 1)>(vb);
#undef VRO
    asm volatile("s_waitcnt lgkmcnt(0)" ::: "memory"); SBAR();
#define PK(L, H) (bf16x8){L[0], L[1], L[2], L[3], H[0], H[1], H[2], H[3]}
    od = __builtin_amdgcn_mfma_f32_32x32x16_bf16(pa0, PK(l0, h0), od, 0, 0, 0);
    od = __builtin_amdgcn_mfma_f32_32x32x16_bf16(pa1, PK(l1, h1), od, 0, 0, 0);
#undef PK
}
template <int HF> __device__ __forceinline__ void pv_half8(f32x16 (&o)[8], unsigned vb, bf16x8 pa0, bf16x8 pa1) {
#define VRO(d0, ks, half) ((d0) * 512 + (ks) * (8 * 1024) + (half) * (8 * 512))
#define RD4(d0, A, B, C, D) do { A = tr_read<VRO(d0, 2 * HF, 0)>(vb); B = tr_read<VRO(d0, 2 * HF, 1)>(vb); C = tr_read<VRO(d0, 2 * HF + 1, 0)>(vb); D = tr_read<VRO(d0, 2 * HF + 1, 1)>(vb); } while (0)
#define PK(L, H) (bf16x8){L[0], L[1], L[2], L[3], H[0], H[1], H[2], H[3]}
#define MM(d0, A, B, C, D) do { o[d0] = __builtin_amdgcn_mfma_f32_32x32x16_bf16(pa0, PK(A, B), o[d0], 0, 0, 0); o[d0] = __builtin_amdgcn_mfma_f32_32x32x16_bf16(pa1, PK(C, D), o[d0], 0, 0, 0); } while (0)
#define WT4(A, B, C, D) asm volatile("s_waitcnt lgkmcnt(4)" : "+v"(A), "+v"(B), "+v"(C), "+v"(D) :: "memory")
#define WT0(A, B, C, D) asm volatile("s_waitcnt lgkmcnt(0)" : "+v"(A), "+v"(B), "+v"(C), "+v"(D) :: "memory")
    s16x4 a0, a1, a2, a3, b0, b1, b2, b3;
    RD4(0, a0, a1, a2, a3);
    RD4(1, b0, b1, b2, b3); WT4(a0, a1, a2, a3); MM(0, a0, a1, a2, a3);
    RD4(2, a0, a1, a2, a3); WT4(b0, b1, b2, b3); MM(1, b0, b1, b2, b3);
    RD4(3, b0, b1, b2, b3); WT4(a0, a1, a2, a3); MM(2, a0, a1, a2, a3);
    RD4(4, a0, a1, a2, a3); WT4(b0, b1, b2, b3); MM(3, b0, b1, b2, b3);
    RD4(5, b0, b1, b2, b3); WT4(a0, a1, a2, a3); MM(4, a0, a1, a2, a3);
    RD4(6, a0, a1, a2, a3); WT4(b0, b1, b2, b3); MM(5, b0, b1, b2, b3);
    RD4(7, b0, b1, b2, b3); WT4(a0, a1, a2, a3); MM(6, a0, a1, a2, a3);
    WT0(b0, b1, b2, b3); MM(7, b0, b1, b2, b3);
#undef VRO
#undef RD4
#undef PK
#undef MM
#undef WT4
#undef WT0
}
__device__ __forceinline__ void k_src(int b, int& row, int& col) { row = b >> 8; const int cb = (b & 255) ^ ((row & 7) << 4); col = cb >> 1; }
template <int NCB> __device__ __forceinline__ void v_src(int b, int& key, int& col) {
    const int st = b >> 9, e = (b & 511) >> 1; const int kk = (st / NCB) * 8 + (e >> 5); key = swap23(kk); col = (st % NCB) * 32 + (e & 31);
}
__device__ __forceinline__ void glds16(const void* g, LAS unsigned char* l) { __builtin_amdgcn_global_load_lds((const unsigned*)g, (LAS unsigned*)l, 16, 0, 0); }

__device__ __forceinline__ const void* karg_ptr(int off) {
    asm volatile("" : "+s"(off));
    const __attribute__((address_space(4))) char* ka = (const __attribute__((address_space(4))) char*)__builtin_amdgcn_kernarg_segment_ptr();
    return *(const void* const __attribute__((address_space(4)))*)(ka + off);
}
#define KIN(i) ((const float*)karg_ptr(8 * (i)))
#define KOUT() ((float*)karg_ptr(152))
#define KWS() ((unsigned char*)karg_ptr(160))

struct Args { const float* in[19]; float* out; unsigned char* ws; };

__global__ void __launch_bounds__(512, 2) mega_fwd(Args args) {
    extern __shared__ __attribute__((aligned(16))) unsigned char lds_raw[];
    Frame F; F.lds = (LAS unsigned char*)lds_raw;
    F.wave = __builtin_amdgcn_readfirstlane(threadIdx.x >> 6);
    F.G = gridDim.x; { const int bx = blockIdx.x; F.vcu = (F.G % 8 == 0) ? (bx % 8) * (F.G / 8) + bx / 8 : bx; }
    volatile LAS unsigned* MISC = (volatile LAS unsigned*)(F.lds + EX_MISC);
    if (threadIdx.x < 64) MISC[threadIdx.x] = 0u;
    __syncthreads();
    (void)xcd_barrier_post((unsigned*)KWS() + CW_BAR, MISC + 8);
#ifndef PH_MASK
#define PH_MASK 0x1FFF
#endif
#define IN(k) ((PH_MASK >> (k)) & 1)
#ifndef REP_PHASE
#define REP_PHASE -1
#endif
#define REPS(k) _Pragma("unroll 1") for (int rep_ = 0; rep_ < ((REP_PHASE) == (k) ? 2 : 1); ++rep_)
#define SEAM(k) do { if (IN(k) && IN((k) + 1)) { XcdBarrier b_; b_.bar = (unsigned*)KWS() + CW_BAR; b_.x = xb_xcc_id(); b_.st = MISC + 8; xcd_barrier(b_); } } while (0)
#define P_XPROMPT KIN(0)
#define P_XSAMPLE KIN(1)
#define P_SSQ ((float*)(KWS() + WS_CTL + CTL_SSQ))
#define P_X KOUT()
#define P_WS(off) ((bf16*)(KWS() + (off)))

    if (IN(0)) REPS(0) {
        const float* x_prompt = KIN(0); const float* x_sample = KIN(1); const float* norm_mix = KIN(2); const float* norm_ffn = KIN(3);
        const float* w_in_even = KIN(4); const float* w_out_even = KIN(6); const float* w_in_odd = KIN(7); const float* w_out_odd = KIN(13);
        const float* w_gate = KIN(15); const float* w_up = KIN(16); const float* w_down = KIN(17);
        unsigned char* ws = KWS(); float* ssq = (float*)(ws + WS_CTL + CTL_SSQ); unsigned* ctl = (unsigned*)ws;
        bf16* WIE = (bf16*)(ws + WS_WIE); bf16* WOE = (bf16*)(ws + WS_WOE); bf16* WIO = (bf16*)(ws + WS_WIO); bf16* WOO = (bf16*)(ws + WS_WOO);
        bf16* WGU0 = (bf16*)(ws + WS_WGU0); bf16* WGU1 = (bf16*)(ws + WS_WGU1); bf16* WD0 = (bf16*)(ws + WS_WD0); bf16* WD1 = (bf16*)(ws + WS_WD1);
        bf16* XB = (bf16*)(ws + WS_XB);
        unsigned char* outb = (unsigned char*)KOUT(); bf16* A8 = (bf16*)(outb + DO_A8); bf16* A2 = (bf16*)(outb + DO_A2); bf16* FC = (bf16*)(outb + DO_FC);
        const int p0lane = lane_id_opaque(), p0tid = F.wave * 64 + p0lane;
        LAS float* scr = (LAS float*)(F.lds + F.wave * 16384);
        const int gw = F.vcu * 8 + F.wave, NGW = F.G * 8;
        const size_t WFF = (size_t)DM * FF;
        {
            constexpr int I0 = 64 * 256, I1 = 64 * 128, I2 = 64 * 384, I3 = 64 * 128, IG = 64 * 344, ID = 172 * 128;
            constexpr int NITEMS = I0 + I1 + I2 + I3 + 4 * IG + 2 * ID;
            for (int it = gw; it < NITEMS; it += NGW) {
                int r = it; WJob j;
                if (r < I0) j = WJob{w_in_even, norm_mix, WIE, DM, EVEN_IN, 0};
                else if ((r -= I0) < I1) j = WJob{w_out_even, nullptr, WOE, DM, DM, 0};
                else if ((r -= I1) < I2) j = WJob{w_in_odd, norm_mix + DM, WIO, DM, ODD_IN, 0};
                else if ((r -= I2) < I3) j = WJob{w_out_odd, nullptr, WOO, DM, DM, 0};
                else if ((r -= I3) < IG) j = WJob{w_gate, norm_ffn, WGU0, DM, FF, 1};
                else if ((r -= IG) < IG) j = WJob{w_up, norm_ffn, WGU0, DM, FF, 2};
                else if ((r -= IG) < IG) j = WJob{w_gate + WFF, norm_ffn + DM, WGU1, DM, FF, 1};
                else if ((r -= IG) < IG) j = WJob{w_up + WFF, norm_ffn + DM, WGU1, DM, FF, 2};
                else if ((r -= IG) < ID) j = WJob{w_down, nullptr, WD0, FF, DM, 0};
                else { r -= ID; j = WJob{w_down + WFF, nullptr, WD1, FF, DM, 0}; }
                const int nblk = j.N / 32, kb = r / nblk, nb = r % nblk, n0 = nb * 32;
                const int drow0 = j.mode == 0 ? n0 : (256 * (n0 >> 7) + (n0 & 127) + (j.mode == 2 ? 128 : 0));
                p0_item(j.W, j.K, j.N, j.g, j.WT, j.K == DM ? LDX : j.K, kb * 64, n0, drow0, scr, p0lane);
            }
        }
        for (int m = gw; m < NTOK; m += NGW) {
            const float* xr = (m < NTOK_P ? x_prompt + (size_t)m * DM : x_sample + (size_t)(m - NTOK_P) * DM);
            float s = 0.f;
#pragma unroll 4
            for (int j = 0; j < 16; ++j) { const f32x4 v = *(const f32x4*)(xr + j * 256 + p0lane * 4);
                s += (v[0] * v[0] + v[1] * v[1]) + (v[2] * v[2] + v[3] * v[3]);
                u32x2 w; w.x = cvt_pk_bf16(v[0], v[1]); w.y = cvt_pk_bf16(v[2], v[3]); *(u32x2*)(XB + (size_t)m * LDX + j * 256 + p0lane * 4) = w; }
            s = wave_sum(s);
            if (p0lane == 0) ssq[m] = s;
        }
        {
            const long gt = (long)F.vcu * 512 + p0tid, NGT = (long)F.G * 512;
            constexpr long C8 = 8192L * 16384 / 8, C2 = 2048L * 4096 / 8, CF = 1024L * 512 / 8;
            for (long ch = gt; ch < C8 + C2 + CF; ch += NGT) {
                bf16* dst; int k, j0, S, mode;
                if (ch < C8) { k = (int)(ch / 2048); j0 = (int)(ch % 2048) * 8; S = 8192; dst = A8 + (size_t)k * 16384 + j0; mode = 0; }
                else if (ch < C8 + C2) { const long c = ch - C8; k = (int)(c / 512); j0 = (int)(c % 512) * 8; S = 2048; dst = A2 + (size_t)k * 4096 + j0; mode = 0; }
                else { const long c = ch - C8 - C2; k = (int)(c / 64); j0 = (int)(c % 64) * 8; S = 512; dst = FC + (size_t)k * 512 + j0; mode = 1; }
                float v[8];
#pragma unroll
                for (int e = 0; e < 8; ++e) { int j = j0 + e; bool sn; int kk = k;
                    if (mode == 0) { sn = j >= S; if (sn) j -= S; } else { sn = k >= 512; if (sn) kk = k - 512; }
                    const int r = (kk * j) & (S - 1); const float fr = (float)r / (float)S;
                    v[e] = sn ? (mode == 0 ? -__builtin_amdgcn_sinf(fr) : __builtin_amdgcn_sinf(fr)) : __builtin_amdgcn_cosf(fr); }
                u32x4 w; w.x = cvt_pk_bf16(v[0], v[1]); w.y = cvt_pk_bf16(v[2], v[3]); w.z = cvt_pk_bf16(v[4], v[5]); w.w = cvt_pk_bf16(v[6], v[7]);
                *(u32x4*)dst = w;
            }
        }
        if (blockIdx.x == 0 && F.wave == 0) {
            float a = 0.f, b = 0.f;
            const float* lambda_q1 = KIN(8); const float* lambda_k1 = KIN(9); const float* lambda_q2 = KIN(10); const float* lambda_k2 = KIN(11);
            for (int i = p0lane; i < 128; i += 64) { a += lambda_q1[i] * lambda_k1[i]; b += lambda_q2[i] * lambda_k2[i]; }
            a = wave_sum(a); b = wave_sum(b);
            if (p0lane == 0) ((float*)ctl)[CW_LAM] = __expf(a) - __expf(b) + LAM_INIT;
        }
    }
    SEAM(0);

    if (IN(1)) REPS(1) {
        unsigned char* ws = KWS(); float* ssq = (float*)(ws + WS_CTL + CTL_SSQ); bf16* XB = (bf16*)(ws + WS_XB); bf16* WIE = (bf16*)(ws + WS_WIE); bf16* PROJ = (bf16*)(ws + WS_PROJ);
        gm::GridOrder S; S.init(NTOK, EVEN_IN, F.G, (int)blockIdx.x, XB, (size_t)LDX * 2, WIE, (size_t)LDX * 2, PROJ, EVEN_IN, 2);
        gm::EpiBf16 E{ssq, 1.0f};
        gm::gemm_phase(F.lds, F.wave, DM, LDX, LDX, S, E);
    }
    SEAM(1);

    if (IN(2)) REPS(2) {
        unsigned char* ws = KWS(); bf16* PROJ = (bf16*)(ws + WS_PROJ); bf16* VT = (bf16*)(ws + WS_VT); bf16* MIX = (bf16*)(ws + WS_MIX);
        bf16* FC = (bf16*)((unsigned char*)KOUT() + DO_FC); const float* rpb_na = KIN(5);
        {
            struct Sch { int G, c; const bf16* FC; const bf16* PROJ; bf16* VT;
                __device__ __forceinline__ bool next(int i, gm::Unit& u) const {
                    const int L = i * G + c; if (L >= 1536) return false;
                    int q, g, pm, pn;
                    if (L < 1024) { q = L >> 9; const int r = L & 511; g = r >> 7; pm = (r >> 5) & 3; pn = r & 31; }
                    else { const int l2 = L - 1024; q = 2 + (l2 >> 7); const int r = l2 & 127; g = r >> 5; pm = (r >> 3) & 3; pn = r & 7; }
                    const SeqInfo si = seq_info(q);
                    u.A = (const char*)(FC + (size_t)pm * 256 * 512);
                    u.B = (const char*)(PROJ + (size_t)(si.row0 + pn * 256) * EVEN_IN + 6144 + g * 512);
                    u.ldc = 2 * si.S; u.row0 = 0; u.col0 = 0;
                    u.C = (char*)(VT + (size_t)4096 * si.row0 + (size_t)(g * 512 + (pm & 1) * 256) * (2 * si.S) + (size_t)(pm >> 1) * si.S + pn * 256);
                    return true; } };
            Sch S{F.G, (int)blockIdx.x, FC, PROJ, VT};
            gm::EpiBf16 E{nullptr, 1.0f};
            gm::gemm_phase(F.lds, F.wave, 512, 512, EVEN_IN, S, E);
        }
        {
            const int w = F.wave, lane = lane_id_opaque(), tid = w * 64 + lane, r32 = lane & 31, hi = lane >> 5, hh = w >> 1, c0 = 32 * (w & 1);
            LAS float* tab = (LAS float*)(F.lds + EX_TAB);
            LAS float* wsl = (LAS float*)(F.lds + EX_WS) + w * 64;
            const LAS unsigned char* Kl = F.lds + hh * 16384; const unsigned vb = (unsigned)(uintptr_t)(F.lds + 65536 + hh * 16384) + v_rd_base(lane);
            const int upw = 1536 / F.G;
            for (int U = F.vcu * upw; U < (F.vcu + 1) * upw && U < 1536; ++U) {
                int q, hq, r;
                if (U < 1024) { q = U >> 9; const int t = U & 511; hq = t >> 7; r = t & 127; } else { const int t2 = U - 1024; q = 2 + (t2 >> 7); const int t = t2 & 127; hq = t >> 5; r = t & 31; }
                const SeqInfo si = seq_info(q); const int rows = si.S >> 6;
                int rs = r - 4; rs = rs < 0 ? 0 : (rs > rows - 8 ? rows - 8 : rs);
                const int h = 4 * hq + hh;
                __syncthreads();
                for (int e = tid; e < 4 * 8 * 32; e += 512) { const int dc = e & 31, i = (e >> 5) & 7, hd = e >> 8; const int dr = rs + i - r + 7;
                    tab[e] = dc < 31 ? rpb_na[((size_t)(4 * hq + hd) * 15 + dr) * 31 + dc] * LOG2E : 0.f; }
                bf16x8 qr[8];
                { const bf16* Qw = PROJ + (size_t)(si.row0 + r * 64 + c0 + r32) * EVEN_IN + h * 128 + hi * 8;
#pragma unroll
                  for (int d0 = 0; d0 < 8; ++d0) qr[d0] = *(const bf16x8*)(Qw + d0 * 16); }
                float m_reg = -1e30f, l_reg = 0.f; f32x16 o[4];
#pragma unroll
                for (int d = 0; d < 4; ++d) o[d] = (f32x16){0.f, 0.f, 0.f, 0.f, 0.f, 0.f, 0.f, 0.f, 0.f, 0.f, 0.f, 0.f, 0.f, 0.f, 0.f, 0.f};
                const int c = c0 + r32; int cs = c - 8; cs = cs < 0 ? 0 : (cs > 48 ? 48 : cs);
                for (int i = 0; i < 8; ++i) {
                    __syncthreads();
                    {
                        const bf16* src = PROJ + (size_t)(si.row0 + (rs + i) * 64) * EVEN_IN + (w < 4 ? 2048 + (4 * hq + w) * 128 : 4096 + (4 * hq + w - 4) * 128);
                        LAS unsigned char* dst = F.lds + w * 16384;
#pragma unroll 4
                        for (int j = 0; j < 16; ++j) { const int b = j * 1024 + lane * 16; int row, col;
                            if (w < 4) k_src(b, row, col); else v_src<4>(b, row, col);
                            glds16(src + (size_t)row * EVEN_IN + col, dst + j * 1024); }
                    }
                    VM_WAIT(); __syncthreads();
                    f32x16 p0, p1; qkt(p0, p1, Kl, qr, r32, hi);
                    const LAS float* tb = tab + (hh * 8 + i) * 32;
#pragma unroll
                    for (int rr = 0; rr < 16; ++rr) {
                        { const int kc = crow(rr, hi); const bool ok = (unsigned)(kc - cs) < 16u; const int dc = kc - c + 15; const float bv = tb[ok ? dc : 0];
                          p0[rr] = ok ? fmaf(p0[rr], ATT_C, bv) : -1e30f; }
                        { const int kc = 32 + crow(rr, hi); const bool ok = (unsigned)(kc - cs) < 16u; const int dc = kc - c + 15; const float bv = tb[ok ? dc : 0];
                          p1[rr] = ok ? fmaf(p1[rr], ATT_C, bv) : -1e30f; }
                    }
                    float alpha; bf16x8 pa0, pa1, pa2, pa3;
                    softmax_tile(p0, p1, m_reg, l_reg, alpha, pa0, pa1, pa2, pa3);
                    if (hi == 0) wsl[r32] = alpha; LDS_WAIT();
#pragma unroll
                    for (int d = 0; d < 4; ++d)
#pragma unroll
                        for (int rr = 0; rr < 16; ++rr) o[d][rr] *= wsl[crow(rr, hi)];
                    pv_one<0, 4>(o[0], vb, pa0, pa1, pa2, pa3); pv_one<1, 4>(o[1], vb, pa0, pa1, pa2, pa3); pv_one<2, 4>(o[2], vb, pa0, pa1, pa2, pa3); pv_one<3, 4>(o[3], vb, pa0, pa1, pa2, pa3);
                }
                if (hi == 0) wsl[32 + r32] = l_reg; LDS_WAIT();
                bf16* Ow = MIX + (size_t)(si.row0 + r * 64 + c0) * LDX + h * 128 + r32;
#pragma unroll
                for (int rr = 0; rr < 16; ++rr) { const int orow = crow(rr, hi); const float rl = __builtin_amdgcn_rcpf(wsl[32 + orow]);
#pragma unroll
                    for (int d = 0; d < 4; ++d) Ow[(size_t)orow * LDX + d * 32] = (bf16)(cvt_pk_bf16(o[d][rr] * rl, 0.f) & 0xffffu); }
            }
            __syncthreads();
        }
    }
    SEAM(2);

    if (IN(3)) REPS(3) {
        unsigned char* ws = KWS(); bf16* VT = (bf16*)(ws + WS_VT); bf16* MIX = (bf16*)(ws + WS_MIX);
        unsigned char* outb = (unsigned char*)KOUT(); bf16* A8 = (bf16*)(outb + DO_A8); bf16* A2 = (bf16*)(outb + DO_A2);
        {
            struct Sch { int G, c; const bf16* A8; const bf16* VT; bf16* MIX;
                __device__ __forceinline__ bool next(int i, gm::Unit& u) const {
                    if (i >= 2 || G != 256) { if (G == 256) return false; const int L = i * G + c; if (L >= 512) return false; const int q = L >> 8, pm = (L >> 3) & 31, pn = L & 7; return fill(u, q, pm, pn); }
                    const int xcd = c & 7, j = c >> 3; return fill(u, i, 4 * xcd + (j >> 3), j & 7); }
                __device__ __forceinline__ bool fill(gm::Unit& u, int q, int pm, int pn) const {
                    u.A = (const char*)(A8 + (size_t)pm * 256 * 16384); u.B = (const char*)(VT + (size_t)4096 * (q * 8192) + (size_t)pn * 256 * 16384);
                    u.ldc = LDX; u.row0 = 0; u.col0 = 0; u.C = (char*)(MIX + (size_t)(q * 8192 + pm * 256) * LDX + 2048 + pn * 256); return true; } };
            Sch S{F.G, (int)blockIdx.x, A8, VT, MIX};
            gm::EpiBf16 E{nullptr, 1.0f / 2048.0f};
            gm::gemm_phase(F.lds, F.wave, 16384, 16384, 16384, S, E);
        }
        {
            struct Sch { int G, c; const bf16* A2; const bf16* VT; bf16* MIX;
                __device__ __forceinline__ bool next(int i, gm::Unit& u) const {
                    int q, pm, pn;
                    if (G == 256) { if (i >= 1) return false; const int xcd = c & 7, j = c >> 3; q = xcd >> 1; pm = 4 * (xcd & 1) + (j >> 3); pn = j & 7; }
                    else { const int L = i * G + c; if (L >= 256) return false; q = L >> 6; pm = (L >> 3) & 7; pn = L & 7; }
                    const int row0 = NTOK_P + q * 2048;
                    u.A = (const char*)(A2 + (size_t)pm * 256 * 4096); u.B = (const char*)(VT + (size_t)4096 * row0 + (size_t)pn * 256 * 4096);
                    u.ldc = LDX; u.row0 = 0; u.col0 = 0; u.C = (char*)(MIX + (size_t)(row0 + pm * 256) * LDX + 2048 + pn * 256); return true; } };
            Sch S{F.G, (int)blockIdx.x, A2, VT, MIX};
            gm::EpiBf16 E{nullptr, 1.0f / 1024.0f};
            gm::gemm_phase(F.lds, F.wave, 4096, 4096, 4096, S, E);
        }
    }
    SEAM(3);

    if (IN(4)) REPS(4) {
        unsigned char* ws = KWS(); float* ssq = (float*)(ws + WS_CTL + CTL_SSQ); bf16* XB = (bf16*)(ws + WS_XB); bf16* MIX = (bf16*)(ws + WS_MIX); bf16* HMID = (bf16*)(ws + WS_PROJ); bf16* PROJ = HMID;
        float* X = KOUT(); const float* x_prompt = KIN(0); const float* x_sample = KIN(1);
        bf16* WOE = (bf16*)(ws + WS_WOE); bf16* WIO = (bf16*)(ws + WS_WIO); bf16* WOO = (bf16*)(ws + WS_WOO);
        bf16* WGU0 = (bf16*)(ws + WS_WGU0); bf16* WGU1 = (bf16*)(ws + WS_WGU1); bf16* WD0 = (bf16*)(ws + WS_WD0); bf16* WD1 = (bf16*)(ws + WS_WD1);
        (void)ssq; (void)XB; (void)MIX; (void)HMID; (void)PROJ; (void)X; (void)x_prompt; (void)x_sample; (void)WOE; (void)WIO; (void)WOO; (void)WGU0; (void)WGU1; (void)WD0; (void)WD1;
        gm::GridOrder S; S.init(NTOK, DM, F.G, (int)blockIdx.x, MIX, (size_t)LDX * 2, WOE, (size_t)LDX * 2, X, DM, 4);
        gm::EpiResid E{x_prompt, x_sample, 1, X, XB, ssq + NTOK, 1};
        gm::gemm_phase(F.lds, F.wave, DM, LDX, LDX, S, E);
    }
    SEAM(4);
    if (IN(5)) REPS(5) {
        unsigned char* ws = KWS(); float* ssq = (float*)(ws + WS_CTL + CTL_SSQ); bf16* XB = (bf16*)(ws + WS_XB); bf16* MIX = (bf16*)(ws + WS_MIX); bf16* HMID = (bf16*)(ws + WS_PROJ); bf16* PROJ = HMID;
        float* X = KOUT(); const float* x_prompt = KIN(0); const float* x_sample = KIN(1);
        bf16* WOE = (bf16*)(ws + WS_WOE); bf16* WIO = (bf16*)(ws + WS_WIO); bf16* WOO = (bf16*)(ws + WS_WOO);
        bf16* WGU0 = (bf16*)(ws + WS_WGU0); bf16* WGU1 = (bf16*)(ws + WS_WGU1); bf16* WD0 = (bf16*)(ws + WS_WD0); bf16* WD1 = (bf16*)(ws + WS_WD1);
        (void)ssq; (void)XB; (void)MIX; (void)HMID; (void)PROJ; (void)X; (void)x_prompt; (void)x_sample; (void)WOE; (void)WIO; (void)WOO; (void)WGU0; (void)WGU1; (void)WD0; (void)WD1;
        gm::GridOrder S; S.init(NTOK, 2 * FF, F.G, (int)blockIdx.x, XB, (size_t)LDX * 2, WGU0, (size_t)LDX * 2, HMID, FF, 2);
        gm::EpiSwiglu E{ssq + NTOK, HMID};
        gm::gemm_phase(F.lds, F.wave, DM, LDX, LDX, S, E);
    }
    SEAM(5);
    if (IN(6)) REPS(6) {
        unsigned char* ws = KWS(); float* ssq = (float*)(ws + WS_CTL + CTL_SSQ); bf16* XB = (bf16*)(ws + WS_XB); bf16* MIX = (bf16*)(ws + WS_MIX); bf16* HMID = (bf16*)(ws + WS_PROJ); bf16* PROJ = HMID;
        float* X = KOUT(); const float* x_prompt = KIN(0); const float* x_sample = KIN(1);
        bf16* WOE = (bf16*)(ws + WS_WOE); bf16* WIO = (bf16*)(ws + WS_WIO); bf16* WOO = (bf16*)(ws + WS_WOO);
        bf16* WGU0 = (bf16*)(ws + WS_WGU0); bf16* WGU1 = (bf16*)(ws + WS_WGU1); bf16* WD0 = (bf16*)(ws + WS_WD0); bf16* WD1 = (bf16*)(ws + WS_WD1);
        (void)ssq; (void)XB; (void)MIX; (void)HMID; (void)PROJ; (void)X; (void)x_prompt; (void)x_sample; (void)WOE; (void)WIO; (void)WOO; (void)WGU0; (void)WGU1; (void)WD0; (void)WD1;
        gm::GridOrder S; S.init(NTOK, DM, F.G, (int)blockIdx.x, HMID, (size_t)FF * 2, WD0, (size_t)FF * 2, X, DM, 4);
        gm::EpiResid E{x_prompt, x_sample, 0, X, XB, ssq + 2 * NTOK, 1};
        gm::gemm_phase(F.lds, F.wave, FF, FF, FF, S, E);
    }
    SEAM(6);
    if (IN(7)) REPS(7) {
        unsigned char* ws = KWS(); float* ssq = (float*)(ws + WS_CTL + CTL_SSQ); bf16* XB = (bf16*)(ws + WS_XB); bf16* MIX = (bf16*)(ws + WS_MIX); bf16* HMID = (bf16*)(ws + WS_PROJ); bf16* PROJ = HMID;
        float* X = KOUT(); const float* x_prompt = KIN(0); const float* x_sample = KIN(1);
        bf16* WOE = (bf16*)(ws + WS_WOE); bf16* WIO = (bf16*)(ws + WS_WIO); bf16* WOO = (bf16*)(ws + WS_WOO);
        bf16* WGU0 = (bf16*)(ws + WS_WGU0); bf16* WGU1 = (bf16*)(ws + WS_WGU1); bf16* WD0 = (bf16*)(ws + WS_WD0); bf16* WD1 = (bf16*)(ws + WS_WD1);
        (void)ssq; (void)XB; (void)MIX; (void)HMID; (void)PROJ; (void)X; (void)x_prompt; (void)x_sample; (void)WOE; (void)WIO; (void)WOO; (void)WGU0; (void)WGU1; (void)WD0; (void)WD1;
        gm::GridOrder S; S.init(NTOK, ODD_IN, F.G, (int)blockIdx.x, XB, (size_t)LDX * 2, WIO, (size_t)LDX * 2, PROJ, ODD_IN, 2);
        gm::EpiBf16 E{ssq + 2 * NTOK, 1.0f};
        gm::gemm_phase(F.lds, F.wave, DM, LDX, LDX, S, E);
    }
    SEAM(7);

    if (IN(8)) REPS(8) {
        unsigned char* ws = KWS(); bf16* PROJ = (bf16*)(ws + WS_PROJ); bf16* MIX = (bf16*)(ws + WS_MIX); const unsigned* ctl = (const unsigned*)ws;
        const float* subln_w = KIN(12); const float* t5_bias = KIN(14);
        const int w = F.wave, mp = w >> 2, wq = w & 3;
        LAS float* tab = (LAS float*)(F.lds + EX_TAB);
        LAS float* wsl = (LAS float*)(F.lds + EX_WS) + w * 64;
        const int NU = 3072;
        for (int uix = 0; ; ++uix) {
            int q, h, qb;
            if (F.G == 256) {
                if (uix >= 12) break;
                const int xv = F.vcu >> 5, lw = F.vcu & 31;
                if (uix < 8) { const int pair = xv * 4 + (uix >> 1); q = pair >> 4; h = pair & 15; qb = lw * 2 + (uix & 1); }
                else { const int pair = xv * 8 + (uix - 8) * 2 + (lw >> 4); q = 2 + (pair >> 4); h = pair & 15; qb = lw & 15; }
            } else {
                const int U = uix * F.G + F.vcu; if (U >= NU) break;
                if (U < 2048) { q = U >> 10; const int t = U & 1023; h = t >> 6; qb = t & 63; } else { const int t2 = U - 2048; q = 2 + (t2 >> 8); const int t = t2 & 255; h = t >> 4; qb = t & 15; }
            }
            const SeqInfo si = seq_info(q); const int NT = si.S >> 6;
            const int lane = lane_id_opaque(), tid = w * 64 + lane, r32 = lane & 31, hi = lane >> 5;
            __syncthreads();
            for (int e = tid; e < 257; e += 512) { const int rel = e - 128; const int n = rel < 0 ? -rel : rel; int bk = rel > 0 ? 16 : 0;
                if (n < 8) bk += n; else { int lg = 2 + (31 - __builtin_clz((unsigned)(n * n))); bk += lg > 15 ? 15 : lg; }
                tab[e] = t5_bias[bk * 16 + h] * LOG2E; }
            const int qpos0 = 128 * qb + 32 * wq;
            bf16x8 qr[8];
            { const bf16* Qw = PROJ + (size_t)(si.row0 + qpos0 + r32) * ODD_IN + h * 256 + mp * 128 + hi * 8;
#pragma unroll
              for (int d0 = 0; d0 < 8; ++d0) qr[d0] = *(const bf16x8*)(Qw + d0 * 16); }
            float m_reg = -1e30f, l_reg = 0.f; f32x16 o[8];
#pragma unroll
            for (int d = 0; d < 8; ++d) o[d] = (f32x16){0.f, 0.f, 0.f, 0.f, 0.f, 0.f, 0.f, 0.f, 0.f, 0.f, 0.f, 0.f, 0.f, 0.f, 0.f, 0.f};
            constexpr unsigned LDB = ODD_IN * 2;
            unsigned offA, offB;
            if (w < 4) { offA = (unsigned)(lane >> 4) * LDB + (unsigned)(((lane & 15) ^ ((lane >> 4) & 7)) << 4); offB = (unsigned)(lane >> 4) * LDB + (unsigned)(((lane & 15) ^ ((4 + (lane >> 4)) & 7)) << 4); }
            else { const int t = (lane & 31) >> 2; offA = (unsigned)((t & 3) + 8 * (t >> 2)) * LDB + (unsigned)(32 * hi + 8 * (lane & 3)) * 2u; offB = offA; }
            const char* kvbase = (const char*)(PROJ + (size_t)si.row0 * ODD_IN + h * 256);
            const int NS = si.S >> 5;
#define DA_DMA(step) do { const int st_ = (step) < NS ? (step) : NS - 1;      \
            const char* tb_ = kvbase + (size_t)(st_ * 32) * LDB; LAS unsigned char* dst_ = F.lds + ((step) & 3) * 32768 + w * 4096; \
            if (w < 4) { const char* t2_ = tb_ + (size_t)(4 * (w & 1)) * 4 * LDB + (4096 + (w >> 1) * 128) * 2; \
                _Pragma("unroll") for (int j_ = 0; j_ < 4; ++j_) glds16(t2_ + (size_t)j_ * 4 * LDB + ((j_ & 1) ? offB : offA), dst_ + j_ * 1024); } \
            else { const char* t2_ = tb_ + (size_t)(4 * ((w - 4) & 1) + 16 * ((w - 4) >> 1)) * LDB + 8192 * 2; \
                _Pragma("unroll") for (int j_ = 0; j_ < 4; ++j_) glds16(t2_ + 128 * j_ + offA, dst_ + j_ * 1024); } } while (0)
            DA_DMA(0); DA_DMA(1);
            __syncthreads();
            const float bfarL = __builtin_bit_cast(float, __builtin_amdgcn_readfirstlane(__builtin_bit_cast(int, tab[0])));
            const float bfarR = __builtin_bit_cast(float, __builtin_amdgcn_readfirstlane(__builtin_bit_cast(int, tab[256])));
#define DA_QS(s_) do { \
                f32x16 p; LDS_WAIT(); qkt_h(p, F.lds + ((s_) & 3) * 32768 + mp * 8192, qr, r32, hi); \
                const int relmin = 32 * (s_) - (qpos0 + 31), relmax = 32 * (s_) + 31 - qpos0;     \
                SBAR(); \
                if (relmax <= -128 || relmin >= 128) { softmax_far_h(p, relmax <= -128 ? bfarL : bfarR, m_reg, l_reg, alpha, pa0, pa1); } \
                else { const int relb = 32 * (s_) - (qpos0 + r32) + 128 + 4 * hi; \
                    _Pragma("unroll") for (int g4 = 0; g4 < 2; ++g4) { \
                        _Pragma("unroll") for (int r8 = 0; r8 < 8; ++r8) { const int rr = g4 * 8 + r8; int ix = relb + (rr & 3) + 8 * (rr >> 2); ix = ix < 0 ? 0 : (ix > 256 ? 256 : ix); p[rr] = fmaf(p[rr], ATT_C, tab[ix]); } \
                        SBAR(); } \
                    softmax_near_h(p, m_reg, l_reg, alpha, pa0, pa1); } \
                SBAR(); \
                if (__any(alpha < 1.f)) { \
                    if (hi == 0) wsl[r32] = alpha; LDS_WAIT(); \
                    _Pragma("unroll") for (int g4 = 0; g4 < 4; ++g4) { \
                        _Pragma("unroll") for (int r4 = 0; r4 < 4; ++r4) { const int rr = g4 * 4 + r4; const float a = wsl[crow(rr, hi)]; \
                            _Pragma("unroll") for (int d = 0; d < 8; ++d) o[d][rr] *= a; } \
                        SBAR(); } } \
                SBAR(); } while (0)
#define DA_PV(s_) do { LDS_WAIT(); pv_half8<0>(o, (unsigned)(uintptr_t)(F.lds + ((s_) & 3) * 32768 + 16384) + v_rd_base(lane), pa0, pa1); } while (0)
#define DA_SYNC() do { asm volatile("s_waitcnt vmcnt(4)" ::: "memory"); __builtin_amdgcn_s_barrier(); asm volatile("" ::: "memory"); } while (0)
            float alpha; bf16x8 pa0, pa1;
            if (mp == 0) {
                for (int s_ = 0; s_ < NS; ++s_) {
                    DA_SYNC(); DA_DMA(s_ + 2);
                    DA_QS(s_); DA_PV(s_);
                }
            } else {
                DA_SYNC(); DA_DMA(2);
                DA_QS(0);
                for (int s_ = 1; s_ < NS; ++s_) {
                    DA_SYNC(); DA_DMA(s_ + 2);
                    DA_PV(s_ - 1); SBAR(); DA_QS(s_);
                }
                DA_PV(NS - 1);
            }
            VM_WAIT(); __syncthreads();
#undef DA_QS
#undef DA_PV
#undef DA_SYNC
#undef DA_DMA
            if (hi == 0) wsl[32 + r32] = l_reg; LDS_WAIT();
            LAS float* xch = (LAS float*)(F.lds + wq * 32768);
            const float lsc = mp ? ((const float*)ctl)[CW_LAM] : 1.0f;
#pragma unroll
            for (int rr = 0; rr < 16; ++rr) { const float rl = __builtin_amdgcn_rcpf(wsl[32 + crow(rr, hi)]) * lsc;
#pragma unroll
                for (int d = 0; d < 8; ++d) o[d][rr] *= rl;
                if ((rr & 3) == 3) SBAR(); }
            if (mp == 1) {
#pragma unroll
                for (int d = 0; d < 8; ++d) {
#pragma unroll
                    for (int rr = 0; rr < 16; ++rr) xch[(d * 16 + rr) * 64 + lane] = o[d][rr];
                    SBAR(); }
            }
            __syncthreads();
            if (mp == 0) {
#pragma unroll
                for (int d = 0; d < 8; ++d) {
#pragma unroll
                    for (int rr = 0; rr < 16; ++rr) o[d][rr] -= xch[(d * 16 + rr) * 64 + lane];
                    SBAR(); }
                float gw_[8];
#pragma unroll
                for (int d = 0; d < 8; ++d) gw_[d] = subln_w[d * 32 + r32] * (1.0f - LAM_INIT);
                LAS unsigned short* img = (LAS unsigned short*)(F.lds + wq * 32768);
#pragma unroll
                for (int rr = 0; rr < 16; ++rr) { float s = 0.f;
#pragma unroll
                    for (int d = 0; d < 8; ++d) s += o[d][rr] * o[d][rr];
                    s += __shfl_xor(s, 1); s += __shfl_xor(s, 2); s += __shfl_xor(s, 4); s += __shfl_xor(s, 8); s += __shfl_xor(s, 16);
                    const float rs_ = __builtin_amdgcn_rsqf(s * (1.0f / 256.0f) + SUBLN_EPS);
#pragma unroll
                    for (int d = 0; d < 8; ++d) img[crow(rr, hi) * 256 + d * 32 + r32] = (unsigned short)(cvt_pk_bf16(o[d][rr] * rs_ * gw_[d], 0.f) & 0xffffu);
                    if ((rr & 3) == 3) SBAR(); }
                LDS_WAIT();
                bf16* Ob = MIX + (size_t)(si.row0 + qpos0) * LDX + h * 256;
#pragma unroll
                for (int i = 0; i < 16; ++i) { const int row = 2 * i + hi; const u32x4 v = *(const LAS u32x4*)(img + row * 256 + r32 * 8);
                    *(u32x4*)(Ob + (size_t)row * LDX + r32 * 8) = v; }
            }
        }
        __syncthreads();
    }
    SEAM(8);

    if (IN(9)) REPS(9) {
        unsigned char* ws = KWS(); float* ssq = (float*)(ws + WS_CTL + CTL_SSQ); bf16* XB = (bf16*)(ws + WS_XB); bf16* MIX = (bf16*)(ws + WS_MIX); bf16* HMID = (bf16*)(ws + WS_PROJ); bf16* PROJ = HMID;
        float* X = KOUT(); const float* x_prompt = KIN(0); const float* x_sample = KIN(1);
        bf16* WOE = (bf16*)(ws + WS_WOE); bf16* WIO = (bf16*)(ws + WS_WIO); bf16* WOO = (bf16*)(ws + WS_WOO);
        bf16* WGU0 = (bf16*)(ws + WS_WGU0); bf16* WGU1 = (bf16*)(ws + WS_WGU1); bf16* WD0 = (bf16*)(ws + WS_WD0); bf16* WD1 = (bf16*)(ws + WS_WD1);
        (void)ssq; (void)XB; (void)MIX; (void)HMID; (void)PROJ; (void)X; (void)x_prompt; (void)x_sample; (void)WOE; (void)WIO; (void)WOO; (void)WGU0; (void)WGU1; (void)WD0; (void)WD1;
        gm::GridOrder S; S.init(NTOK, DM, F.G, (int)blockIdx.x, MIX, (size_t)LDX * 2, WOO, (size_t)LDX * 2, X, DM, 4);
        gm::EpiResid E{x_prompt, x_sample, 0, X, XB, ssq + 3 * NTOK, 1};
        gm::gemm_phase(F.lds, F.wave, DM, LDX, LDX, S, E);
    }
    SEAM(9);
    if (IN(10)) REPS(10) {
        unsigned char* ws = KWS(); float* ssq = (float*)(ws + WS_CTL + CTL_SSQ); bf16* XB = (bf16*)(ws + WS_XB); bf16* MIX = (bf16*)(ws + WS_MIX); bf16* HMID = (bf16*)(ws + WS_PROJ); bf16* PROJ = HMID;
        float* X = KOUT(); const float* x_prompt = KIN(0); const float* x_sample = KIN(1);
        bf16* WOE = (bf16*)(ws + WS_WOE); bf16* WIO = (bf16*)(ws + WS_WIO); bf16* WOO = (bf16*)(ws + WS_WOO);
        bf16* WGU0 = (bf16*)(ws + WS_WGU0); bf16* WGU1 = (bf16*)(ws + WS_WGU1); bf16* WD0 = (bf16*)(ws + WS_WD0); bf16* WD1 = (bf16*)(ws + WS_WD1);
        (void)ssq; (void)XB; (void)MIX; (void)HMID; (void)PROJ; (void)X; (void)x_prompt; (void)x_sample; (void)WOE; (void)WIO; (void)WOO; (void)WGU0; (void)WGU1; (void)WD0; (void)WD1;
        gm::GridOrder S; S.init(NTOK, 2 * FF, F.G, (int)blockIdx.x, XB, (size_t)LDX * 2, WGU1, (size_t)LDX * 2, HMID, FF, 2);
        gm::EpiSwiglu E{ssq + 3 * NTOK, HMID};
        gm::gemm_phase(F.lds, F.wave, DM, LDX, LDX, S, E);
    }
    SEAM(10);
    if (IN(11)) REPS(11) {
        unsigned char* ws = KWS(); float* ssq = (float*)(ws + WS_CTL + CTL_SSQ); bf16* XB = (bf16*)(ws + WS_XB); bf16* MIX = (bf16*)(ws + WS_MIX); bf16* HMID = (bf16*)(ws + WS_PROJ); bf16* PROJ = HMID;
        float* X = KOUT(); const float* x_prompt = KIN(0); const float* x_sample = KIN(1);
        bf16* WOE = (bf16*)(ws + WS_WOE); bf16* WIO = (bf16*)(ws + WS_WIO); bf16* WOO = (bf16*)(ws + WS_WOO);
        bf16* WGU0 = (bf16*)(ws + WS_WGU0); bf16* WGU1 = (bf16*)(ws + WS_WGU1); bf16* WD0 = (bf16*)(ws + WS_WD0); bf16* WD1 = (bf16*)(ws + WS_WD1);
        (void)ssq; (void)XB; (void)MIX; (void)HMID; (void)PROJ; (void)X; (void)x_prompt; (void)x_sample; (void)WOE; (void)WIO; (void)WOO; (void)WGU0; (void)WGU1; (void)WD0; (void)WD1;
        gm::GridOrder S; S.init(NTOK, DM, F.G, (int)blockIdx.x, HMID, (size_t)FF * 2, WD1, (size_t)FF * 2, X, DM, 4);
        gm::EpiResid E{x_prompt, x_sample, 0, X, XB, ssq + 4 * NTOK, 0};
        gm::gemm_phase(F.lds, F.wave, FF, FF, FF, S, E);
    }
    SEAM(11);
    if (IN(12)) REPS(12) {
        float* X = KOUT(); const float* norm_final = KIN(18); float* ssq = (float*)(KWS() + WS_CTL + CTL_SSQ);
        const int gw = F.vcu * 8 + F.wave, NGW = F.G * 8, fl = lane_id_opaque();
        for (int m = gw; m < NTOK; m += NGW) {
            const float rs = __builtin_amdgcn_rsqf(ssq[4 * NTOK + m] * (1.0f / DM) + RMS_EPS);
            float* xr = X + (size_t)m * DM;
#pragma unroll 4
            for (int j = 0; j < 16; ++j) { const int cidx = j * 256 + fl * 4; const f32x4 v = *(const f32x4*)(xr + cidx); const f32x4 g = *(const f32x4*)(norm_final + cidx);
                *(f32x4*)(xr + cidx) = v * rs * g; }
        }
    }
#undef IN
#undef SEAM
}

extern "C" void kernel_launch(void* const* d_in, const int* in_sizes, int n_in, void* d_out, int out_size, void* d_ws, size_t ws_size, hipStream_t stream) {
    static int grid = 0;
    if (grid == 0) {
        if (n_in != 19 || out_size != NTOK * DM || ws_size < WS_END) { fprintf(stderr, "kernel_launch: unexpected shapes: n_in %d out %d ws %zu (need %zu)\n", n_in, out_size, ws_size, (size_t)WS_END); grid = -1; return; }
        int dev = 0, cus = 0, per_cu = 0;
        if (hipGetDevice(&dev) != hipSuccess || hipDeviceGetAttribute(&cus, hipDeviceAttributeMultiprocessorCount, dev) != hipSuccess) { grid = -1; return; }
        if (hipFuncSetAttribute((const void*)mega_fwd, hipFuncAttributeMaxDynamicSharedMemorySize, LDS_BYTES) != hipSuccess) { fprintf(stderr, "kernel_launch: hipFuncSetAttribute failed\n"); grid = -1; return; }
        if (hipOccupancyMaxActiveBlocksPerMultiprocessor(&per_cu, (const void*)mega_fwd, 512, LDS_BYTES) != hipSuccess || per_cu < 1)
            fprintf(stderr, "kernel_launch: occupancy query reports %d\n", per_cu);
        (void)hipGetLastError();
        grid = cus;
    }
    if (grid < 0) return;
    (void)hipMemsetAsync((char*)d_ws + WS_CTL, 0, CTL_ZERO_BYTES, stream);
    Args a{};
    for (int i = 0; i < 19; ++i) a.in[i] = (const float*)d_in[i];
    a.out = (float*)d_out; a.ws = (unsigned char*)d_ws;
    hipLaunchKernelGGL(mega_fwd, dim3(grid), dim3(512), LDS_BYTES, stream, a);
    const hipError_t le = hipPeekAtLastError();
    if (le != hipSuccess) fprintf(stderr, "kernel_launch: launch failed: %s\n", hipGetErrorName(le));
}
```

```cpp
#include <hip/hip_runtime.h>
#include <cstdio>
#include <cstdint>

#define GAS __attribute__((address_space(1)))
#define LAS __attribute__((address_space(3)))
typedef unsigned short bf16;
typedef short bf16x8 __attribute__((ext_vector_type(8)));
typedef short s16x4 __attribute__((ext_vector_type(4)));
typedef float f32x4 __attribute__((ext_vector_type(4)));
typedef float f32x16 __attribute__((ext_vector_type(16)));
typedef unsigned u32x4 __attribute__((ext_vector_type(4)));
typedef unsigned u32x2 __attribute__((ext_vector_type(2)));

constexpr int DM = 4096, NTOK = 24576, NTOK_P = 16384, FF = 11008;
constexpr int LDX = DM + 128;
constexpr int EVEN_IN = 8192, ODD_IN = 12288;
constexpr float RMS_EPS = 1e-6f, SUBLN_EPS = 1e-5f;
constexpr float LOG2E = 1.4426950408889634f;
constexpr float ATT_C = 0.088388347648318440f * LOG2E;
constexpr float LAM_INIT = 0.35550906759f;

constexpr size_t MiB = 1u << 20;
constexpr size_t WS_CTL = 0, CTL_ZERO_BYTES = 1 * MiB;
constexpr size_t WROW = (size_t)LDX * 2;
constexpr size_t WS_WIE = 2 * MiB, WS_WOE = WS_WIE + 8192 * WROW, WS_WIO = WS_WOE + 4096 * WROW, WS_WOO = WS_WIO + 12288 * WROW;
constexpr size_t WS_WGU0 = WS_WOO + 4096 * WROW, WS_WGU1 = WS_WGU0 + 22016 * WROW, WS_WD0 = WS_WGU1 + 22016 * WROW, WS_WD1 = WS_WD0 + 86 * MiB;
constexpr size_t WS_XB = WS_WD1 + 86 * MiB, WS_MIX = WS_XB + (size_t)NTOK * WROW, WS_PROJ = WS_MIX + (size_t)NTOK * WROW, WS_VT = WS_PROJ + 384 * MiB, WS_END = WS_PROJ + 576 * MiB;
static_assert(WS_END <= (size_t)1864 * MiB && WS_WGU0 % 256 == 0 && WS_XB % 256 == 0 && WS_PROJ % 256 == 0, "workspace map");
constexpr size_t DO_T8 = 0, DO_T2 = 128 * MiB, DO_FC = 136 * MiB, DO_PQ8 = 144 * MiB, DO_PQ2 = 208 * MiB;
#ifndef DFT_HERM
#define DFT_HERM 1
#endif
constexpr size_t DO_T8S = 240 * MiB, DO_P256 = 304 * MiB, DO_WS2 = 320 * MiB, DO_WSP = 321 * MiB;
constexpr int CW_BAR = 4096;
constexpr int CW_LAM = 64;
constexpr size_t CTL_SSQ = 65536;
static_assert(CTL_SSQ + 5 * (size_t)NTOK * 4 <= CTL_ZERO_BYTES, "ctl");

constexpr int RING_BYTES = 131072;
constexpr int EX_OFF = RING_BYTES, EX_MISC = EX_OFF, EX_WS = EX_OFF + 256, EX_TAB = EX_OFF + 2304;
constexpr int LDS_BYTES = 147456;

#define LDS_WAIT() asm volatile("s_waitcnt lgkmcnt(0)" ::: "memory")
#define VM_WAIT() asm volatile("s_waitcnt vmcnt(0)" ::: "memory")
#define SBAR() __builtin_amdgcn_sched_barrier(0)

__device__ __forceinline__ unsigned cvt_pk_bf16(float lo, float hi) { unsigned r; asm volatile("v_cvt_pk_bf16_f32 %0, %1, %2" : "=v"(r) : "v"(lo), "v"(hi)); return r; }

#define XB_TMO      128
#define XB_XCNT(j)  (256  + 64 * (j))
#define XB_XSUB(j)  (1280 + 64 * (j))
#define XB_XGEN(j)  (2304 + 64 * (j))
#define XB_TOP      3328
#define XB_TOPGEN   3392
#define XCD_BAR_WORDS 3456
#define XB_SPIN_CAP (1u << 20)
__device__ __forceinline__ unsigned xb_ld(unsigned* p)              { return __hip_atomic_load(p, __ATOMIC_RELAXED, __HIP_MEMORY_SCOPE_AGENT); }
__device__ __forceinline__ unsigned xb_add(unsigned* p, unsigned v) { return __hip_atomic_fetch_add(p, v, __ATOMIC_RELAXED, __HIP_MEMORY_SCOPE_AGENT); }
__device__ __forceinline__ unsigned xb_xcc_id() { return (unsigned)__builtin_amdgcn_s_getreg((3 << 11) | 20) & 0xFu; }
#define XB_SPIN(cond, bar) do { unsigned _sp = 0; while (cond) { __builtin_amdgcn_s_sleep(1); \
    if ((++_sp & 255u) == 0u) { if (xb_ld(&(bar)[XB_TMO])) break; if (_sp > XB_SPIN_CAP) { atomicAdd(&(bar)[XB_TMO], 1u); break; } } } } while (0)
struct XcdBarrier { unsigned* bar; unsigned x; volatile LAS unsigned* st; };
__device__ __forceinline__ XcdBarrier xcd_barrier_post(unsigned* bar, volatile LAS unsigned* st) {
    XcdBarrier b; b.bar = bar; b.x = xb_xcc_id(); b.st = st;
    if (threadIdx.x == 0) (void)xb_add(&bar[XB_XCNT(b.x)], 1u);
    return b;
}
__device__ __forceinline__ void xcd_barrier_complete(unsigned* bar, unsigned x, unsigned& nloc, unsigned& nx) {
    const unsigned G = gridDim.x * gridDim.y * gridDim.z;
    unsigned sum, cnt, mine, sp = 0u;
    for (;;) {
        sum = 0u; cnt = 0u; mine = 0u;
#pragma unroll
        for (unsigned j = 0; j < 16; ++j) { const unsigned c = xb_ld(&bar[XB_XCNT(j)]); sum += c; cnt += (c > 0u) ? 1u : 0u; mine = (j == x) ? c : mine; }
        if (sum == G) break;
        __builtin_amdgcn_s_sleep(1);
        if ((++sp & 255u) == 0u) { if (xb_ld(&bar[XB_TMO])) break; if (sp > XB_SPIN_CAP) { atomicAdd(&bar[XB_TMO], 1u); break; } }
    }
    nloc = mine > 0u ? mine : 1u; nx = cnt > 0u ? cnt : 1u;
}
__device__ __forceinline__ void xcd_barrier(const XcdBarrier& b) {
    asm volatile("s_waitcnt vmcnt(0)" ::: "memory");
    __syncthreads();
    if (threadIdx.x == 0) {
        unsigned* bar = b.bar;
        __builtin_amdgcn_s_waitcnt(0);
        unsigned nloc = b.st[0], nx = b.st[1];
        if (nloc == 0u) { xcd_barrier_complete(bar, b.x, nloc, nx); b.st[0] = nloc; b.st[1] = nx; }
        const unsigned old = xb_add(&bar[XB_XSUB(b.x)], 1u);
        const unsigned gen = old / nloc;
        if (old + 1u == (gen + 1u) * nloc) {
            __builtin_amdgcn_fence(__ATOMIC_RELEASE, "agent");
            asm volatile("s_waitcnt vmcnt(0)" ::: "memory");
            const unsigned og = xb_add(&bar[XB_TOP], 1u);
            const unsigned tg = og / nx;
            if (og + 1u == (tg + 1u) * nx) xb_add(&bar[XB_TOPGEN], 1u);
            else XB_SPIN(xb_ld(&bar[XB_TOPGEN]) == tg, bar);
            __builtin_amdgcn_fence(__ATOMIC_ACQUIRE, "agent");
            xb_add(&bar[XB_XGEN(b.x)], 1u);
            asm volatile("s_waitcnt vmcnt(0)" ::: "memory");
        } else {
            XB_SPIN(xb_ld(&bar[XB_XGEN(b.x)]) == gen, bar);
            __builtin_amdgcn_fence(__ATOMIC_ACQUIRE, "agent");
            asm volatile("s_waitcnt vmcnt(0)" ::: "memory");
        }
    }
    __syncthreads();
}

__device__ __forceinline__ int lane_id_opaque() { int l = (int)__builtin_amdgcn_mbcnt_hi(~0u, __builtin_amdgcn_mbcnt_lo(~0u, 0u)); asm volatile("" : "+v"(l)); return l & 63; }

__device__ __forceinline__ float dpp_f(float v, int ctrl_sel) {
    const int x = __float_as_int(v); int r;
    if (ctrl_sel == 0) r = __builtin_amdgcn_mov_dpp(x, 0xB1, 0xF, 0xF, true);
    else if (ctrl_sel == 1) r = __builtin_amdgcn_mov_dpp(x, 0x4E, 0xF, 0xF, true);
    else if (ctrl_sel == 2) r = __builtin_amdgcn_mov_dpp(x, 0x141, 0xF, 0xF, true);
    else r = __builtin_amdgcn_mov_dpp(x, 0x140, 0xF, 0xF, true);
    return __int_as_float(r);
}
__device__ __forceinline__ float sum_rows16(float v) {
    auto rr = __builtin_amdgcn_permlane16_swap(__float_as_uint(v), __float_as_uint(v), false, false); return __uint_as_float(rr[0]) + __uint_as_float(rr[1]);
}
__device__ __forceinline__ float sum_halves32(float v) {
    auto rr = __builtin_amdgcn_permlane32_swap(__float_as_uint(v), __float_as_uint(v), false, false); return __uint_as_float(rr[0]) + __uint_as_float(rr[1]);
}
__device__ __forceinline__ float sum_row16(float v) {
    v += dpp_f(v, 0); v += dpp_f(v, 1); v += dpp_f(v, 2); v += dpp_f(v, 3); return v;
}

namespace gm {
constexpr int BM = 256, BK = 64, HALF = 128, HTB = HALF * BK * 2, NXCD = 8, WGM = 8;
__host__ __device__ __forceinline__ int lds_byte(int r, int c) { const int st = (r >> 4) * 2 + (c >> 5), rr = r & 15, cc = c & 31, ob = rr * 64 + cc * 2; return st * 1024 + (ob ^ (((ob >> 9) & 1) << 5)); }
__host__ __device__ __forceinline__ void stage_rc(int b, int& R, int& C) { const int st = b / 1024, sb = b % 1024, swz = sb ^ (((sb >> 9) & 1) << 5); R = (st >> 1) * 16 + swz / 64; C = (st & 1) * 32 + (swz % 64) / 2; }
__host__ __device__ __forceinline__ int perm32(int rho) { const int n = rho >> 4, i = rho & 15; return 8 * (i >> 2) + 4 * n + (i & 3); }

struct Unit { const char* A; const char* B; char* C; int ldc; int row0; int col0; };

#ifndef ORD48
#define ORD48 3
#endif
struct GridOrder {
    int nM, nN, nwg, G, c; const char* A; const char* B; char* C; size_t atile, btile; int ldc, esz; bool sh48 = false;
    __device__ __forceinline__ void init(int M, int N, int G_, int c_, const void* A_, size_t lda_bytes, const void* B_, size_t ldb_bytes, void* C_, int ldc_, int esz_) {
        nM = M / BM; nN = N / BM; nwg = nM * nN; G = G_; c = c_; A = (const char*)A_; B = (const char*)B_; C = (char*)C_; atile = lda_bytes * BM; btile = ldb_bytes * BM; ldc = ldc_; esz = esz_; }
    __device__ __forceinline__ bool next(int i, Unit& u) const {
        int pm, pn;
        if (G == 256 && nM == 96 && (nN & 1) == 0) {
            const int x = c & 7, e = i * 32 + (c >> 3), nA = 8 * nN;
            if (sh48 && nN == 16) {
                const int q = e & 31, r = e >> 5; if (r >= 6) return false;
                if (r < 4) { pm = 8 * x + 4 * (r >> 1) + (q & 3); pn = 8 * (r & 1) + (q >> 2); }
                else { pm = 64 + 8 * (x >> 1) + 4 * (r - 4) + (q & 3); pn = 8 * (x & 1) + (q >> 2); }
            } else
            if (e < nA) { pn = e >> 3; pm = 8 * x + (e & 7); }
            else { const int e2 = e - nA; if (e2 >= 4 * nN) return false; pn = (nN >> 1) * (x & 1) + (e2 >> 3); pm = 64 + 8 * (x >> 1) + (e2 & 7); }
        } else {
        const long L = (long)i * G + c; if (L >= nwg) return false;
        int wgid = (int)L; { const int q = nwg / NXCD, r = nwg % NXCD, xcd = wgid % NXCD, off = wgid / NXCD; wgid = (xcd < r ? xcd * (q + 1) : r * (q + 1) + (xcd - r) * q) + off; }
        const int nig = WGM * nN, gid = wgid / nig, fm = gid * WGM, gsz = (nM - fm) < WGM ? (nM - fm) : WGM;
        pm = fm + ((wgid % nig) % gsz); pn = (wgid % nig) / gsz;
        }
        u.A = A + (size_t)pm * atile; u.B = B + (size_t)pn * btile; u.row0 = pm * BM; u.col0 = pn * BM; u.ldc = ldc;
        u.C = C + ((size_t)u.row0 * ldc + u.col0) * esz; return true;
    }
};

__device__ __forceinline__ void load_rstd8(float (&rs)[8], const float* ssq, int row0, int wr, int fr, float scale) {
    if (ssq) {
#pragma unroll
        for (int g = 0; g < 8; ++g) rs[g] = ssq[row0 + (g >> 2) * HALF + wr * 64 + (g & 3) * 16 + fr];
#pragma unroll
        for (int g = 0; g < 8; ++g) rs[g] = __builtin_amdgcn_rsqf(rs[g] * (1.0f / DM) + RMS_EPS) * scale;
    } else {
#pragma unroll
        for (int g = 0; g < 8; ++g) rs[g] = scale;
    }
}
struct EpiBf16 {
    static constexpr bool PERM = true;
    const float* ssq; float scale;
    __device__ __forceinline__ void operator()(const f32x4 (&acc)[2][2][4][2], const Unit& u, int wr, int wc, int fr, int fq) const {
        bf16* base = (bf16*)u.C + wc * 32 + 8 * fq;
        float rs[8]; load_rstd8(rs, ssq, u.row0, wr, fr, scale);
#pragma unroll
        for (int ai = 0; ai < 2; ++ai)
#pragma unroll
            for (int m = 0; m < 4; ++m) { int r = ai * HALF + wr * 64 + m * 16 + fr; asm volatile("" : "+v"(r));
                const float s = rs[ai * 4 + m];
                bf16* rowp = base + (size_t)r * u.ldc;
#pragma unroll
                for (int bj = 0; bj < 2; ++bj) { const f32x4 v0 = acc[ai][bj][m][0] * s, v1 = acc[ai][bj][m][1] * s;
                    u32x4 w; w.x = cvt_pk_bf16(v0[0], v0[1]); w.y = cvt_pk_bf16(v0[2], v0[3]); w.z = cvt_pk_bf16(v1[0], v1[1]); w.w = cvt_pk_bf16(v1[2], v1[3]);
                    *(u32x4*)(rowp + bj * HALF) = w; } }
    }
};
struct EpiSwiglu {
    static constexpr bool PERM = true;
    const float* ssq; bf16* H;
    __device__ __forceinline__ void operator()(const f32x4 (&acc)[2][2][4][2], const Unit& u, int wr, int wc, int fr, int fq) const {
        bf16* base = H + (size_t)u.row0 * FF + (u.col0 >> 1) + wc * 32 + 8 * fq;
        float rs[8]; load_rstd8(rs, ssq, u.row0, wr, fr, 1.0f);
#pragma unroll
        for (int ai = 0; ai < 2; ++ai)
#pragma unroll
            for (int m = 0; m < 4; ++m) { int r = ai * HALF + wr * 64 + m * 16 + fr; asm volatile("" : "+v"(r));
                const float s = rs[ai * 4 + m];
                float hv[8];
#pragma unroll
                for (int n = 0; n < 2; ++n)
#pragma unroll
                    for (int j = 0; j < 4; ++j) { const float g = acc[ai][0][m][n][j] * s, up = acc[ai][1][m][n][j] * s;
                        const float e = __builtin_amdgcn_exp2f(-g * LOG2E); hv[n * 4 + j] = g * __builtin_amdgcn_rcpf(1.0f + e) * up; }
                u32x4 w; w.x = cvt_pk_bf16(hv[0], hv[1]); w.y = cvt_pk_bf16(hv[2], hv[3]); w.z = cvt_pk_bf16(hv[4], hv[5]); w.w = cvt_pk_bf16(hv[6], hv[7]);
                *(u32x4*)(base + (size_t)r * FF) = w; }
    }
};
struct EpiResid {
    static constexpr bool PERM = false;
    const float* xp; const float* xs; int from_input;
    float* X; bf16* XB; float* ssq; int write_xb;
    __device__ __forceinline__ void operator()(const f32x4 (&acc)[2][2][4][2], const Unit& u, int wr, int wc, int fr, int fq) const {
        const float* rbase = from_input ? (u.row0 < NTOK_P ? xp + (size_t)u.row0 * DM : xs + (size_t)(u.row0 - NTOK_P) * DM) : X + (size_t)u.row0 * DM;
        const int c0 = u.col0 + wc * 32 + 4 * fq;
        f32x4 rv[4], rn[4];
        { int r = wr * 64 + fr; asm volatile("" : "+v"(r)); const unsigned off = (unsigned)r * DM + c0;
#pragma unroll
          for (int q = 0; q < 4; ++q) rv[q] = *(const f32x4*)(rbase + off + (q >> 1) * HALF + (q & 1) * 16); }
#pragma unroll
        for (int g = 0; g < 8; ++g) { const int ai = g >> 2, m = g & 3;
            if (g < 7) { int r2 = ((g + 1) >> 2) * HALF + wr * 64 + ((g + 1) & 3) * 16 + fr; asm volatile("" : "+v"(r2)); const unsigned off2 = (unsigned)r2 * DM + c0;
#pragma unroll
                for (int q = 0; q < 4; ++q) rn[q] = *(const f32x4*)(rbase + off2 + (q >> 1) * HALF + (q & 1) * 16); }
            int r = ai * HALF + wr * 64 + m * 16 + fr; asm volatile("" : "+v"(r));
            const unsigned off = (unsigned)r * DM + c0, offx = (unsigned)r * LDX + c0;
            float s = 0.f;
#pragma unroll
            for (int bj = 0; bj < 2; ++bj)
#pragma unroll
                for (int n = 0; n < 2; ++n) { const f32x4 v = rv[bj * 2 + n] + acc[ai][bj][m][n];
                    *(f32x4*)(X + (size_t)u.row0 * DM + off + bj * HALF + n * 16) = v;
                    s += (v[0] * v[0] + v[1] * v[1]) + (v[2] * v[2] + v[3] * v[3]);
                    if (write_xb) { u32x2 w; w.x = cvt_pk_bf16(v[0], v[1]); w.y = cvt_pk_bf16(v[2], v[3]); *(u32x2*)(XB + (size_t)u.row0 * LDX + offx + bj * HALF + n * 16) = w; } }
            s = sum_halves32(sum_rows16(s));
            if (fq == 0) unsafeAtomicAdd(ssq + u.row0 + r, s);
#pragma unroll
            for (int q = 0; q < 4; ++q) rv[q] = rn[q];
        }
    }
};

template <class Epi, class Sched>
__device__ __forceinline__ void gemm_phase(LAS unsigned char* lds, const int wave, const int K, const int lda, const int ldb, const Sched& S, const Epi& E) {
    const int lane = lane_id_opaque(), wid = wave, tid = wid * 64 + lane, wr = wid >> 2, wc = wid & 3, fr = lane & 15, fq = lane >> 4;
    const int nt = K / BK;
    unsigned voffA[2], voffB[2];
#pragma unroll
    for (int i = 0; i < 2; ++i) { int R, C; stage_rc(tid * 16 + i * 8192, R, C); const int Rb = Epi::PERM ? ((R & ~31) + perm32(R & 31)) : R;
        voffA[i] = (unsigned)(R * lda + C) * 2u; voffB[i] = (unsigned)(Rb * ldb + C) * 2u; }
    const size_t kstep = (size_t)(BK * 2);
    const size_t hstepA = (size_t)HALF * lda * 2, hstepB = (size_t)HALF * ldb * 2;
    const unsigned ldsw = (unsigned)wid * 1024u;
    const int aoff = lds_byte(wr * 64 + fr, fq * 8), boff = lds_byte(wc * 32 + fr, fq * 8);
#define PG8_SA(b, h) (((b) * 2 + (h)) * HTB)
#define PG8_SB(b, h) ((4 + (b) * 2 + (h)) * HTB)
#define PG8_STAGE(bufoff, gbase, voff) do { _Pragma("unroll") for (int _i = 0; _i < 2; ++_i) \
        __builtin_amdgcn_global_load_lds((const unsigned*)((const char*)(gbase) + (voff)[_i]), (LAS unsigned*)(lds + (bufoff) + ldsw + _i * 8192), 16, 0, 0); } while (0)
#define PG8_LDA(dst, b, h) do { _Pragma("unroll") for (int m = 0; m < 4; ++m) _Pragma("unroll") for (int k = 0; k < 2; ++k) dst[m][k] = *(const LAS bf16x8*)(lds + PG8_SA(b, h) + aoff + m * 2048 + k * 1024); } while (0)
#define PG8_LDB(dst, b, h) do { _Pragma("unroll") for (int n = 0; n < 2; ++n) _Pragma("unroll") for (int k = 0; k < 2; ++k) dst[n][k] = *(const LAS bf16x8*)(lds + PG8_SB(b, h) + boff + n * 2048 + k * 1024); } while (0)
#ifndef GEMM_PRIO
#define GEMM_PRIO 1
#endif
#define PG8_MMA(ai, bj, At, Bt) do { if (GEMM_PRIO) __builtin_amdgcn_s_setprio(GEMM_PRIO); _Pragma("unroll") for (int m = 0; m < 4; ++m) _Pragma("unroll") for (int n = 0; n < 2; ++n) _Pragma("unroll") for (int k = 0; k < 2; ++k) \
        acc[ai][bj][m][n] = __builtin_amdgcn_mfma_f32_16x16x32_bf16(Bt[n][k], At[m][k], acc[ai][bj][m][n], 0, 0, 0); if (GEMM_PRIO) __builtin_amdgcn_s_setprio(0); } while (0)
#define PG8_WAIT_V(n) asm volatile("s_waitcnt vmcnt(" #n ")" ::: "memory")
#define PG8_WAIT_L(n) asm volatile("s_waitcnt lgkmcnt(" #n ")" ::: "memory")
#define PG8_BAR __builtin_amdgcn_s_barrier()
#define PG8_SCHED __builtin_amdgcn_sched_barrier(0)
    Unit cur, nxt; int ui = 0;
    if (!S.next(0, cur)) return;
    f32x4 acc[2][2][4][2];
#pragma unroll
    for (int a = 0; a < 2; ++a)
#pragma unroll
        for (int b = 0; b < 2; ++b)
#pragma unroll
            for (int m = 0; m < 4; ++m)
#pragma unroll
                for (int n = 0; n < 2; ++n) acc[a][b][m][n] = (f32x4){0.f, 0.f, 0.f, 0.f};
    bf16x8 At[4][2], B0[2][2], B1[2][2];
    const char* cA = cur.A; const char* cB = cur.B;
#ifndef GEMM_SP2
#define GEMM_SP2 1
#endif
#if GEMM_SP2
    PG8_STAGE(PG8_SB(0, 0), cB, voffB); PG8_STAGE(PG8_SB(0, 1), cB + hstepB, voffB); PG8_STAGE(PG8_SA(0, 0), cA, voffA); PG8_STAGE(PG8_SA(0, 1), cA + hstepA, voffA);
    if (wr == 1) PG8_BAR;
    PG8_WAIT_V(2); PG8_BAR;
    PG8_STAGE(PG8_SB(1, 0), cB + kstep, voffB); PG8_STAGE(PG8_SA(1, 0), cA + kstep, voffA); PG8_STAGE(PG8_SB(1, 1), cB + hstepB + kstep, voffB);
    PG8_WAIT_V(6); PG8_BAR;
#else
    PG8_STAGE(PG8_SB(0, 0), cB, voffB); PG8_STAGE(PG8_SA(0, 0), cA, voffA); PG8_STAGE(PG8_SB(0, 1), cB + hstepB, voffB); PG8_STAGE(PG8_SA(0, 1), cA + hstepA, voffA);
    if (wr == 1) PG8_BAR;
    PG8_WAIT_V(4); PG8_BAR;
    PG8_STAGE(PG8_SB(1, 0), cB + kstep, voffB); PG8_STAGE(PG8_SA(1, 0), cA + kstep, voffA); PG8_STAGE(PG8_SB(1, 1), cB + hstepB + kstep, voffB);
    PG8_WAIT_V(6); PG8_BAR;
#endif
    for (;;) {
        const bool has_next = S.next(ui + 1, nxt);
        const char* nA = has_next ? nxt.A : cA; const char* nB = has_next ? nxt.B : cB;
        asm volatile(".p2align 7");
        for (int t = 0; t < nt; t += 2) {
            const bool last = (t == nt - 2);
            const char* a1 = cA + (size_t)(t + 1) * kstep;
            const char* a2 = last ? nA : cA + (size_t)(t + 2) * kstep; const char* b2 = last ? nB : cB + (size_t)(t + 2) * kstep;
            const char* a3 = a2 + kstep; const char* b3 = b2 + kstep;
#if GEMM_SP2
            PG8_LDB(B0, 0, 0); PG8_LDB(B1, 0, 1); PG8_SCHED; PG8_LDA(At, 0, 0); PG8_STAGE(PG8_SA(1, 1), a1 + hstepA, voffA);
            PG8_WAIT_V(8); PG8_WAIT_L(0); PG8_BAR; PG8_MMA(0, 0, At, B0); PG8_MMA(0, 1, At, B1); PG8_BAR; PG8_SCHED;
            PG8_LDA(At, 0, 1); PG8_STAGE(PG8_SB(0, 0), b2, voffB); PG8_STAGE(PG8_SB(0, 1), b2 + hstepB, voffB); PG8_STAGE(PG8_SA(0, 0), a2, voffA);
            PG8_WAIT_V(8); PG8_WAIT_L(0); PG8_BAR; PG8_MMA(1, 0, At, B0); PG8_MMA(1, 1, At, B1); PG8_BAR; PG8_SCHED;
            PG8_LDB(B0, 1, 0); PG8_LDB(B1, 1, 1); PG8_SCHED; PG8_LDA(At, 1, 0); PG8_STAGE(PG8_SA(0, 1), a2 + hstepA, voffA);
            PG8_WAIT_V(8); PG8_WAIT_L(0); PG8_BAR; PG8_MMA(0, 0, At, B0); PG8_MMA(0, 1, At, B1); PG8_BAR; PG8_SCHED;
            PG8_LDA(At, 1, 1); PG8_STAGE(PG8_SB(1, 0), b3, voffB); PG8_STAGE(PG8_SB(1, 1), b3 + hstepB, voffB); PG8_STAGE(PG8_SA(1, 0), a3, voffA);
            PG8_WAIT_V(8); PG8_WAIT_L(0); PG8_BAR; PG8_MMA(1, 0, At, B0); PG8_MMA(1, 1, At, B1); PG8_BAR; PG8_SCHED;
#else
            PG8_LDB(B0, 0, 0); PG8_SCHED; PG8_LDA(At, 0, 0); PG8_STAGE(PG8_SA(1, 1), a1 + hstepA, voffA);
            PG8_WAIT_L(8); PG8_BAR; PG8_WAIT_L(0); PG8_MMA(0, 0, At, B0); PG8_BAR; PG8_SCHED;
            PG8_LDB(B1, 0, 1); PG8_STAGE(PG8_SB(0, 0), b2, voffB);
            PG8_BAR; PG8_WAIT_L(0); PG8_MMA(0, 1, At, B1); PG8_BAR;
            PG8_LDA(At, 0, 1); PG8_STAGE(PG8_SA(0, 0), a2, voffA);
            PG8_BAR; PG8_WAIT_L(0); PG8_MMA(1, 0, At, B0); PG8_BAR; PG8_SCHED;
            PG8_STAGE(PG8_SB(0, 1), b2 + hstepB, voffB);
            PG8_WAIT_V(6); PG8_BAR; PG8_MMA(1, 1, At, B1); PG8_BAR;
            PG8_LDB(B0, 1, 0); PG8_SCHED; PG8_LDA(At, 1, 0); PG8_STAGE(PG8_SA(0, 1), a2 + hstepA, voffA);
            PG8_WAIT_L(8); PG8_BAR; PG8_WAIT_L(0); PG8_MMA(0, 0, At, B0); PG8_BAR; PG8_SCHED;
            PG8_LDB(B1, 1, 1); PG8_STAGE(PG8_SB(1, 0), b3, voffB);
            PG8_BAR; PG8_WAIT_L(0); PG8_MMA(0, 1, At, B1); PG8_BAR;
            PG8_LDA(At, 1, 1); PG8_STAGE(PG8_SA(1, 0), a3, voffA);
            PG8_BAR; PG8_WAIT_L(0); PG8_MMA(1, 0, At, B0); PG8_BAR; PG8_SCHED;
            PG8_STAGE(PG8_SB(1, 1), b3 + hstepB, voffB);
            PG8_WAIT_V(6); PG8_BAR; PG8_MMA(1, 1, At, B1); PG8_BAR;
#endif
        }
        if (wr == 0) PG8_BAR;
        E(acc, cur, wr, wc, fr, fq);
        if (!has_next) break;
#pragma unroll
        for (int a = 0; a < 2; ++a)
#pragma unroll
            for (int b = 0; b < 2; ++b)
#pragma unroll
                for (int m = 0; m < 4; ++m)
#pragma unroll
                    for (int n = 0; n < 2; ++n) acc[a][b][m][n] = (f32x4){0.f, 0.f, 0.f, 0.f};
        cur = nxt; cA = nA; cB = nB; ++ui;
        if (wr == 1) PG8_BAR;
    }
    PG8_WAIT_V(0);
    PG8_BAR;
#undef PG8_SA
#undef PG8_SB
#undef PG8_STAGE
#undef PG8_LDA
#undef PG8_LDB
#undef PG8_MMA
#undef PG8_WAIT_V
#undef PG8_WAIT_L
#undef PG8_BAR
#undef PG8_SCHED
}
}

struct Frame {
    LAS unsigned char* lds;
    int wave, vcu, G;
};
struct SeqInfo { int row0, S; };
__device__ __forceinline__ SeqInfo seq_info(int q) { SeqInfo s; if (q < 2) { s.row0 = q * 8192; s.S = 8192; } else { s.row0 = NTOK_P + (q - 2) * 2048; s.S = 2048; } return s; }

__device__ __forceinline__ float wave_sum(float v) {
#pragma unroll
    for (int o = 1; o < 64; o <<= 1) v += __shfl_xor(v, o);
    return v;
}

__device__ __forceinline__ void p0_load(f32x4 (&v)[8], float (&gs)[8], const float* W, int N, const float* g, int k0, int n0, int lane) {
    const int n4 = (lane & 7) * 4;
#pragma unroll
    for (int i = 0; i < 8; ++i) { const int kk = (lane >> 3) + 8 * i;
        v[i] = *(const f32x4*)(W + (size_t)(k0 + kk) * N + n0 + n4);
        gs[i] = g ? g[k0 + kk] : 1.0f; }
}
__device__ __forceinline__ void p0_store(const f32x4 (&vv)[8], const float (&gs)[8], bf16* WT, int ldw, int k0, int drow0, LAS float* scr, int lane) {
    const int n4 = (lane & 7) * 4;
#pragma unroll
    for (int i = 0; i < 8; ++i) { const int kk = (lane >> 3) + 8 * i; const f32x4 v = vv[i] * gs[i];
        scr[kk * 33 + n4 + 0] = v[0]; scr[kk * 33 + n4 + 1] = v[1]; scr[kk * 33 + n4 + 2] = v[2]; scr[kk * 33 + n4 + 3] = v[3]; }
    LDS_WAIT(); asm volatile("" ::: "memory");
    const int c = lane & 7;
#pragma unroll
    for (int j = 0; j < 4; ++j) { const int n = (lane >> 3) + 8 * j; const LAS float* s = scr + (8 * c) * 33 + n;
        u32x4 o; o.x = cvt_pk_bf16(s[0 * 33], s[1 * 33]); o.y = cvt_pk_bf16(s[2 * 33], s[3 * 33]); o.z = cvt_pk_bf16(s[4 * 33], s[5 * 33]); o.w = cvt_pk_bf16(s[6 * 33], s[7 * 33]);
        *(u32x4*)(WT + (size_t)(drow0 + n) * ldw + k0 + 8 * c) = o; }
    LDS_WAIT(); asm volatile("" ::: "memory");
}
struct WJob { const float* W; const float* g; bf16* WT; int K, N, mode; };

#define KSWZ(row, colB) ((row) * 256 + ((colB) ^ (((row) & 7) << 4)))
__device__ __forceinline__ int crow(int r, int hi) { return (r & 3) + 8 * (r >> 2) + 4 * hi; }
__device__ __forceinline__ int swap23(int k) { return (k & ~0xC) | ((k & 4) << 1) | ((k & 8) >> 1); }
__device__ __forceinline__ int v_rd_base(int lane) { return ((lane & 3) << 3) | (((lane >> 2) & 3) << 6) | (((lane >> 4) & 1) << 5) | (((lane >> 5) & 1) << 8); }
template <int OFF> __device__ __forceinline__ s16x4 tr_read(unsigned vb) {
    s16x4 r; asm volatile("ds_read_b64_tr_b16 %0, %1 offset:%2" : "=&v"(r) : "v"(vb), "i"(OFF) : "memory"); return r;
}
__device__ __forceinline__ void qkt(f32x16& p0, f32x16& p1, const LAS unsigned char* Ks, const bf16x8 (&qr)[8], int r32, int hi) {
    p0 = (f32x16){0.f, 0.f, 0.f, 0.f, 0.f, 0.f, 0.f, 0.f, 0.f, 0.f, 0.f, 0.f, 0.f, 0.f, 0.f, 0.f}; p1 = p0;
    const LAS unsigned char* k0p = Ks + r32 * 256; const LAS unsigned char* k1p = Ks + (32 + r32) * 256; const int sw = (r32 & 7) << 4;
    bf16x8 a0 = *(const LAS bf16x8*)(k0p + ((hi * 16) ^ sw)), a1 = *(const LAS bf16x8*)(k1p + ((hi * 16) ^ sw));
#pragma unroll
    for (int d0 = 0; d0 < 8; ++d0) {
        bf16x8 n0 = a0, n1 = a1;
        if (d0 < 7) { const int cb = ((d0 + 1) * 32 + hi * 16) ^ sw; n0 = *(const LAS bf16x8*)(k0p + cb); n1 = *(const LAS bf16x8*)(k1p + cb); }
        p0 = __builtin_amdgcn_mfma_f32_32x32x16_bf16(a0, qr[d0], p0, 0, 0, 0);
        p1 = __builtin_amdgcn_mfma_f32_32x32x16_bf16(a1, qr[d0], p1, 0, 0, 0);
        a0 = n0; a1 = n1;
        SBAR();
    }
}
template <int D0, int NCB> __device__ __forceinline__ void pv_one(f32x16& od, unsigned vb, bf16x8 pa0, bf16x8 pa1, bf16x8 pa2, bf16x8 pa3) {
#define VRO(ks, half) (D0 * 512 + (ks) * (NCB * 1024) + (half) * (NCB * 512))
    const s16x4 l0 = tr_read<VRO(0, 0)>(vb), h0 = tr_read<VRO(0, 1)>(vb), l1 = tr_read<VRO(1, 0)>(vb), h1 = tr_read<VRO(1, 1)>(vb);
    const s16x4 l2 = tr_read<VRO(2, 0)>(vb), h2 = tr_read<VRO(2, 1)>(vb), l3 = tr_read<VRO(3, 0)>(vb), h3 = tr_read<VRO(3, 1)>(vb);
#undef VRO
    asm volatile("s_waitcnt lgkmcnt(0)" ::: "memory"); SBAR();
#define PK(L, H) (bf16x8){L[0], L[1], L[2], L[3], H[0], H[1], H[2], H[3]}
    od = __builtin_amdgcn_mfma_f32_32x32x16_bf16(pa0, PK(l0, h0), od, 0, 0, 0);
    od = __builtin_amdgcn_mfma_f32_32x32x16_bf16(pa1, PK(l1, h1), od, 0, 0, 0);
    od = __builtin_amdgcn_mfma_f32_32x32x16_bf16(pa2, PK(l2, h2), od, 0, 0, 0);
    od = __builtin_amdgcn_mfma_f32_32x32x16_bf16(pa3, PK(l3, h3), od, 0, 0, 0);
#undef PK
}
__device__ __forceinline__ void softmax_tile(f32x16& p0, f32x16& p1, float& m_reg, float& l_reg, float& alpha, bf16x8& pa0, bf16x8& pa1, bf16x8& pa2, bf16x8& pa3) {
    float pmax = p0[0];
#pragma unroll
    for (int r = 1; r < 16; ++r) pmax = fmaxf(pmax, p0[r]);
#pragma unroll
    for (int r = 0; r < 16; ++r) pmax = fmaxf(pmax, p1[r]);
    { auto rr = __builtin_amdgcn_permlane32_swap(__float_as_uint(pmax), __float_as_uint(pmax), false, false);
      pmax = fmaxf(__uint_as_float(rr[0]), __uint_as_float(rr[1])); }
    if (__all(pmax - m_reg <= 6.0f)) { alpha = 1.0f; }
    else { const float mn_ = fmaxf(m_reg, pmax); alpha = __builtin_amdgcn_exp2f(m_reg - mn_); m_reg = mn_; }
    const float mn = m_reg;
#pragma unroll
    for (int r = 0; r < 16; ++r) p0[r] = __builtin_amdgcn_exp2f(p0[r] - mn);
#pragma unroll
    for (int r = 0; r < 16; ++r) p1[r] = __builtin_amdgcn_exp2f(p1[r] - mn);
    float ps = 0.f;
#pragma unroll
    for (int r = 0; r < 16; ++r) ps += p0[r];
#pragma unroll
    for (int r = 0; r < 16; ++r) ps += p1[r];
    { auto rr = __builtin_amdgcn_permlane32_swap(__float_as_uint(ps), __float_as_uint(ps), false, false);
      ps = __uint_as_float(rr[0]) + __uint_as_float(rr[1]); }
    l_reg = l_reg * alpha + ps;
#define PK4(P, BASE, OUT) do { unsigned a0 = cvt_pk_bf16(P[BASE + 0], P[BASE + 1]), a1 = cvt_pk_bf16(P[BASE + 2], P[BASE + 3]);   \
    unsigned b0 = cvt_pk_bf16(P[BASE + 4], P[BASE + 5]), b1 = cvt_pk_bf16(P[BASE + 6], P[BASE + 7]);                              \
    auto r0 = __builtin_amdgcn_permlane32_swap(a0, b0, false, false); auto r1 = __builtin_amdgcn_permlane32_swap(a1, b1, false, false); \
    u32x4 w = {r0[0], r1[0], r0[1], r1[1]}; OUT = *reinterpret_cast<bf16x8*>(&w); } while (0)
    PK4(p0, 0, pa0); PK4(p0, 8, pa1); PK4(p1, 0, pa2); PK4(p1, 8, pa3);
#undef PK4
}
constexpr float SM_THR = 6.0f;
__device__ __forceinline__ void softmax_far(f32x16& p0, f32x16& p1, const float b, float& m_reg, float& l_reg, float& alpha, bf16x8& pa0, bf16x8& pa1, bf16x8& pa2, bf16x8& pa3) {
    float pmax = p0[0];
#pragma unroll
    for (int r = 1; r < 16; ++r) pmax = fmaxf(pmax, p0[r]);
#pragma unroll
    for (int r = 0; r < 16; ++r) pmax = fmaxf(pmax, p1[r]);
    { auto rr = __builtin_amdgcn_permlane32_swap(__float_as_uint(pmax), __float_as_uint(pmax), false, false);
      pmax = fmaxf(__uint_as_float(rr[0]), __uint_as_float(rr[1])); }
    const float pm = fmaf(pmax, ATT_C, b);
    if (__all(pm - m_reg <= SM_THR)) { alpha = 1.0f; }
    else { const float mn = fmaxf(m_reg, pm); alpha = __builtin_amdgcn_exp2f(m_reg - mn); m_reg = mn; }
    const float c = b - m_reg;
#pragma unroll
    for (int r = 0; r < 16; ++r) p0[r] = __builtin_amdgcn_exp2f(fmaf(p0[r], ATT_C, c));
#pragma unroll
    for (int r = 0; r < 16; ++r) p1[r] = __builtin_amdgcn_exp2f(fmaf(p1[r], ATT_C, c));
    float ps = 0.f;
#pragma unroll
    for (int r = 0; r < 16; ++r) ps += p0[r];
#pragma unroll
    for (int r = 0; r < 16; ++r) ps += p1[r];
    { auto rr = __builtin_amdgcn_permlane32_swap(__float_as_uint(ps), __float_as_uint(ps), false, false);
      ps = __uint_as_float(rr[0]) + __uint_as_float(rr[1]); }
    l_reg = l_reg * alpha + ps;
#define PK4(P, BASE, OUT) do { unsigned a0 = cvt_pk_bf16(P[BASE + 0], P[BASE + 1]), a1 = cvt_pk_bf16(P[BASE + 2], P[BASE + 3]);   \
    unsigned b0 = cvt_pk_bf16(P[BASE + 4], P[BASE + 5]), b1 = cvt_pk_bf16(P[BASE + 6], P[BASE + 7]);                              \
    auto r0 = __builtin_amdgcn_permlane32_swap(a0, b0, false, false); auto r1 = __builtin_amdgcn_permlane32_swap(a1, b1, false, false); \
    u32x4 w = {r0[0], r1[0], r0[1], r1[1]}; OUT = *reinterpret_cast<bf16x8*>(&w); } while (0)
    PK4(p0, 0, pa0); PK4(p0, 8, pa1); PK4(p1, 0, pa2); PK4(p1, 8, pa3);
#undef PK4
}
#ifndef ATT_CPRIO
#define ATT_CPRIO 1
#endif
#ifndef ATT_SPRIO
#define ATT_SPRIO 0
#endif
__device__ __forceinline__ bf16x8 lds_rd128(unsigned a) { bf16x8 r; asm volatile("ds_read_b128 %0, %1" : "=&v"(r) : "v"(a) : "memory"); return r; }
__device__ __forceinline__ void qkt_h(f32x16& p, const LAS unsigned char* Ks32, const bf16x8 (&qr)[8], int r32, int hi) {
    p = (f32x16){0.f, 0.f, 0.f, 0.f, 0.f, 0.f, 0.f, 0.f, 0.f, 0.f, 0.f, 0.f, 0.f, 0.f, 0.f, 0.f};
    const unsigned kb = (unsigned)(uintptr_t)Ks32 + (unsigned)r32 * 256u; const unsigned sw = (unsigned)(r32 & 7) << 4, h16 = (unsigned)hi * 16u;
#define KA(d0) (kb + ((((unsigned)(d0)) * 32u + h16) ^ sw))
#define WTK(N, F) asm volatile("s_waitcnt lgkmcnt(" #N ")" : "+v"(F) :: "memory")
#define MMK(F, d0) p = __builtin_amdgcn_mfma_f32_32x32x16_bf16(F, qr[d0], p, 0, 0, 0)
    bf16x8 f0 = lds_rd128(KA(0)), f1 = lds_rd128(KA(1));
    if (ATT_CPRIO) __builtin_amdgcn_s_setprio(1);
    WTK(1, f0); MMK(f0, 0); f0 = lds_rd128(KA(2));
    WTK(1, f1); MMK(f1, 1); f1 = lds_rd128(KA(3));
    WTK(1, f0); MMK(f0, 2); f0 = lds_rd128(KA(4));
    WTK(1, f1); MMK(f1, 3); f1 = lds_rd128(KA(5));
    WTK(1, f0); MMK(f0, 4); f0 = lds_rd128(KA(6));
    WTK(1, f1); MMK(f1, 5); f1 = lds_rd128(KA(7));
    WTK(1, f0); MMK(f0, 6);
    WTK(0, f1); MMK(f1, 7);
    if (ATT_CPRIO) __builtin_amdgcn_s_setprio(0);
#undef KA
#undef WTK
#undef MMK
}
#define PK4H(P, BASE, OUT) do { unsigned a0_ = cvt_pk_bf16(P[BASE + 0], P[BASE + 1]), a1_ = cvt_pk_bf16(P[BASE + 2], P[BASE + 3]);   \
    unsigned b0_ = cvt_pk_bf16(P[BASE + 4], P[BASE + 5]), b1_ = cvt_pk_bf16(P[BASE + 6], P[BASE + 7]);                              \
    auto r0_ = __builtin_amdgcn_permlane32_swap(a0_, b0_, false, false); auto r1_ = __builtin_amdgcn_permlane32_swap(a1_, b1_, false, false); \
    u32x4 w_ = {r0_[0], r1_[0], r0_[1], r1_[1]}; OUT = *reinterpret_cast<bf16x8*>(&w_); } while (0)
struct NoHook16 { __device__ __forceinline__ void operator()(int) const {} };
#ifndef PV16
#define PV16 1
#endif
__device__ __forceinline__ void sm_tail_h(f32x16& p, const float alpha, float& l_reg, bf16x8& pa0, bf16x8& pa1) {
#pragma unroll
    for (int r = 0; r < 16; ++r) p[r] = __builtin_amdgcn_exp2f(p[r]);
    float ps = 0.f;
#pragma unroll
    for (int r = 0; r < 16; ++r) ps += p[r];
    { auto rr = __builtin_amdgcn_permlane32_swap(__float_as_uint(ps), __float_as_uint(ps), false, false);
      ps = __uint_as_float(rr[0]) + __uint_as_float(rr[1]); }
    l_reg = l_reg * alpha + ps;
#if PV16
    { const unsigned a0 = cvt_pk_bf16(p[0], p[1]), a1 = cvt_pk_bf16(p[2], p[3]), a2 = cvt_pk_bf16(p[4], p[5]), a3 = cvt_pk_bf16(p[6], p[7]);
      const unsigned b0 = cvt_pk_bf16(p[8], p[9]), b1 = cvt_pk_bf16(p[10], p[11]), b2 = cvt_pk_bf16(p[12], p[13]), b3 = cvt_pk_bf16(p[14], p[15]);
      auto s0 = __builtin_amdgcn_permlane16_swap(a0, b0, false, false); auto s1 = __builtin_amdgcn_permlane16_swap(a1, b1, false, false);
      auto s2 = __builtin_amdgcn_permlane16_swap(a2, b2, false, false); auto s3 = __builtin_amdgcn_permlane16_swap(a3, b3, false, false);
      u32x4 w0 = {s0[0], s1[0], s2[0], s3[0]}, w1 = {s0[1], s1[1], s2[1], s3[1]};
      pa0 = *reinterpret_cast<bf16x8*>(&w0); pa1 = *reinterpret_cast<bf16x8*>(&w1); }
#else
    PK4H(p, 0, pa0); PK4H(p, 8, pa1);
#endif
}
__device__ __forceinline__ void pair16(float x, float& q0, float& q1) {
    auto rr = __builtin_amdgcn_permlane16_swap(__float_as_uint(x), __float_as_uint(x), false, false); q0 = __uint_as_float(rr[0]); q1 = __uint_as_float(rr[1]);
}
__device__ __forceinline__ int v_rd_base16(int lane) { return ((lane >> 5) & 1) * 4096 + (4 * ((lane >> 4) & 1) + ((lane >> 2) & 3)) * 32 + (lane & 3) * 8; }
template <class Hook = NoHook16> __device__ __forceinline__ void pv_half16(f32x4 (&o)[16][2], unsigned vb, bf16x8 pq0, bf16x8 pq1, const Hook& hook = Hook()) {
#define VRO(db, u) ((u) * 8192 + (db) * 256)
#define RD2(db, A, B) do { A = tr_read<VRO(db, 0)>(vb); B = tr_read<VRO(db, 1)>(vb); } while (0)
#define PK(L, H) (bf16x8){L[0], L[1], L[2], L[3], H[0], H[1], H[2], H[3]}
#define MM(db, A, B) do { const bf16x8 vf_ = PK(A, B); o[db][0] = __builtin_amdgcn_mfma_f32_16x16x32_bf16(vf_, pq0, o[db][0], 0, 0, 0); o[db][1] = __builtin_amdgcn_mfma_f32_16x16x32_bf16(vf_, pq1, o[db][1], 0, 0, 0); } while (0)
#define WT2(A, B) asm volatile("s_waitcnt lgkmcnt(2)" : "+v"(A), "+v"(B) :: "memory")
#define WT4(A, B) asm volatile("s_waitcnt lgkmcnt(4)" : "+v"(A), "+v"(B) :: "memory")
#define WT0(A, B) asm volatile("s_waitcnt lgkmcnt(0)" : "+v"(A), "+v"(B) :: "memory")
    s16x4 a0, a1, b0, b1, c0, c1;
    RD2(0, a0, a1); RD2(1, b0, b1);
    if (ATT_CPRIO) __builtin_amdgcn_s_setprio(1);
    RD2(2, c0, c1); WT4(a0, a1); MM(0, a0, a1);
    RD2(3, a0, a1); WT4(b0, b1); MM(1, b0, b1); hook(0);
    RD2(4, b0, b1); WT4(c0, c1); MM(2, c0, c1);
    RD2(5, c0, c1); WT4(a0, a1); MM(3, a0, a1);
    RD2(6, a0, a1); WT4(b0, b1); MM(4, b0, b1);
    RD2(7, b0, b1); WT4(c0, c1); MM(5, c0, c1); hook(1);
    RD2(8, c0, c1); WT4(a0, a1); MM(6, a0, a1);
    RD2(9, a0, a1); WT4(b0, b1); MM(7, b0, b1);
    RD2(10, b0, b1); WT4(c0, c1); MM(8, c0, c1);
    RD2(11, c0, c1); WT4(a0, a1); MM(9, a0, a1); hook(2);
    RD2(12, a0, a1); WT4(b0, b1); MM(10, b0, b1);
    RD2(13, b0, b1); WT4(c0, c1); MM(11, c0, c1);
    RD2(14, c0, c1); WT4(a0, a1); MM(12, a0, a1);
    RD2(15, a0, a1); WT4(b0, b1); MM(13, b0, b1); hook(3);
    WT2(c0, c1); MM(14, c0, c1);
    WT0(a0, a1); MM(15, a0, a1);
    if (ATT_CPRIO) __builtin_amdgcn_s_setprio(0);
#undef VRO
#undef RD2
#undef PK
#undef MM
#undef WT2
#undef WT4
#undef WT0
}
__device__ __forceinline__ float rowmax_h(const f32x16& p) {
    float pmax = p[0];
#pragma unroll
    for (int r = 1; r < 16; ++r) pmax = fmaxf(pmax, p[r]);
    auto rr = __builtin_amdgcn_permlane32_swap(__float_as_uint(pmax), __float_as_uint(pmax), false, false);
    return fmaxf(__uint_as_float(rr[0]), __uint_as_float(rr[1]));
}
__device__ __forceinline__ float sm_decide(const float pm, float& m_reg) {
    if (__all(pm - m_reg <= SM_THR)) return 1.0f;
    const float mn = fmaxf(m_reg, pm); const float alpha = __builtin_amdgcn_exp2f(m_reg - mn); m_reg = mn; return alpha;
}
__device__ __forceinline__ void softmax_far_h(f32x16& p, const float b, float& m_reg, float& l_reg, float& alpha, bf16x8& pa0, bf16x8& pa1) {
    const float pm = fmaf(rowmax_h(p), ATT_C, b);
    alpha = sm_decide(pm, m_reg);
    const float c = b - m_reg;
#pragma unroll
    for (int r = 0; r < 16; ++r) p[r] = fmaf(p[r], ATT_C, c);
    sm_tail_h(p, alpha, l_reg, pa0, pa1);
}
__device__ __forceinline__ void softmax_near_h(f32x16& p, float& m_reg, float& l_reg, float& alpha, bf16x8& pa0, bf16x8& pa1) {
    alpha = sm_decide(rowmax_h(p), m_reg);
#pragma unroll
    for (int r = 0; r < 16; ++r) p[r] = p[r] - m_reg;
    sm_tail_h(p, alpha, l_reg, pa0, pa1);
}
template <int D0, int NCB, int HF> __device__ __forceinline__ void pv_half(f32x16& od, unsigned vb, bf16x8 pa0, bf16x8 pa1) {
#define VRO(ks, half) (D0 * 512 + (ks) * (NCB * 1024) + (half) * (NCB * 512))
    const s16x4 l0 = tr_read<VRO(2 * HF, 0)>(vb), h0 = tr_read<VRO(2 * HF, 1)>(vb), l1 = tr_read<VRO(2 * HF + 1, 0)>(vb), h1 = tr_read<VRO(2 * HF + 1, 1)>(vb);
#undef VRO
    asm volatile("s_waitcnt lgkmcnt(0)" ::: "memory"); SBAR();
#define PK(L, H) (bf16x8){L[0], L[1], L[2], L[3], H[0], H[1], H[2], H[3]}
    od = __builtin_amdgcn_mfma_f32_32x32x16_bf16(pa0, PK(l0, h0), od, 0, 0, 0);
    od = __builtin_amdgcn_mfma_f32_32x32x16_bf16(pa1, PK(l1, h1), od, 0, 0, 0);
#undef PK
}
struct NoHook { __device__ __forceinline__ void operator()(int) const {} };
template <int HF, class Hook = NoHook> __device__ __forceinline__ void pv_half8(f32x16 (&o)[8], unsigned vb, bf16x8 pa0, bf16x8 pa1, const Hook& hook = Hook()) {
#define VRO(d0, ks, half) ((d0) * 512 + (ks) * (8 * 1024) + (half) * (8 * 512))
#define RD4(d0, A, B, C, D) do { A = tr_read<VRO(d0, 2 * HF, 0)>(vb); B = tr_read<VRO(d0, 2 * HF, 1)>(vb); C = tr_read<VRO(d0, 2 * HF + 1, 0)>(vb); D = tr_read<VRO(d0, 2 * HF + 1, 1)>(vb); } while (0)
#define PK(L, H) (bf16x8){L[0], L[1], L[2], L[3], H[0], H[1], H[2], H[3]}
#define MM(d0, A, B, C, D) do { o[d0] = __builtin_amdgcn_mfma_f32_32x32x16_bf16(pa0, PK(A, B), o[d0], 0, 0, 0); o[d0] = __builtin_amdgcn_mfma_f32_32x32x16_bf16(pa1, PK(C, D), o[d0], 0, 0, 0); } while (0)
#define WT4(A, B, C, D) asm volatile("s_waitcnt lgkmcnt(4)" : "+v"(A), "+v"(B), "+v"(C), "+v"(D) :: "memory")
#define WT0(A, B, C, D) asm volatile("s_waitcnt lgkmcnt(0)" : "+v"(A), "+v"(B), "+v"(C), "+v"(D) :: "memory")
    s16x4 a0, a1, a2, a3, b0, b1, b2, b3;
    RD4(0, a0, a1, a2, a3);
    if (ATT_CPRIO) __builtin_amdgcn_s_setprio(1);
    RD4(1, b0, b1, b2, b3); WT4(a0, a1, a2, a3); MM(0, a0, a1, a2, a3); hook(0);
    RD4(2, a0, a1, a2, a3); WT4(b0, b1, b2, b3); MM(1, b0, b1, b2, b3);
    RD4(3, b0, b1, b2, b3); WT4(a0, a1, a2, a3); MM(2, a0, a1, a2, a3); hook(1);
    RD4(4, a0, a1, a2, a3); WT4(b0, b1, b2, b3); MM(3, b0, b1, b2, b3);
    RD4(5, b0, b1, b2, b3); WT4(a0, a1, a2, a3); MM(4, a0, a1, a2, a3); hook(2);
    RD4(6, a0, a1, a2, a3); WT4(b0, b1, b2, b3); MM(5, b0, b1, b2, b3);
    RD4(7, b0, b1, b2, b3); WT4(a0, a1, a2, a3); MM(6, a0, a1, a2, a3); hook(3);
    WT0(b0, b1, b2, b3); MM(7, b0, b1, b2, b3);
    if (ATT_CPRIO) __builtin_amdgcn_s_setprio(0);
#undef VRO
#undef RD4
#undef PK
#undef MM
#undef WT4
#undef WT0
}
__device__ __forceinline__ void k_src(int b, int& row, int& col) { row = b >> 8; const int cb = (b & 255) ^ ((row & 7) << 4); col = cb >> 1; }
template <int NCB> __device__ __forceinline__ void v_src(int b, int& key, int& col) {
    const int st = b >> 9, e = (b & 511) >> 1; const int kk = (st / NCB) * 8 + (e >> 5); key = swap23(kk); col = (st % NCB) * 32 + (e & 31);
}
__device__ __forceinline__ void glds16(const void* g, LAS unsigned char* l) { __builtin_amdgcn_global_load_lds((const unsigned*)g, (LAS unsigned*)l, 16, 0, 0); }

__device__ __forceinline__ const void* karg_ptr(int off) {
    asm volatile("" : "+s"(off));
    const __attribute__((address_space(4))) char* ka = (const __attribute__((address_space(4))) char*)__builtin_amdgcn_kernarg_segment_ptr();
    return *(const void* const __attribute__((address_space(4)))*)(ka + off);
}
#define KIN(i) ((const float*)karg_ptr(8 * (i)))
#define KOUT() ((float*)karg_ptr(152))
#define KWS() ((unsigned char*)karg_ptr(160))

struct Args { const float* in[19]; float* out; unsigned char* ws; };

__global__ void __launch_bounds__(512, 2) mega_fwd(Args args) {
    extern __shared__ __attribute__((aligned(16))) unsigned char lds_raw[];
    Frame F; F.lds = (LAS unsigned char*)lds_raw;
    F.wave = __builtin_amdgcn_readfirstlane(threadIdx.x >> 6);
    F.G = gridDim.x; { const int bx = blockIdx.x; F.vcu = (F.G % 8 == 0) ? (bx % 8) * (F.G / 8) + bx / 8 : bx; }
    volatile LAS unsigned* MISC = (volatile LAS unsigned*)(F.lds + EX_MISC);
    if (threadIdx.x < 64) MISC[threadIdx.x] = 0u;
    __syncthreads();
    (void)xcd_barrier_post((unsigned*)KWS() + CW_BAR, MISC + 8);
#ifndef PH_MASK
#define PH_MASK 0x3FFF
#endif
#define IN(k) ((PH_MASK >> (k)) & 1)
#ifndef REP_PHASE
#define REP_PHASE -1
#endif
#define REPS(k) _Pragma("unroll 1") for (int rep_ = 0; rep_ < ((REP_PHASE) == (k) ? 2 : 1); ++rep_)
#define SEAMX(a_, b_) do { if (IN(a_) && IN(b_)) { XcdBarrier b_x; b_x.bar = (unsigned*)KWS() + CW_BAR; b_x.x = xb_xcc_id(); b_x.st = MISC + 8; xcd_barrier(b_x); } } while (0)
#define SEAM(k) do { if (IN(k) && IN((k) + 1)) { XcdBarrier b_; b_.bar = (unsigned*)KWS() + CW_BAR; b_.x = xb_xcc_id(); b_.st = MISC + 8; xcd_barrier(b_); } } while (0)
#define P_XPROMPT KIN(0)
#define P_XSAMPLE KIN(1)
#define P_SSQ ((float*)(KWS() + WS_CTL + CTL_SSQ))
#define P_X KOUT()
#define P_WS(off) ((bf16*)(KWS() + (off)))

    if (IN(0)) REPS(0) {
        const float* x_prompt = KIN(0); const float* x_sample = KIN(1); const float* norm_mix = KIN(2); const float* norm_ffn = KIN(3);
        const float* w_in_even = KIN(4); const float* w_out_even = KIN(6); const float* w_in_odd = KIN(7); const float* w_out_odd = KIN(13);
        const float* w_gate = KIN(15); const float* w_up = KIN(16); const float* w_down = KIN(17);
        unsigned char* ws = KWS(); float* ssq = (float*)(ws + WS_CTL + CTL_SSQ); unsigned* ctl = (unsigned*)ws;
        bf16* WIE = (bf16*)(ws + WS_WIE); bf16* WOE = (bf16*)(ws + WS_WOE); bf16* WIO = (bf16*)(ws + WS_WIO); bf16* WOO = (bf16*)(ws + WS_WOO);
        bf16* WGU0 = (bf16*)(ws + WS_WGU0); bf16* WGU1 = (bf16*)(ws + WS_WGU1); bf16* WD0 = (bf16*)(ws + WS_WD0); bf16* WD1 = (bf16*)(ws + WS_WD1);
        bf16* XB = (bf16*)(ws + WS_XB);
        unsigned char* outb = (unsigned char*)KOUT(); bf16* T8 = (bf16*)(outb + DO_T8); bf16* T2 = (bf16*)(outb + DO_T2); bf16* FC = (bf16*)(outb + DO_FC);
        const int p0lane = lane_id_opaque(), p0tid = F.wave * 64 + p0lane;
        LAS float* scr = (LAS float*)(F.lds + F.wave * 16384);
        const int gw = F.vcu * 8 + F.wave, NGW = F.G * 8;
        const size_t WFF = (size_t)DM * FF;
        {
            constexpr int I0 = 64 * 256, I1 = 64 * 128, I2 = 64 * 384, I3 = 64 * 128, IG = 64 * 344, ID = 172 * 128;
            constexpr int NITEMS = I0 + I1 + I2 + I3 + 4 * IG + 2 * ID;
#define P0_ISSUE(X, it_) do { int r = (it_); WJob j; \
                if (r < I0) j = WJob{w_in_even, norm_mix, WIE, DM, EVEN_IN, 0}; \
                else if ((r -= I0) < I1) j = WJob{w_out_even, nullptr, WOE, DM, DM, 0}; \
                else if ((r -= I1) < I2) j = WJob{w_in_odd, norm_mix + DM, WIO, DM, ODD_IN, 0}; \
                else if ((r -= I2) < I3) j = WJob{w_out_odd, nullptr, WOO, DM, DM, 0}; \
                else if ((r -= I3) < IG) j = WJob{w_gate, norm_ffn, WGU0, DM, FF, 1}; \
                else if ((r -= IG) < IG) j = WJob{w_up, norm_ffn, WGU0, DM, FF, 2}; \
                else if ((r -= IG) < IG) j = WJob{w_gate + WFF, norm_ffn + DM, WGU1, DM, FF, 1}; \
                else if ((r -= IG) < IG) j = WJob{w_up + WFF, norm_ffn + DM, WGU1, DM, FF, 2}; \
                else if ((r -= IG) < ID) j = WJob{w_down, nullptr, WD0, FF, DM, 0}; \
                else { r -= ID; j = WJob{w_down + WFF, nullptr, WD1, FF, DM, 0}; } \
                const int nblk = j.N / 32, kb = r / nblk, nb = r % nblk, n0 = nb * 32; \
                wt##X = j.WT; ldw##X = j.K == DM ? LDX : j.K; k0##X = kb * 64; dr##X = j.mode == 0 ? n0 : (256 * (n0 >> 7) + (n0 & 127) + (j.mode == 2 ? 128 : 0)); \
                p0_load(v##X, g##X, j.W, j.N, j.g, kb * 64, n0, p0lane); } while (0)
            f32x4 vA[8], vB[8]; float gA[8], gB[8]; bf16* wtA = nullptr; bf16* wtB = nullptr; int ldwA = 0, ldwB = 0, k0A = 0, k0B = 0, drA = 0, drB = 0;
            if (gw < NITEMS) P0_ISSUE(A, gw);
            for (int it = gw; it < NITEMS; it += 2 * NGW) {
                const bool hasB = it + NGW < NITEMS, hasA2 = it + 2 * NGW < NITEMS;
                if (hasB) P0_ISSUE(B, it + NGW);
                p0_store(vA, gA, wtA, ldwA, k0A, drA, scr, p0lane);
                if (hasA2) P0_ISSUE(A, it + 2 * NGW);
                if (hasB) p0_store(vB, gB, wtB, ldwB, k0B, drB, scr, p0lane);
            }
#undef P0_ISSUE
        }
        for (int m = gw; m < NTOK; m += NGW) {
            const float* xr = (m < NTOK_P ? x_prompt + (size_t)m * DM : x_sample + (size_t)(m - NTOK_P) * DM);
            float s = 0.f;
#pragma unroll 4
            for (int j = 0; j < 16; ++j) { const f32x4 v = *(const f32x4*)(xr + j * 256 + p0lane * 4);
                s += (v[0] * v[0] + v[1] * v[1]) + (v[2] * v[2] + v[3] * v[3]);
                u32x2 w; w.x = cvt_pk_bf16(v[0], v[1]); w.y = cvt_pk_bf16(v[2], v[3]); *(u32x2*)(XB + (size_t)m * LDX + j * 256 + p0lane * 4) = w; }
            s = wave_sum(s);
            if (p0lane == 0) ssq[m] = s;
        }
        {
            const long gt = (long)F.vcu * 512 + p0tid, NGT = (long)F.G * 512;
            constexpr long C8 = 2L * 4096 * 8192 / 8, C2 = 2L * 1024 * 2048 / 8, CF = 1024L * 512 / 8, CS = DFT_HERM ? 4L * 4096 * 2048 / 8 : 0;
            bf16* T8S = (bf16*)(outb + DO_T8S);
            for (long ch = gt; ch < C8 + C2 + CF + CS; ch += NGT) {
                bf16* dst; int k, j0, S; bool sn;
                if (ch >= C8 + C2 + CF) { const long c = ch - (C8 + C2 + CF); const int kc = (int)(c / (4096L * 256)); const long c1 = c % (4096L * 256); k = (int)(c1 / 256); const int jj = (int)(c1 % 256) * 8; j0 = kc * 2048 + jj; S = 8192; sn = false; dst = T8S + ((size_t)kc * 4096 + k) * 2048 + jj; } else
                if (ch < C8) { const int wh = (int)(ch / (4096L * 1024)); const long c = ch % (4096L * 1024); k = (int)(c / 1024); j0 = (int)(c % 1024) * 8; S = 8192; sn = wh != 0; dst = T8 + ((size_t)wh * 4096 + k) * 8192 + j0; }
                else if (ch < C8 + C2) { const long c0 = ch - C8; const int wh = (int)(c0 / (1024L * 256)); const long c = c0 % (1024L * 256); k = (int)(c / 256); j0 = (int)(c % 256) * 8; S = 2048; sn = wh != 0; dst = T2 + ((size_t)wh * 1024 + k) * 2048 + j0; }
                else { const long c = ch - C8 - C2; k = (int)(c / 64); j0 = (int)(c % 64) * 8; S = 512; sn = k >= 512; if (sn) k -= 512; dst = FC + (size_t)(sn ? k + 512 : k) * 512 + j0; }
                float v[8];
#pragma unroll
                for (int e = 0; e < 8; ++e) { const int r = (k * (j0 + e)) & (S - 1); const float fr = (float)r / (float)S;
                    v[e] = sn ? __builtin_amdgcn_sinf(fr) : __builtin_amdgcn_cosf(fr); }
                u32x4 w; w.x = cvt_pk_bf16(v[0], v[1]); w.y = cvt_pk_bf16(v[2], v[3]); w.z = cvt_pk_bf16(v[4], v[5]); w.w = cvt_pk_bf16(v[6], v[7]);
                *(u32x4*)dst = w;
            }
        }
        if (blockIdx.x == 0 && F.wave == 0) {
            float a = 0.f, b = 0.f;
            const float* lambda_q1 = KIN(8); const float* lambda_k1 = KIN(9); const float* lambda_q2 = KIN(10); const float* lambda_k2 = KIN(11);
            for (int i = p0lane; i < 128; i += 64) { a += lambda_q1[i] * lambda_k1[i]; b += lambda_q2[i] * lambda_k2[i]; }
            a = wave_sum(a); b = wave_sum(b);
            if (p0lane == 0) ((float*)ctl)[CW_LAM] = __expf(a) - __expf(b) + LAM_INIT;
        }
    }
    SEAM(0);

    if (IN(1)) REPS(1) {
        unsigned char* ws = KWS(); float* ssq = (float*)(ws + WS_CTL + CTL_SSQ); bf16* XB = (bf16*)(ws + WS_XB); bf16* WIE = (bf16*)(ws + WS_WIE); bf16* PROJ = (bf16*)(ws + WS_PROJ);
        gm::GridOrder S; S.init(NTOK, EVEN_IN, F.G, (int)blockIdx.x, XB, (size_t)LDX * 2, WIE, (size_t)LDX * 2, PROJ, EVEN_IN, 2);
        gm::EpiBf16 E{ssq, 1.0f};
        gm::gemm_phase(F.lds, F.wave, DM, LDX, LDX, S, E);
    }
    SEAM(1);

    if (IN(2)) REPS(2) {
        unsigned char* ws = KWS(); bf16* PROJ = (bf16*)(ws + WS_PROJ); bf16* VT = (bf16*)(ws + WS_VT); bf16* MIX = (bf16*)(ws + WS_MIX);
        bf16* FC = (bf16*)((unsigned char*)KOUT() + DO_FC); const float* rpb_na = KIN(5);
        {
            struct Sch { int G, c; const bf16* FC; const bf16* PROJ; bf16* VT;
                __device__ __forceinline__ bool next(int i, gm::Unit& u) const {
                    int q, g, pm, pn;
#if DFT_HERM
                    const int L = i * G + c; if (L >= 768) return false;
                    if (L < 512) { q = L >> 8; const int r = L & 255; g = r >> 6; pm = ((r >> 5) & 1) * 2; pn = r & 31; }
                    else { const int l2 = L - 512; q = 2 + (l2 >> 6); const int r = l2 & 63; g = r >> 4; pm = ((r >> 3) & 1) * 2; pn = r & 7; }
#else
                    const int L = i * G + c; if (L >= 1536) return false;
                    if (L < 1024) { q = L >> 9; const int r = L & 511; g = r >> 7; pm = (r >> 5) & 3; pn = r & 31; }
                    else { const int l2 = L - 1024; q = 2 + (l2 >> 7); const int r = l2 & 127; g = r >> 5; pm = (r >> 3) & 3; pn = r & 7; }
#endif
                    const SeqInfo si = seq_info(q);
                    u.A = (const char*)(FC + (size_t)pm * 256 * 512);
                    u.B = (const char*)(PROJ + (size_t)(si.row0 + pn * 256) * EVEN_IN + 6144 + g * 512);
                    u.ldc = 2 * si.S; u.row0 = 0; u.col0 = 0;
                    u.C = (char*)(VT + (size_t)4096 * si.row0 + (size_t)(g * 512 + (pm & 1) * 256) * (2 * si.S) + (size_t)(pm >> 1) * si.S + pn * 256);
                    return true; } };
            Sch S{F.G, (int)blockIdx.x, FC, PROJ, VT};
            gm::EpiBf16 E{nullptr, 1.0f};
            gm::gemm_phase(F.lds, F.wave, 512, 512, EVEN_IN, S, E);
        }
#if DFT_HERM
        {
            unsigned char* outb = (unsigned char*)KOUT(); bf16* WSP = (bf16*)(outb + DO_WSP); float* WS2 = (float*)(outb + DO_WS2);
            const int lane = lane_id_opaque(), gw = F.vcu * 8 + F.wave, NGW = F.G * 8;
            for (int tok = gw; tok < NTOK; tok += NGW) {
                const bf16* ur = PROJ + (size_t)tok * EVEN_IN + 6144 + lane * 8; float acc4[4];
#pragma unroll
                for (int g = 0; g < 4; ++g) { const u32x4 v = *(const u32x4*)(ur + g * 512); float a = 0.f;
#pragma unroll
                    for (int e = 0; e < 4; ++e) a += __uint_as_float(v[e] << 16) - __uint_as_float(v[e] & 0xffff0000u);
                    acc4[g] = wave_sum(a); }
                if (lane < 4) { const float wv = lane == 0 ? acc4[0] : lane == 1 ? acc4[1] : lane == 2 ? acc4[2] : acc4[3];
                    if (tok < NTOK_P) { const int q = tok >> 13, s_ = tok & 8191; WSP[((size_t)(q * 4 + (s_ >> 11)) * 256 + lane) * 4096 + (s_ & 2047)] = (bf16)(cvt_pk_bf16(wv, 0.f) & 0xffffu); }
                    else { const int t2 = tok - NTOK_P; WS2[((t2 >> 11) * 4 + lane) * 2048 + (t2 & 2047)] = wv; } }
            }
        }
#endif
        {
            const int w = F.wave, rsel = w >> 2, hh = (w >> 1) & 1, c0 = 32 * (w & 1);
            LAS float* tab = (LAS float*)(F.lds + EX_TAB);
            LAS float* wsl = (LAS float*)(F.lds + EX_WS) + w * 64;
            const int upw = 1536 / F.G;
            const bool chunked = upw * F.G == 1536;
            for (int U = chunked ? F.vcu * upw : F.vcu; U < (chunked ? (F.vcu + 1) * upw : 1536); U += chunked ? 1 : F.G) {
                int q, hp, rp;
                if (U < 1024) { q = U >> 9; const int t = U & 511; hp = t >> 6; rp = t & 63; } else { const int t2 = U - 1024; q = 2 + (t2 >> 7); const int t = t2 & 127; hp = t >> 4; rp = t & 15; }
                const SeqInfo si = seq_info(q); const int rows = si.S >> 6;
                const int lane = lane_id_opaque(), tid = w * 64 + lane, r32 = lane & 31, hi = lane >> 5;
                const int r0 = 2 * rp, r = r0 + rsel;
                int rs0 = r0 - 4; rs0 = rs0 < 0 ? 0 : (rs0 > rows - 8 ? rows - 8 : rs0);
                int rs1 = r0 - 3; rs1 = rs1 < 0 ? 0 : (rs1 > rows - 8 ? rows - 8 : rs1);
                const int rsw = rsel ? rs1 : rs0, nrow = rs1 + 8 - rs0;
                const int h = 2 * hp + hh;
                __syncthreads();
                for (int e = tid; e < 2 * 2 * 8 * 32; e += 512) { const int dc = e & 31, i = (e >> 5) & 7, hd = (e >> 8) & 1, rsl = e >> 9; const int dr = (rsl ? rs1 : rs0) + i - (r0 + rsl) + 7;
                    tab[e] = dc < 31 ? rpb_na[((size_t)(2 * hp + hd) * 15 + dr) * 31 + dc] * LOG2E : 0.f; }
                bf16x8 qr[8];
                { const bf16* Qw = PROJ + (size_t)(si.row0 + r * 64 + c0 + r32) * EVEN_IN + h * 128 + hi * 8;
#pragma unroll
                  for (int d0 = 0; d0 < 8; ++d0) qr[d0] = *(const bf16x8*)(Qw + d0 * 16); }
                float m_reg = -1e30f, l_reg = 0.f; f32x16 o[4];
#pragma unroll
                for (int d = 0; d < 4; ++d) o[d] = (f32x16){0.f, 0.f, 0.f, 0.f, 0.f, 0.f, 0.f, 0.f, 0.f, 0.f, 0.f, 0.f, 0.f, 0.f, 0.f, 0.f};
                const int c = c0 + r32; int cs = c - 8; cs = cs < 0 ? 0 : (cs > 48 ? 48 : cs);
                constexpr unsigned LDE = EVEN_IN * 2;
                unsigned offA, offB;
                if (w < 4) { offA = (unsigned)(lane >> 4) * LDE + (unsigned)(((lane & 15) ^ ((lane >> 4) & 7)) << 4); offB = (unsigned)(lane >> 4) * LDE + (unsigned)(((lane & 15) ^ ((4 + (lane >> 4)) & 7)) << 4); }
                else { const int t = (lane & 31) >> 2; offA = (unsigned)((t & 3) + 8 * (t >> 2)) * LDE + (unsigned)(32 * hi + 8 * (lane & 3)) * 2u; offB = offA; }
                const char* kvb = (const char*)(PROJ + (size_t)si.row0 * EVEN_IN + (w < 4 ? 2048 : 4096) + (2 * hp + ((w >> 1) & 1)) * 128);
#define NA_DMA(kr_, bs_) do { const char* tb_ = kvb + (size_t)((kr_) * 64) * LDE; LAS unsigned char* dst_ = F.lds + (bs_) * 65536 + (w >> 1) * 16384 + (w & 1) * 8192; \
                if (w < 4) { _Pragma("unroll") for (int j_ = 0; j_ < 8; ++j_) glds16(tb_ + (size_t)(4 * (8 * (w & 1) + j_)) * LDE + ((j_ & 1) ? offB : offA), dst_ + j_ * 1024); } \
                else { _Pragma("unroll") for (int j_ = 0; j_ < 8; ++j_) { const int pi_ = 8 * (w & 1) + j_; glds16(tb_ + (size_t)(4 * ((pi_ >> 1) & 1) + 16 * (pi_ >> 2)) * LDE + 128 * (pi_ & 1) + offA, dst_ + j_ * 1024); } } } while (0)
                NA_DMA(rs0, 0);
                for (int t = 0; t < nrow; ++t) {
                    asm volatile("s_waitcnt vmcnt(0) lgkmcnt(0)" ::: "memory"); __builtin_amdgcn_s_barrier(); asm volatile("" ::: "memory");
                    if (t + 1 < nrow) NA_DMA(rs0 + t + 1, (t + 1) & 1);
                    const int i = rs0 + t - rsw;
                    if (i >= 0 && i < 8) {
                        const LAS unsigned char* Kl = F.lds + (t & 1) * 65536 + hh * 16384; const unsigned vb = (unsigned)(uintptr_t)(F.lds + (t & 1) * 65536 + 32768 + hh * 16384) + v_rd_base(lane);
                        f32x16 p0, p1; LDS_WAIT(); qkt(p0, p1, Kl, qr, r32, hi);
                        const LAS float* tb = tab + ((rsel * 2 + hh) * 8 + i) * 32;
#pragma unroll
                        for (int rr = 0; rr < 16; ++rr) {
                            { const int kc = crow(rr, hi); const bool ok = (unsigned)(kc - cs) < 16u; const int dc = kc - c + 15; const float bv = tb[ok ? dc : 0];
                              p0[rr] = ok ? fmaf(p0[rr], ATT_C, bv) : -1e30f; }
                            { const int kc = 32 + crow(rr, hi); const bool ok = (unsigned)(kc - cs) < 16u; const int dc = kc - c + 15; const float bv = tb[ok ? dc : 0];
                              p1[rr] = ok ? fmaf(p1[rr], ATT_C, bv) : -1e30f; }
                        }
                        float alpha; bf16x8 pa0, pa1, pa2, pa3;
                        softmax_tile(p0, p1, m_reg, l_reg, alpha, pa0, pa1, pa2, pa3);
                        if (__any(alpha < 1.f)) {
                            if (hi == 0) wsl[r32] = alpha; LDS_WAIT();
#pragma unroll
                            for (int d = 0; d < 4; ++d)
#pragma unroll
                                for (int rr = 0; rr < 16; ++rr) o[d][rr] *= wsl[crow(rr, hi)];
                        }
                        pv_one<0, 4>(o[0], vb, pa0, pa1, pa2, pa3); pv_one<1, 4>(o[1], vb, pa0, pa1, pa2, pa3); pv_one<2, 4>(o[2], vb, pa0, pa1, pa2, pa3); pv_one<3, 4>(o[3], vb, pa0, pa1, pa2, pa3);
                    }
                }
#undef NA_DMA
                if (hi == 0) wsl[32 + r32] = l_reg; LDS_WAIT();
                __syncthreads();
                LAS unsigned short* img = (LAS unsigned short*)(F.lds + w * 8192);
#pragma unroll
                for (int rr = 0; rr < 16; ++rr) { const int orow = crow(rr, hi); const float rl = __builtin_amdgcn_rcpf(wsl[32 + orow]);
#pragma unroll
                    for (int d = 0; d < 4; ++d) img[orow * 128 + d * 32 + r32] = (unsigned short)(cvt_pk_bf16(o[d][rr] * rl, 0.f) & 0xffffu); }
                LDS_WAIT();
                bf16* Ob = MIX + (size_t)(si.row0 + r * 64 + c0) * LDX + h * 128;
#pragma unroll
                for (int i2 = 0; i2 < 8; ++i2) { const int row = 4 * i2 + (lane >> 4); const u32x4 v = *(const LAS u32x4*)(img + row * 128 + (lane & 15) * 8);
                    *(u32x4*)(Ob + (size_t)row * LDX + (lane & 15) * 8) = v; }
            }
            __syncthreads();
        }
    }
    SEAM(2);

#if DFT_HERM
    if (IN(3)) REPS(3) {
        unsigned char* ws = KWS(); bf16* VT = (bf16*)(ws + WS_VT);
        unsigned char* outb = (unsigned char*)KOUT(); bf16* T8 = (bf16*)(outb + DO_T8); bf16* T2 = (bf16*)(outb + DO_T2); bf16* PQ8 = (bf16*)(outb + DO_PQ8); bf16* PQ2 = (bf16*)(outb + DO_PQ2);
        bf16* T8S = (bf16*)(outb + DO_T8S); bf16* WSP = (bf16*)(outb + DO_WSP); bf16* P256 = (bf16*)(outb + DO_P256);
        {
            struct Sch { int G, c; const bf16* T8; const bf16* VT; bf16* PQ;
                __device__ __forceinline__ bool next(int i, gm::Unit& u) const {
                    int q, wh, pm, g;
                    if (G == 256) { if (i >= 1) return false; const int x = c & 7, j = c >> 3; q = x >> 2; wh = (x >> 1) & 1; pm = (x & 1) * 8 + (j >> 2); g = j & 3; }
                    else { const int L = i * G + c; if (L >= 256) return false; q = L >> 7; wh = (L >> 6) & 1; pm = (L >> 2) & 15; g = L & 3; }
                    u.A = (const char*)(T8 + ((size_t)wh * 4096 + pm * 256) * 8192); u.B = (const char*)(VT + (size_t)4096 * (q * 8192) + (size_t)(2 * g) * 256 * 16384 + wh * 8192);
                    u.ldc = 2048; u.row0 = 0; u.col0 = 0; u.C = (char*)(PQ + ((size_t)(q * 2 + wh) * 4096 + pm * 256) * 2048 + (2 * g) * 256); return true; } };
            Sch S{F.G, (int)blockIdx.x, T8, VT, PQ8};
            gm::EpiBf16 E{nullptr, 1.0f / 2048.0f};
            gm::gemm_phase(F.lds, F.wave, 8192, 8192, 16384, S, E);
        }
        {
            struct Sch { int G, c; const bf16* T2; const bf16* VT; bf16* PQ; const bf16* T8S; const bf16* WSP; bf16* P256;
                __device__ __forceinline__ bool next(int i, gm::Unit& u) const {
                    const int L = i * G + c; if (L >= 256) return false;
                    u.row0 = 0; u.col0 = 0;
                    if (L < 128) { const int q = L >> 5, wh = (L >> 4) & 1, pm = (L >> 2) & 3, g = L & 3; const int row0 = NTOK_P + q * 2048;
                        u.A = (const char*)(T2 + ((size_t)wh * 1024 + pm * 256) * 2048); u.B = (const char*)(VT + (size_t)4096 * row0 + (size_t)(2 * g) * 256 * 4096 + wh * 2048);
                        u.ldc = 2048; u.C = (char*)(PQ + ((size_t)(q * 2 + wh) * 1024 + pm * 256) * 2048 + (2 * g) * 256); }
                    else { const int l2 = L - 128, q = l2 >> 6, pm = (l2 >> 2) & 15, kc = l2 & 3;
                        u.A = (const char*)(T8S + ((size_t)kc * 4096 + pm * 256) * 2048); u.B = (const char*)(WSP + (size_t)(q * 4 + kc) * 256 * 4096);
                        u.ldc = 256; u.C = (char*)(P256 + ((size_t)(q * 4 + kc) * 4096 + pm * 256) * 256); }
                    return true; } };
            Sch S{F.G, (int)blockIdx.x, T2, VT, PQ2, T8S, WSP, P256};
            gm::EpiBf16 E{nullptr, 1.0f / 1024.0f};
            gm::gemm_phase(F.lds, F.wave, 2048, 2048, 4096, S, E);
        }
    }
    SEAMX(3, 13);
    if (IN(13)) REPS(13) {
        unsigned char* ws = KWS(); const bf16* VT = (const bf16*)(ws + WS_VT); bf16* MIX = (bf16*)(ws + WS_MIX);
        unsigned char* outb = (unsigned char*)KOUT(); const bf16* PQ8 = (const bf16*)(outb + DO_PQ8); const bf16* PQ2 = (const bf16*)(outb + DO_PQ2);
        const bf16* T2 = (const bf16*)(outb + DO_T2); const bf16* WSP = (const bf16*)(outb + DO_WSP); const bf16* P256 = (const bf16*)(outb + DO_P256); const float* WS2 = (const float*)(outb + DO_WS2);
        const int lane = lane_id_opaque(), gw = F.vcu * 8 + F.wave, NGW = F.G * 8;
        for (int it = gw; it < NTOK * 4; it += NGW) {
            const int tok = it >> 2, g = it & 3;
            int q, row; if (tok < NTOK_P) { q = tok >> 13; row = tok & 8191; } else { const int t2 = tok - NTOK_P; q = 2 + (t2 >> 11); row = t2 & 2047; }
            const SeqInfo si = seq_info(q); const int Sh = si.S >> 1;
            if (row == Sh) continue;
            const bool fk = row > Sh; const int kp = fk ? si.S - row : row;
            const bf16* Pp = (q < 2 ? PQ8 + (size_t)q * 2 * 4096 * 2048 : PQ2 + (size_t)(q - 2) * 2 * 1024 * 2048) + (size_t)kp * 2048 + g * 512;
            const bf16* Qp = Pp + (size_t)Sh * 2048;
            float sp;
            if (q < 2) { float a = 0.f;
#pragma unroll
                for (int kc = 0; kc < 4; ++kc) a += __uint_as_float((unsigned)P256[((size_t)(q * 4 + kc) * 4096 + kp) * 256 + g] << 16);
                sp = 0.5f * a; }
            else { const bf16* tr = T2 + (size_t)kp * 2048 + lane * 32; const float* wr_ = WS2 + ((q - 2) * 4 + g) * 2048 + lane * 32; float a = 0.f;
#pragma unroll
                for (int e = 0; e < 4; ++e) { const u32x4 tv = *(const u32x4*)(tr + e * 8); const f32x4 w0 = *(const f32x4*)(wr_ + e * 8), w1 = *(const f32x4*)(wr_ + e * 8 + 4);
                    a += __uint_as_float(tv[0] << 16) * w0[0] + __uint_as_float(tv[0] & 0xffff0000u) * w0[1] + __uint_as_float(tv[1] << 16) * w0[2] + __uint_as_float(tv[1] & 0xffff0000u) * w0[3]
                       + __uint_as_float(tv[2] << 16) * w1[0] + __uint_as_float(tv[2] & 0xffff0000u) * w1[1] + __uint_as_float(tv[3] << 16) * w1[2] + __uint_as_float(tv[3] & 0xffff0000u) * w1[3]; }
                sp = wave_sum(a) * (1.0f / 1024.0f); }
            const int l0 = lane * 8; float pv[8], qv[8];
            if (lane < 32) { const u32x4 a = *(const u32x4*)(Pp + l0), b = *(const u32x4*)(Qp + l0);
#pragma unroll
                for (int e = 0; e < 4; ++e) { pv[2 * e] = __uint_as_float(a[e] << 16); pv[2 * e + 1] = __uint_as_float(a[e] & 0xffff0000u); qv[2 * e] = __uint_as_float(b[e] << 16); qv[2 * e + 1] = __uint_as_float(b[e] & 0xffff0000u); } }
            else {
                const u32x4 a = *(const u32x4*)(Pp + 504 - l0), b = *(const u32x4*)(Qp + 504 - l0); float ta[8], tb[8];
#pragma unroll
                for (int e = 0; e < 4; ++e) { ta[2 * e] = __uint_as_float(a[e] << 16); ta[2 * e + 1] = __uint_as_float(a[e] & 0xffff0000u); tb[2 * e] = __uint_as_float(b[e] << 16); tb[2 * e + 1] = __uint_as_float(b[e] & 0xffff0000u); }
#pragma unroll
                for (int j = 1; j < 8; ++j) { pv[j] = ta[8 - j]; qv[j] = -tb[8 - j]; }
                if (lane == 32) { pv[0] = sp; qv[0] = 0.f; }
                else { pv[0] = __uint_as_float((unsigned)Pp[512 - l0] << 16); qv[0] = -__uint_as_float((unsigned)Qp[512 - l0] << 16); } }
            float o8[8];
#pragma unroll
            for (int j = 0; j < 8; ++j) o8[j] = fk ? pv[j] + qv[j] : pv[j] - qv[j];
            u32x4 w; w.x = cvt_pk_bf16(o8[0], o8[1]); w.y = cvt_pk_bf16(o8[2], o8[3]); w.z = cvt_pk_bf16(o8[4], o8[5]); w.w = cvt_pk_bf16(o8[6], o8[7]);
            *(u32x4*)(MIX + (size_t)tok * LDX + 2048 + g * 512 + l0) = w;
        }
        for (int it = gw; it < 6 * 4 * 257; it += NGW) {
            const int q = it / (4 * 257), r = it % (4 * 257), g = r / 257, lp = r % 257; const SeqInfo si = seq_info(q);
            float acc = 0.f;
            if (lp < 256) { const bf16* vr = VT + (size_t)4096 * si.row0 + (size_t)(g * 512 + lp) * (2 * si.S);
                for (int s0 = lane * 8; s0 < si.S; s0 += 512) { const u32x4 v = *(const u32x4*)(vr + s0);
#pragma unroll
                    for (int e = 0; e < 4; ++e) acc += __uint_as_float(v[e] << 16) - __uint_as_float(v[e] & 0xffff0000u); } }
            else if (q < 2) { for (int s0 = lane * 8; s0 < 8192; s0 += 512) { const u32x4 v = *(const u32x4*)(WSP + ((size_t)(q * 4 + (s0 >> 11)) * 256 + g) * 4096 + (s0 & 2047));
#pragma unroll
                    for (int e = 0; e < 4; ++e) acc += __uint_as_float(v[e] << 16) - __uint_as_float(v[e] & 0xffff0000u); } }
            else { const float* wr_ = WS2 + ((q - 2) * 4 + g) * 2048; for (int s0 = lane * 4; s0 < 2048; s0 += 256) { const f32x4 v = *(const f32x4*)(wr_ + s0); acc += (v[0] - v[1]) + (v[2] - v[3]); } }
            acc = wave_sum(acc) * (si.S == 8192 ? 1.0f / 2048.0f : 1.0f / 1024.0f);
            if (lane == 0) { bf16* orow = MIX + (size_t)(si.row0 + (si.S >> 1)) * LDX + 2048 + g * 512; const bf16 hv = (bf16)(cvt_pk_bf16(acc, 0.f) & 0xffffu);
                orow[lp] = hv; if (lp > 0 && lp < 256) orow[512 - lp] = hv; }
        }
    }
#else
    if (IN(3)) REPS(3) {
        unsigned char* ws = KWS(); bf16* VT = (bf16*)(ws + WS_VT);
        unsigned char* outb = (unsigned char*)KOUT(); bf16* T8 = (bf16*)(outb + DO_T8); bf16* T2 = (bf16*)(outb + DO_T2); bf16* PQ8 = (bf16*)(outb + DO_PQ8); bf16* PQ2 = (bf16*)(outb + DO_PQ2);
        {
            struct Sch { int G, c; const bf16* T8; const bf16* VT; bf16* PQ;
                __device__ __forceinline__ bool next(int i, gm::Unit& u) const {
                    int q, wh, pm, pn;
                    if (G == 256) { if (i >= 2) return false; const int xcd = c & 7, j = c >> 3; q = i; wh = xcd >> 2; pm = (xcd & 3) * 4 + (j >> 3); pn = j & 7; }
                    else { const int L = i * G + c; if (L >= 512) return false; q = L >> 8; wh = (L >> 7) & 1; pm = (L >> 3) & 15; pn = L & 7; }
                    u.A = (const char*)(T8 + ((size_t)wh * 4096 + pm * 256) * 8192); u.B = (const char*)(VT + (size_t)4096 * (q * 8192) + (size_t)pn * 256 * 16384 + wh * 8192);
                    u.ldc = 2048; u.row0 = 0; u.col0 = 0; u.C = (char*)(PQ + ((size_t)(q * 2 + wh) * 4096 + pm * 256) * 2048 + pn * 256); return true; } };
            Sch S{F.G, (int)blockIdx.x, T8, VT, PQ8};
            gm::EpiBf16 E{nullptr, 1.0f / 2048.0f};
            gm::gemm_phase(F.lds, F.wave, 8192, 8192, 16384, S, E);
        }
        {
            struct Sch { int G, c; const bf16* T2; const bf16* VT; bf16* PQ;
                __device__ __forceinline__ bool next(int i, gm::Unit& u) const {
                    int q, wh, pm, pn;
                    if (G == 256) { if (i >= 1) return false; const int xcd = c & 7, j = c >> 3; q = xcd >> 1; wh = xcd & 1; pm = j >> 3; pn = j & 7; }
                    else { const int L = i * G + c; if (L >= 256) return false; q = L >> 6; wh = (L >> 5) & 1; pm = (L >> 3) & 3; pn = L & 7; }
                    const int row0 = NTOK_P + q * 2048;
                    u.A = (const char*)(T2 + ((size_t)wh * 1024 + pm * 256) * 2048); u.B = (const char*)(VT + (size_t)4096 * row0 + (size_t)pn * 256 * 4096 + wh * 2048);
                    u.ldc = 2048; u.row0 = 0; u.col0 = 0; u.C = (char*)(PQ + ((size_t)(q * 2 + wh) * 1024 + pm * 256) * 2048 + pn * 256); return true; } };
            Sch S{F.G, (int)blockIdx.x, T2, VT, PQ2};
            gm::EpiBf16 E{nullptr, 1.0f / 1024.0f};
            gm::gemm_phase(F.lds, F.wave, 2048, 2048, 4096, S, E);
        }
    }
    SEAMX(3, 13);
    if (IN(13)) REPS(13) {
        unsigned char* ws = KWS(); const bf16* VT = (const bf16*)(ws + WS_VT); bf16* MIX = (bf16*)(ws + WS_MIX);
        unsigned char* outb = (unsigned char*)KOUT(); const bf16* PQ8 = (const bf16*)(outb + DO_PQ8); const bf16* PQ2 = (const bf16*)(outb + DO_PQ2);
        const int lane = lane_id_opaque(), gw = F.vcu * 8 + F.wave, NGW = F.G * 8;
        for (int it = gw; it < 2 * 4096 * 4 + 4 * 1024 * 4; it += NGW) {
            int q, k, qt, Sh; const bf16* PQ;
            if (it < 32768) { q = it >> 14; k = (it >> 2) & 4095; qt = it & 3; Sh = 4096; PQ = PQ8 + (size_t)q * 2 * 4096 * 2048; }
            else { const int i2 = it - 32768; q = i2 >> 12; k = (i2 >> 2) & 1023; qt = i2 & 3; Sh = 1024; PQ = PQ2 + (size_t)q * 2 * 1024 * 2048; q += 2; }
            const SeqInfo si = seq_info(q); const int col = qt * 512 + lane * 8;
            const u32x4 pv = *(const u32x4*)(PQ + (size_t)k * 2048 + col), qv = *(const u32x4*)(PQ + ((size_t)Sh + k) * 2048 + col);
            u32x4 d, a;
#pragma unroll
            for (int e = 0; e < 4; ++e) { const float p0 = __uint_as_float(pv[e] << 16), p1 = __uint_as_float(pv[e] & 0xffff0000u), q0 = __uint_as_float(qv[e] << 16), q1 = __uint_as_float(qv[e] & 0xffff0000u);
                d[e] = cvt_pk_bf16(p0 - q0, p1 - q1); a[e] = cvt_pk_bf16(p0 + q0, p1 + q1); }
            *(u32x4*)(MIX + (size_t)(si.row0 + k) * LDX + 2048 + col) = d;
            if (k) *(u32x4*)(MIX + (size_t)(si.row0 + si.S - k) * LDX + 2048 + col) = a;
        }
        for (int it = gw; it < 6 * 2048; it += NGW) {
            const int q = it >> 11, c = it & 2047; const SeqInfo si = seq_info(q);
            const bf16* vr = VT + (size_t)4096 * si.row0 + (size_t)c * (2 * si.S);
            float acc = 0.f;
            for (int s0 = lane * 8; s0 < si.S; s0 += 512) { const u32x4 v = *(const u32x4*)(vr + s0);
#pragma unroll
                for (int e = 0; e < 4; ++e) acc += __uint_as_float(v[e] << 16) - __uint_as_float(v[e] & 0xffff0000u); }
            acc = wave_sum(acc) * (si.S == 8192 ? 1.0f / 2048.0f : 1.0f / 1024.0f);
            if (lane == 0) MIX[(size_t)(si.row0 + (si.S >> 1)) * LDX + 2048 + c] = (bf16)(cvt_pk_bf16(acc, 0.f) & 0xffffu);
        }
    }
#endif
    SEAMX(13, 4);

    if (IN(4)) REPS(4) {
        unsigned char* ws = KWS(); float* ssq = (float*)(ws + WS_CTL + CTL_SSQ); bf16* XB = (bf16*)(ws + WS_XB); bf16* MIX = (bf16*)(ws + WS_MIX); bf16* HMID = (bf16*)(ws + WS_PROJ); bf16* PROJ = HMID;
        float* X = KOUT(); const float* x_prompt = KIN(0); const float* x_sample = KIN(1);
        bf16* WOE = (bf16*)(ws + WS_WOE); bf16* WIO = (bf16*)(ws + WS_WIO); bf16* WOO = (bf16*)(ws + WS_WOO);
        bf16* WGU0 = (bf16*)(ws + WS_WGU0); bf16* WGU1 = (bf16*)(ws + WS_WGU1); bf16* WD0 = (bf16*)(ws + WS_WD0); bf16* WD1 = (bf16*)(ws + WS_WD1);
        (void)ssq; (void)XB; (void)MIX; (void)HMID; (void)PROJ; (void)X; (void)x_prompt; (void)x_sample; (void)WOE; (void)WIO; (void)WOO; (void)WGU0; (void)WGU1; (void)WD0; (void)WD1;
        gm::GridOrder S; S.init(NTOK, DM, F.G, (int)blockIdx.x, MIX, (size_t)LDX * 2, WOE, (size_t)LDX * 2, X, DM, 4); S.sh48 = (ORD48 & 2) != 0;
        gm::EpiResid E{x_prompt, x_sample, 1, X, XB, ssq + NTOK, 1};
        gm::gemm_phase(F.lds, F.wave, DM, LDX, LDX, S, E);
    }
    SEAM(4);
    if (IN(5)) REPS(5) {
        unsigned char* ws = KWS(); float* ssq = (float*)(ws + WS_CTL + CTL_SSQ); bf16* XB = (bf16*)(ws + WS_XB); bf16* MIX = (bf16*)(ws + WS_MIX); bf16* HMID = (bf16*)(ws + WS_PROJ); bf16* PROJ = HMID;
        float* X = KOUT(); const float* x_prompt = KIN(0); const float* x_sample = KIN(1);
        bf16* WOE = (bf16*)(ws + WS_WOE); bf16* WIO = (bf16*)(ws + WS_WIO); bf16* WOO = (bf16*)(ws + WS_WOO);
        bf16* WGU0 = (bf16*)(ws + WS_WGU0); bf16* WGU1 = (bf16*)(ws + WS_WGU1); bf16* WD0 = (bf16*)(ws + WS_WD0); bf16* WD1 = (bf16*)(ws + WS_WD1);
        (void)ssq; (void)XB; (void)MIX; (void)HMID; (void)PROJ; (void)X; (void)x_prompt; (void)x_sample; (void)WOE; (void)WIO; (void)WOO; (void)WGU0; (void)WGU1; (void)WD0; (void)WD1;
        gm::GridOrder S; S.init(NTOK, 2 * FF, F.G, (int)blockIdx.x, XB, (size_t)LDX * 2, WGU0, (size_t)LDX * 2, HMID, FF, 2);
        gm::EpiSwiglu E{ssq + NTOK, HMID};
        gm::gemm_phase(F.lds, F.wave, DM, LDX, LDX, S, E);
    }
    SEAM(5);
    if (IN(6)) REPS(6) {
        unsigned char* ws = KWS(); float* ssq = (float*)(ws + WS_CTL + CTL_SSQ); bf16* XB = (bf16*)(ws + WS_XB); bf16* MIX = (bf16*)(ws + WS_MIX); bf16* HMID = (bf16*)(ws + WS_PROJ); bf16* PROJ = HMID;
        float* X = KOUT(); const float* x_prompt = KIN(0); const float* x_sample = KIN(1);
        bf16* WOE = (bf16*)(ws + WS_WOE); bf16* WIO = (bf16*)(ws + WS_WIO); bf16* WOO = (bf16*)(ws + WS_WOO);
        bf16* WGU0 = (bf16*)(ws + WS_WGU0); bf16* WGU1 = (bf16*)(ws + WS_WGU1); bf16* WD0 = (bf16*)(ws + WS_WD0); bf16* WD1 = (bf16*)(ws + WS_WD1);
        (void)ssq; (void)XB; (void)MIX; (void)HMID; (void)PROJ; (void)X; (void)x_prompt; (void)x_sample; (void)WOE; (void)WIO; (void)WOO; (void)WGU0; (void)WGU1; (void)WD0; (void)WD1;
        gm::GridOrder S; S.init(NTOK, DM, F.G, (int)blockIdx.x, HMID, (size_t)FF * 2, WD0, (size_t)FF * 2, X, DM, 4); S.sh48 = (ORD48 & 1) != 0;
        gm::EpiResid E{x_prompt, x_sample, 0, X, XB, ssq + 2 * NTOK, 1};
        gm::gemm_phase(F.lds, F.wave, FF, FF, FF, S, E);
    }
    SEAM(6);
    if (IN(7)) REPS(7) {
        unsigned char* ws = KWS(); float* ssq = (float*)(ws + WS_CTL + CTL_SSQ); bf16* XB = (bf16*)(ws + WS_XB); bf16* MIX = (bf16*)(ws + WS_MIX); bf16* HMID = (bf16*)(ws + WS_PROJ); bf16* PROJ = HMID;
        float* X = KOUT(); const float* x_prompt = KIN(0); const float* x_sample = KIN(1);
        bf16* WOE = (bf16*)(ws + WS_WOE); bf16* WIO = (bf16*)(ws + WS_WIO); bf16* WOO = (bf16*)(ws + WS_WOO);
        bf16* WGU0 = (bf16*)(ws + WS_WGU0); bf16* WGU1 = (bf16*)(ws + WS_WGU1); bf16* WD0 = (bf16*)(ws + WS_WD0); bf16* WD1 = (bf16*)(ws + WS_WD1);
        (void)ssq; (void)XB; (void)MIX; (void)HMID; (void)PROJ; (void)X; (void)x_prompt; (void)x_sample; (void)WOE; (void)WIO; (void)WOO; (void)WGU0; (void)WGU1; (void)WD0; (void)WD1;
        gm::GridOrder S; S.init(NTOK, ODD_IN, F.G, (int)blockIdx.x, XB, (size_t)LDX * 2, WIO, (size_t)LDX * 2, PROJ, ODD_IN, 2);
        gm::EpiBf16 E{ssq + 2 * NTOK, 1.0f};
        gm::gemm_phase(F.lds, F.wave, DM, LDX, LDX, S, E);
    }
    SEAM(7);

    if (IN(8)) REPS(8) {
        unsigned char* ws = KWS(); bf16* PROJ = (bf16*)(ws + WS_PROJ); bf16* MIX = (bf16*)(ws + WS_MIX); const unsigned* ctl = (const unsigned*)ws;
        const float* subln_w = KIN(12); const float* t5_bias = KIN(14);
        const int w = F.wave, mp = w >> 2, wq = w & 3;
        LAS float* tab = (LAS float*)(F.lds + EX_TAB);
        LAS float* wsl = (LAS float*)(F.lds + EX_WS) + w * 64;
        const int NU = 3072;
        for (int uix = 0; ; ++uix) {
            int q, h, qb;
            if (F.G == 256) {
                if (uix >= 12) break;
                const int xv = F.vcu >> 5, lw = F.vcu & 31;
                if (uix < 8) { const int pair = xv * 4 + (uix >> 1); q = pair >> 4; h = pair & 15; qb = lw * 2 + (uix & 1); }
                else { const int pair = xv * 8 + (uix - 8) * 2 + (lw >> 4); q = 2 + (pair >> 4); h = pair & 15; qb = lw & 15; }
            } else {
                const int U = uix * F.G + F.vcu; if (U >= NU) break;
                if (U < 2048) { q = U >> 10; const int t = U & 1023; h = t >> 6; qb = t & 63; } else { const int t2 = U - 2048; q = 2 + (t2 >> 8); const int t = t2 & 255; h = t >> 4; qb = t & 15; }
            }
            const SeqInfo si = seq_info(q); const int NT = si.S >> 6;
            const int lane = lane_id_opaque(), tid = w * 64 + lane, r32 = lane & 31, hi = lane >> 5;
            __syncthreads();
            for (int e = tid; e < 257; e += 512) { const int rel = e - 128; const int n = rel < 0 ? -rel : rel; int bk = rel > 0 ? 16 : 0;
                if (n < 8) bk += n; else { int lg = 2 + (31 - __builtin_clz((unsigned)(n * n))); bk += lg > 15 ? 15 : lg; }
                tab[e] = t5_bias[bk * 16 + h] * LOG2E; }
            const int qpos0 = 128 * qb + 32 * wq;
            bf16x8 qr[8];
            { const bf16* Qw = PROJ + (size_t)(si.row0 + qpos0 + r32) * ODD_IN + h * 256 + mp * 128 + hi * 8;
#pragma unroll
              for (int d0 = 0; d0 < 8; ++d0) qr[d0] = *(const bf16x8*)(Qw + d0 * 16); }
            float m_reg = -1e30f, l_reg = 0.f; f32x4 o[16][2];
#pragma unroll
            for (int d = 0; d < 16; ++d) { o[d][0] = (f32x4){0.f, 0.f, 0.f, 0.f}; o[d][1] = (f32x4){0.f, 0.f, 0.f, 0.f}; }
            constexpr unsigned LDB = ODD_IN * 2;
            unsigned offA;
            if (w < 4) offA = (unsigned)(lane >> 4) * LDB + (unsigned)(((lane & 15) ^ ((lane >> 4) & 7)) << 4);
            else { const int r8 = (lane >> 1) & 7; offA = (unsigned)(16 * (r8 >> 2) + (r8 & 3)) * LDB + (unsigned)(16 * (lane >> 4) + 8 * (lane & 1)) * 2u; }
            const char* kvbase = (const char*)(PROJ + (size_t)si.row0 * ODD_IN + h * 256);
            const int NS = si.S >> 5;
            struct DmaHook { const char* kvbase; LAS unsigned char* ldsb; unsigned offA; int w, NS, step;
                __device__ __forceinline__ void operator()(int j_) const {
                    const int st_ = step < NS ? step : NS - 1; const char* tb_ = kvbase + (size_t)(st_ * 32) * (ODD_IN * 2); LAS unsigned char* dst_ = ldsb + (step & 3) * 32768 + w * 4096 + j_ * 1024;
                    if (w < 4) glds16(tb_ + (size_t)(4 * (w & 1)) * 4 * (ODD_IN * 2) + (4096 + (w >> 1) * 128) * 2 + (size_t)j_ * 4 * (ODD_IN * 2) + ((j_ & 1) ? (offA ^ 64u) : offA), dst_);
                    else glds16(tb_ + (size_t)(4 * ((w - 4) & 1) + 8 * ((w - 4) >> 1)) * (ODD_IN * 2) + 8192 * 2 + 128 * j_ + offA, dst_); } };
#define DA_DMA(step) do { const int st_ = (step) < NS ? (step) : NS - 1;      \
            const char* tb_ = kvbase + (size_t)(st_ * 32) * LDB; LAS unsigned char* dst_ = F.lds + ((step) & 3) * 32768 + w * 4096; \
            if (w < 4) { const char* t2_ = tb_ + (size_t)(4 * (w & 1)) * 4 * LDB + (4096 + (w >> 1) * 128) * 2; \
                _Pragma("unroll") for (int j_ = 0; j_ < 4; ++j_) glds16(t2_ + (size_t)j_ * 4 * LDB + ((j_ & 1) ? (offA ^ 64u) : offA), dst_ + j_ * 1024); } \
            else { const char* t2_ = tb_ + (size_t)(4 * ((w - 4) & 1) + 8 * ((w - 4) >> 1)) * LDB + 8192 * 2; \
                _Pragma("unroll") for (int j_ = 0; j_ < 4; ++j_) glds16(t2_ + 128 * j_ + offA, dst_ + j_ * 1024); } } while (0)
#ifndef ATT_PIPE
#define ATT_PIPE 0
#endif
            DA_DMA(0); DA_DMA(1);
#if ATT_PIPE
            DA_DMA(2);
#endif
            __syncthreads();
            const float bfarL = __builtin_bit_cast(float, __builtin_amdgcn_readfirstlane(__builtin_bit_cast(int, tab[0])));
            const float bfarR = __builtin_bit_cast(float, __builtin_amdgcn_readfirstlane(__builtin_bit_cast(int, tab[256])));
#define DA_QK(s_, P_) do { LDS_WAIT(); qkt_h(P_, F.lds + ((s_) & 3) * 32768 + mp * 8192, qr, r32, hi); } while (0)
#define DA_SM(s_, P_) do { \
                const int relmin = 32 * (s_) - (qpos0 + 31), relmax = 32 * (s_) + 31 - qpos0;     \
                SBAR(); \
                if (relmax <= -128 || relmin >= 128) { softmax_far_h(P_, relmax <= -128 ? bfarL : bfarR, m_reg, l_reg, alpha, pa0, pa1); } \
                else { const int relb = 32 * (s_) - (qpos0 + r32) + 128 + 4 * hi; \
                    _Pragma("unroll") for (int g4 = 0; g4 < 2; ++g4) { \
                        _Pragma("unroll") for (int r8 = 0; r8 < 8; ++r8) { const int rr = g4 * 8 + r8; int ix = relb + (rr & 3) + 8 * (rr >> 2); ix = ix < 0 ? 0 : (ix > 256 ? 256 : ix); P_[rr] = fmaf(P_[rr], ATT_C, tab[ix]); } \
                        SBAR(); } \
                    softmax_near_h(P_, m_reg, l_reg, alpha, pa0, pa1); } \
                SBAR(); \
                if (__any(alpha < 1.f)) { float aq0, aq1; pair16(alpha, aq0, aq1); \
                    _Pragma("unroll") for (int d = 0; d < 16; ++d) { o[d][0] *= aq0; o[d][1] *= aq1; if ((d & 3) == 3) SBAR(); } } \
                SBAR(); } while (0)
#define DA_PV(s_) do { LDS_WAIT(); pv_half16(o, (unsigned)(uintptr_t)(F.lds + ((s_) & 3) * 32768 + 16384) + v_rd_base16(lane), pa0, pa1); } while (0)
#define DA_PVD(s_, dstep_) do { LDS_WAIT(); const DmaHook hk_{kvbase, F.lds, offA, w, NS, (dstep_)}; pv_half16(o, (unsigned)(uintptr_t)(F.lds + ((s_) & 3) * 32768 + 16384) + v_rd_base16(lane), pa0, pa1, hk_); } while (0)
#define DA_SYNC() do { asm volatile("s_waitcnt vmcnt(4)" ::: "memory"); __builtin_amdgcn_s_barrier(); asm volatile("" ::: "memory"); } while (0)
            float alpha; bf16x8 pa0, pa1;
#if ATT_PIPE
            f32x16 pA, pB;
            asm volatile("s_waitcnt vmcnt(8)" ::: "memory"); __builtin_amdgcn_s_barrier(); asm volatile("" ::: "memory");
            DA_QK(0, pA);
            for (int s_ = 0; s_ < NS; s_ += 2) {
                DA_SYNC();
                DA_QK(s_ + 1, pB); SBAR();
                DA_SM(s_, pA); DA_PVD(s_, s_ + 3);
                DA_SYNC();
                if (s_ + 2 < NS) { DA_QK(s_ + 2, pA); } SBAR();
                DA_SM(s_ + 1, pB); DA_PVD(s_ + 1, s_ + 4);
            }
#else
            if (ATT_SPRIO && mp == 1) __builtin_amdgcn_s_setprio(1);
#ifndef ATT_CUT
#define ATT_CUT 1
#endif
#if ATT_CUT
            if (mp == 0) {
                DA_SYNC(); DA_DMA(2);
                { f32x16 p; DA_QK(0, p); DA_SM(0, p); }
                for (int s_ = 1; s_ < NS; ++s_) {
                    DA_SYNC();
                    DA_PVD(s_ - 1, s_ + 2); SBAR(); { f32x16 p; DA_QK(s_, p); DA_SM(s_, p); }
                }
                DA_SYNC();
                DA_PV(NS - 1);
            } else {
                f32x16 p;
                DA_SYNC(); DA_DMA(2);
                DA_QK(0, p);
                for (int s_ = 1; s_ < NS; ++s_) {
                    DA_SYNC();
                    DA_SM(s_ - 1, p); DA_PVD(s_ - 1, s_ + 2); SBAR(); DA_QK(s_, p);
                }
                DA_SYNC();
                DA_SM(NS - 1, p); DA_PV(NS - 1);
            }
#else
            if (mp == 0) {
                for (int s_ = 0; s_ < NS; ++s_) {
                    DA_SYNC();
                    { f32x16 p; DA_QK(s_, p); DA_SM(s_, p); } DA_PVD(s_, s_ + 2);
                }
            } else {
                DA_SYNC(); DA_DMA(2);
                { f32x16 p; DA_QK(0, p); DA_SM(0, p); }
                for (int s_ = 1; s_ < NS; ++s_) {
                    DA_SYNC();
                    DA_PVD(s_ - 1, s_ + 2); SBAR(); { f32x16 p; DA_QK(s_, p); DA_SM(s_, p); }
                }
                DA_PV(NS - 1);
            }
#endif
            if (ATT_SPRIO) __builtin_amdgcn_s_setprio(0);
#endif
            VM_WAIT(); __syncthreads();
#undef DA_QK
#undef DA_SM
#undef DA_PV
#undef DA_PVD
#undef DA_SYNC
#undef DA_DMA
            LAS float* xch = (LAS float*)(F.lds + wq * 32768);
            const float lsc = mp ? ((const float*)ctl)[CW_LAM] : 1.0f;
            { float l0, l1; pair16(l_reg, l0, l1); const float rl0 = __builtin_amdgcn_rcpf(l0) * lsc, rl1 = __builtin_amdgcn_rcpf(l1) * lsc;
#pragma unroll
              for (int d = 0; d < 16; ++d) { o[d][0] *= rl0; o[d][1] *= rl1; if ((d & 3) == 3) SBAR(); } }
            if (mp == 1) {
#pragma unroll
                for (int d = 0; d < 16; ++d) {
#pragma unroll
                    for (int e = 0; e < 8; ++e) xch[(d * 8 + e) * 64 + lane] = o[d][e >> 2][e & 3];
                    if (d & 1) SBAR(); }
            }
            __syncthreads();
            if (mp == 0) {
#pragma unroll
                for (int d = 0; d < 16; ++d) {
#pragma unroll
                    for (int e = 0; e < 8; ++e) o[d][e >> 2][e & 3] -= xch[(d * 8 + e) * 64 + lane];
                    if (d & 1) SBAR(); }
                float s0 = 0.f, s1 = 0.f;
#pragma unroll
                for (int d = 0; d < 16; ++d)
#pragma unroll
                    for (int i = 0; i < 4; ++i) { s0 += o[d][0][i] * o[d][0][i]; s1 += o[d][1][i] * o[d][1][i]; }
                s0 = sum_halves32(sum_rows16(s0)); s1 = sum_halves32(sum_rows16(s1));
                const float rs0 = __builtin_amdgcn_rsqf(s0 * (1.0f / 256.0f) + SUBLN_EPS) * (1.0f - LAM_INIT), rs1 = __builtin_amdgcn_rsqf(s1 * (1.0f / 256.0f) + SUBLN_EPS) * (1.0f - LAM_INIT);
                LAS unsigned short* img = (LAS unsigned short*)(F.lds + wq * 32768);
                const int g4 = 4 * (lane >> 4), c16 = lane & 15;
#pragma unroll
                for (int d = 0; d < 16; ++d) { const f32x4 gw_ = *(const f32x4*)(subln_w + d * 16 + g4);
                    u32x2 w0, w1;
                    w0.x = cvt_pk_bf16(o[d][0][0] * rs0 * gw_[0], o[d][0][1] * rs0 * gw_[1]); w0.y = cvt_pk_bf16(o[d][0][2] * rs0 * gw_[2], o[d][0][3] * rs0 * gw_[3]);
                    w1.x = cvt_pk_bf16(o[d][1][0] * rs1 * gw_[0], o[d][1][1] * rs1 * gw_[1]); w1.y = cvt_pk_bf16(o[d][1][2] * rs1 * gw_[2], o[d][1][3] * rs1 * gw_[3]);
                    *(LAS u32x2*)(img + c16 * 256 + d * 16 + g4) = w0; *(LAS u32x2*)(img + (16 + c16) * 256 + d * 16 + g4) = w1;
                    if ((d & 3) == 3) SBAR(); }
                LDS_WAIT();
                bf16* Ob = MIX + (size_t)(si.row0 + qpos0) * LDX + h * 256;
#pragma unroll
                for (int i = 0; i < 16; ++i) { const int row = 2 * i + hi; const u32x4 v = *(const LAS u32x4*)(img + row * 256 + r32 * 8);
                    *(u32x4*)(Ob + (size_t)row * LDX + r32 * 8) = v; }
            }
        }
        __syncthreads();
    }
    SEAM(8);

    if (IN(9)) REPS(9) {
        unsigned char* ws = KWS(); float* ssq = (float*)(ws + WS_CTL + CTL_SSQ); bf16* XB = (bf16*)(ws + WS_XB); bf16* MIX = (bf16*)(ws + WS_MIX); bf16* HMID = (bf16*)(ws + WS_PROJ); bf16* PROJ = HMID;
        float* X = KOUT(); const float* x_prompt = KIN(0); const float* x_sample = KIN(1);
        bf16* WOE = (bf16*)(ws + WS_WOE); bf16* WIO = (bf16*)(ws + WS_WIO); bf16* WOO = (bf16*)(ws + WS_WOO);
        bf16* WGU0 = (bf16*)(ws + WS_WGU0); bf16* WGU1 = (bf16*)(ws + WS_WGU1); bf16* WD0 = (bf16*)(ws + WS_WD0); bf16* WD1 = (bf16*)(ws + WS_WD1);
        (void)ssq; (void)XB; (void)MIX; (void)HMID; (void)PROJ; (void)X; (void)x_prompt; (void)x_sample; (void)WOE; (void)WIO; (void)WOO; (void)WGU0; (void)WGU1; (void)WD0; (void)WD1;
        gm::GridOrder S; S.init(NTOK, DM, F.G, (int)blockIdx.x, MIX, (size_t)LDX * 2, WOO, (size_t)LDX * 2, X, DM, 4); S.sh48 = (ORD48 & 2) != 0;
        gm::EpiResid E{x_prompt, x_sample, 0, X, XB, ssq + 3 * NTOK, 1};
        gm::gemm_phase(F.lds, F.wave, DM, LDX, LDX, S, E);
    }
    SEAM(9);
    if (IN(10)) REPS(10) {
        unsigned char* ws = KWS(); float* ssq = (float*)(ws + WS_CTL + CTL_SSQ); bf16* XB = (bf16*)(ws + WS_XB); bf16* MIX = (bf16*)(ws + WS_MIX); bf16* HMID = (bf16*)(ws + WS_PROJ); bf16* PROJ = HMID;
        float* X = KOUT(); const float* x_prompt = KIN(0); const float* x_sample = KIN(1);
        bf16* WOE = (bf16*)(ws + WS_WOE); bf16* WIO = (bf16*)(ws + WS_WIO); bf16* WOO = (bf16*)(ws + WS_WOO);
        bf16* WGU0 = (bf16*)(ws + WS_WGU0); bf16* WGU1 = (bf16*)(ws + WS_WGU1); bf16* WD0 = (bf16*)(ws + WS_WD0); bf16* WD1 = (bf16*)(ws + WS_WD1);
        (void)ssq; (void)XB; (void)MIX; (void)HMID; (void)PROJ; (void)X; (void)x_prompt; (void)x_sample; (void)WOE; (void)WIO; (void)WOO; (void)WGU0; (void)WGU1; (void)WD0; (void)WD1;
        gm::GridOrder S; S.init(NTOK, 2 * FF, F.G, (int)blockIdx.x, XB, (size_t)LDX * 2, WGU1, (size_t)LDX * 2, HMID, FF, 2);
        gm::EpiSwiglu E{ssq + 3 * NTOK, HMID};
        gm::gemm_phase(F.lds, F.wave, DM, LDX, LDX, S, E);
    }
    SEAM(10);
    if (IN(11)) REPS(11) {
        unsigned char* ws = KWS(); float* ssq = (float*)(ws + WS_CTL + CTL_SSQ); bf16* XB = (bf16*)(ws + WS_XB); bf16* MIX = (bf16*)(ws + WS_MIX); bf16* HMID = (bf16*)(ws + WS_PROJ); bf16* PROJ = HMID;
        float* X = KOUT(); const float* x_prompt = KIN(0); const float* x_sample = KIN(1);
        bf16* WOE = (bf16*)(ws + WS_WOE); bf16* WIO = (bf16*)(ws + WS_WIO); bf16* WOO = (bf16*)(ws + WS_WOO);
        bf16* WGU0 = (bf16*)(ws + WS_WGU0); bf16* WGU1 = (bf16*)(ws + WS_WGU1); bf16* WD0 = (bf16*)(ws + WS_WD0); bf16* WD1 = (bf16*)(ws + WS_WD1);
        (void)ssq; (void)XB; (void)MIX; (void)HMID; (void)PROJ; (void)X; (void)x_prompt; (void)x_sample; (void)WOE; (void)WIO; (void)WOO; (void)WGU0; (void)WGU1; (void)WD0; (void)WD1;
        gm::GridOrder S; S.init(NTOK, DM, F.G, (int)blockIdx.x, HMID, (size_t)FF * 2, WD1, (size_t)FF * 2, X, DM, 4); S.sh48 = (ORD48 & 1) != 0;
        gm::EpiResid E{x_prompt, x_sample, 0, X, XB, ssq + 4 * NTOK, 0};
        gm::gemm_phase(F.lds, F.wave, FF, FF, FF, S, E);
    }
    SEAM(11);
    if (IN(12)) REPS(12) {
        float* X = KOUT(); const float* norm_final = KIN(18); float* ssq = (float*)(KWS() + WS_CTL + CTL_SSQ);
        const int gw = F.vcu * 8 + F.wave, NGW = F.G * 8, fl = lane_id_opaque();
        for (int m = gw; m < NTOK; m += NGW) {
            const float rs = __builtin_amdgcn_rsqf(ssq[4 * NTOK + m] * (1.0f / DM) + RMS_EPS);
            float* xr = X + (size_t)m * DM;
#pragma unroll 4
            for (int j = 0; j < 16; ++j) { const int cidx = j * 256 + fl * 4; const f32x4 v = *(const f32x4*)(xr + cidx); const f32x4 g = *(const f32x4*)(norm_final + cidx);
                *(f32x4*)(xr + cidx) = v * rs * g; }
        }
    }
#undef IN
#undef SEAM
}

extern "C" void kernel_launch(void* const* d_in, const int* in_sizes, int n_in, void* d_out, int out_size, void* d_ws, size_t ws_size, hipStream_t stream) {
    static int grid = 0;
    if (grid == 0) {
        if (n_in != 19 || out_size != NTOK * DM || ws_size < WS_END) { fprintf(stderr, "kernel_launch: unexpected shapes: n_in %d out %d ws %zu (need %zu)\n", n_in, out_size, ws_size, (size_t)WS_END); grid = -1; return; }
        int dev = 0, cus = 0, per_cu = 0;
        if (hipGetDevice(&dev) != hipSuccess || hipDeviceGetAttribute(&cus, hipDeviceAttributeMultiprocessorCount, dev) != hipSuccess) { grid = -1; return; }
        if (hipFuncSetAttribute((const void*)mega_fwd, hipFuncAttributeMaxDynamicSharedMemorySize, LDS_BYTES) != hipSuccess) { fprintf(stderr, "kernel_launch: hipFuncSetAttribute failed\n"); grid = -1; return; }
        if (hipOccupancyMaxActiveBlocksPerMultiprocessor(&per_cu, (const void*)mega_fwd, 512, LDS_BYTES) != hipSuccess || per_cu < 1)
            fprintf(stderr, "kernel_launch: occupancy query reports %d\n", per_cu);
        (void)hipGetLastError();
        grid = cus;
    }
    if (grid < 0) return;
    (void)hipMemsetAsync((char*)d_ws + WS_CTL, 0, CTL_ZERO_BYTES, stream);
    Args a{};
    for (int i = 0; i < 19; ++i) a.in[i] = (const float*)d_in[i];
    a.out = (float*)d_out; a.ws = (unsigned char*)d_ws;
    hipLaunchKernelGGL(mega_fwd, dim3(grid), dim3(512), LDS_BYTES, stream, a);
    const hipError_t le = hipPeekAtLastError();
    if (le != hipSuccess) fprintf(stderr, "kernel_launch: launch failed: %s\n", hipGetErrorName(le));
}
```

```cpp
#include <hip/hip_runtime.h>
#include <cstdio>
#include <cstdint>

#define GAS __attribute__((address_space(1)))
#define LAS __attribute__((address_space(3)))
typedef unsigned short bf16;
typedef short bf16x8 __attribute__((ext_vector_type(8)));
typedef short s16x4 __attribute__((ext_vector_type(4)));
typedef float f32x4 __attribute__((ext_vector_type(4)));
typedef float f32x16 __attribute__((ext_vector_type(16)));
typedef unsigned u32x4 __attribute__((ext_vector_type(4)));
typedef unsigned u32x2 __attribute__((ext_vector_type(2)));

constexpr int DM = 4096, NTOK = 24576, NTOK_P = 16384, FF = 11008;
constexpr int LDX = DM + 128;
constexpr int EVEN_IN = 8192, ODD_IN = 12288;
constexpr float RMS_EPS = 1e-6f, SUBLN_EPS = 1e-5f;
constexpr float LOG2E = 1.4426950408889634f;
constexpr float ATT_C = 0.088388347648318440f * LOG2E;
constexpr float LAM_INIT = 0.35550906759f;

constexpr size_t MiB = 1u << 20;
constexpr size_t WS_CTL = 0, CTL_ZERO_BYTES = 1 * MiB;
constexpr size_t WROW = (size_t)LDX * 2;
constexpr size_t WS_WIE = 2 * MiB, WS_WOE = WS_WIE + 8192 * WROW, WS_WIO = WS_WOE + 4096 * WROW, WS_WOO = WS_WIO + 12288 * WROW;
constexpr size_t WS_WGU0 = WS_WOO + 4096 * WROW, WS_WGU1 = WS_WGU0 + 22016 * WROW, WS_WD0 = WS_WGU1 + 22016 * WROW, WS_WD1 = WS_WD0 + 86 * MiB;
constexpr size_t WS_XB = WS_WD1 + 86 * MiB, WS_MIX = WS_XB + (size_t)NTOK * WROW, WS_PROJ = WS_MIX + (size_t)NTOK * WROW, WS_VT = WS_PROJ + 384 * MiB, WS_END = WS_PROJ + 576 * MiB;
static_assert(WS_END <= (size_t)1864 * MiB && WS_WGU0 % 256 == 0 && WS_XB % 256 == 0 && WS_PROJ % 256 == 0, "workspace map");
constexpr size_t DO_T8 = 0, DO_T2 = 128 * MiB, DO_FC = 136 * MiB, DO_PQ8 = 144 * MiB, DO_PQ2 = 208 * MiB;
#ifndef DFT_HERM
#define DFT_HERM 1
#endif
constexpr size_t DO_T8S = 240 * MiB, DO_P256 = 304 * MiB, DO_WS2 = 320 * MiB, DO_WSP = 321 * MiB;
constexpr int CW_BAR = 4096;
constexpr int CW_LAM = 64;
constexpr size_t CTL_SSQ = 65536;
static_assert(CTL_SSQ + 5 * (size_t)NTOK * 4 <= CTL_ZERO_BYTES, "ctl");

constexpr int RING_BYTES = 131072;
constexpr int EX_OFF = RING_BYTES, EX_MISC = EX_OFF, EX_WS = EX_OFF + 256, EX_TAB = EX_OFF + 2304;
constexpr int LDS_BYTES = 147456;

#define LDS_WAIT() asm volatile("s_waitcnt lgkmcnt(0)" ::: "memory")
#define VM_WAIT() asm volatile("s_waitcnt vmcnt(0)" ::: "memory")
#define SBAR() __builtin_amdgcn_sched_barrier(0)

__device__ __forceinline__ unsigned cvt_pk_bf16(float lo, float hi) { unsigned r; asm volatile("v_cvt_pk_bf16_f32 %0, %1, %2" : "=v"(r) : "v"(lo), "v"(hi)); return r; }

#define XB_TMO      128
#define XB_XCNT(j)  (256  + 64 * (j))
#define XB_XSUB(j)  (1280 + 64 * (j))
#define XB_XGEN(j)  (2304 + 64 * (j))
#define XB_TOP      3328
#define XB_TOPGEN   3392
#define XCD_BAR_WORDS 3456
#define XB_SPIN_CAP (1u << 20)
__device__ __forceinline__ unsigned xb_ld(unsigned* p)              { return __hip_atomic_load(p, __ATOMIC_RELAXED, __HIP_MEMORY_SCOPE_AGENT); }
__device__ __forceinline__ unsigned xb_add(unsigned* p, unsigned v) { return __hip_atomic_fetch_add(p, v, __ATOMIC_RELAXED, __HIP_MEMORY_SCOPE_AGENT); }
__device__ __forceinline__ unsigned xb_xcc_id() { return (unsigned)__builtin_amdgcn_s_getreg((3 << 11) | 20) & 0xFu; }
#define XB_SPIN(cond, bar) do { unsigned _sp = 0; while (cond) { __builtin_amdgcn_s_sleep(1); \
    if ((++_sp & 255u) == 0u) { if (xb_ld(&(bar)[XB_TMO])) break; if (_sp > XB_SPIN_CAP) { atomicAdd(&(bar)[XB_TMO], 1u); break; } } } } while (0)
struct XcdBarrier { unsigned* bar; unsigned x; volatile LAS unsigned* st; };
__device__ __forceinline__ XcdBarrier xcd_barrier_post(unsigned* bar, volatile LAS unsigned* st) {
    XcdBarrier b; b.bar = bar; b.x = xb_xcc_id(); b.st = st;
    if (threadIdx.x == 0) (void)xb_add(&bar[XB_XCNT(b.x)], 1u);
    return b;
}
__device__ __forceinline__ void xcd_barrier_complete(unsigned* bar, unsigned x, unsigned& nloc, unsigned& nx) {
    const unsigned G = gridDim.x * gridDim.y * gridDim.z;
    unsigned sum, cnt, mine, sp = 0u;
    for (;;) {
        sum = 0u; cnt = 0u; mine = 0u;
#pragma unroll
        for (unsigned j = 0; j < 16; ++j) { const unsigned c = xb_ld(&bar[XB_XCNT(j)]); sum += c; cnt += (c > 0u) ? 1u : 0u; mine = (j == x) ? c : mine; }
        if (sum == G) break;
        __builtin_amdgcn_s_sleep(1);
        if ((++sp & 255u) == 0u) { if (xb_ld(&bar[XB_TMO])) break; if (sp > XB_SPIN_CAP) { atomicAdd(&bar[XB_TMO], 1u); break; } }
    }
    nloc = mine > 0u ? mine : 1u; nx = cnt > 0u ? cnt : 1u;
}
__device__ __forceinline__ void xcd_barrier(const XcdBarrier& b) {
    asm volatile("s_waitcnt vmcnt(0)" ::: "memory");
    __syncthreads();
    if (threadIdx.x == 0) {
        unsigned* bar = b.bar;
        __builtin_amdgcn_s_waitcnt(0);
        unsigned nloc = b.st[0], nx = b.st[1];
        if (nloc == 0u) { xcd_barrier_complete(bar, b.x, nloc, nx); b.st[0] = nloc; b.st[1] = nx; }
        const unsigned old = xb_add(&bar[XB_XSUB(b.x)], 1u);
        const unsigned gen = old / nloc;
        if (old + 1u == (gen + 1u) * nloc) {
            __builtin_amdgcn_fence(__ATOMIC_RELEASE, "agent");
            asm volatile("s_waitcnt vmcnt(0)" ::: "memory");
            const unsigned og = xb_add(&bar[XB_TOP], 1u);
            const unsigned tg = og / nx;
            if (og + 1u == (tg + 1u) * nx) xb_add(&bar[XB_TOPGEN], 1u);
            else XB_SPIN(xb_ld(&bar[XB_TOPGEN]) == tg, bar);
            __builtin_amdgcn_fence(__ATOMIC_ACQUIRE, "agent");
            xb_add(&bar[XB_XGEN(b.x)], 1u);
            asm volatile("s_waitcnt vmcnt(0)" ::: "memory");
        } else {
            XB_SPIN(xb_ld(&bar[XB_XGEN(b.x)]) == gen, bar);
            __builtin_amdgcn_fence(__ATOMIC_ACQUIRE, "agent");
            asm volatile("s_waitcnt vmcnt(0)" ::: "memory");
        }
    }
    __syncthreads();
}

__device__ __forceinline__ int lane_id_opaque() { int l = (int)__builtin_amdgcn_mbcnt_hi(~0u, __builtin_amdgcn_mbcnt_lo(~0u, 0u)); asm volatile("" : "+v"(l)); return l & 63; }

__device__ __forceinline__ float dpp_f(float v, int ctrl_sel) {
    const int x = __float_as_int(v); int r;
    if (ctrl_sel == 0) r = __builtin_amdgcn_mov_dpp(x, 0xB1, 0xF, 0xF, true);
    else if (ctrl_sel == 1) r = __builtin_amdgcn_mov_dpp(x, 0x4E, 0xF, 0xF, true);
    else if (ctrl_sel == 2) r = __builtin_amdgcn_mov_dpp(x, 0x141, 0xF, 0xF, true);
    else r = __builtin_amdgcn_mov_dpp(x, 0x140, 0xF, 0xF, true);
    return __int_as_float(r);
}
__device__ __forceinline__ float sum_rows16(float v) {
    auto rr = __builtin_amdgcn_permlane16_swap(__float_as_uint(v), __float_as_uint(v), false, false); return __uint_as_float(rr[0]) + __uint_as_float(rr[1]);
}
__device__ __forceinline__ float sum_halves32(float v) {
    auto rr = __builtin_amdgcn_permlane32_swap(__float_as_uint(v), __float_as_uint(v), false, false); return __uint_as_float(rr[0]) + __uint_as_float(rr[1]);
}
__device__ __forceinline__ float sum_row16(float v) {
    v += dpp_f(v, 0); v += dpp_f(v, 1); v += dpp_f(v, 2); v += dpp_f(v, 3); return v;
}

namespace gm {
constexpr int BM = 256, BK = 64, HALF = 128, HTB = HALF * BK * 2, NXCD = 8, WGM = 8;
__host__ __device__ __forceinline__ int lds_byte(int r, int c) { const int st = (r >> 4) * 2 + (c >> 5), rr = r & 15, cc = c & 31, ob = rr * 64 + cc * 2; return st * 1024 + (ob ^ (((ob >> 9) & 1) << 5)); }
__host__ __device__ __forceinline__ void stage_rc(int b, int& R, int& C) { const int st = b / 1024, sb = b % 1024, swz = sb ^ (((sb >> 9) & 1) << 5); R = (st >> 1) * 16 + swz / 64; C = (st & 1) * 32 + (swz % 64) / 2; }
__host__ __device__ __forceinline__ int perm32(int rho) { const int n = rho >> 4, i = rho & 15; return 8 * (i >> 2) + 4 * n + (i & 3); }

struct Unit { const char* A; const char* B; char* C; int ldc; int row0; int col0; };

#ifndef ORD48
#define ORD48 3
#endif
struct GridOrder {
    int nM, nN, nwg, G, c; const char* A; const char* B; char* C; size_t atile, btile; int ldc, esz; bool sh48 = false;
    __device__ __forceinline__ void init(int M, int N, int G_, int c_, const void* A_, size_t lda_bytes, const void* B_, size_t ldb_bytes, void* C_, int ldc_, int esz_) {
        nM = M / BM; nN = N / BM; nwg = nM * nN; G = G_; c = c_; A = (const char*)A_; B = (const char*)B_; C = (char*)C_; atile = lda_bytes * BM; btile = ldb_bytes * BM; ldc = ldc_; esz = esz_; }
    __device__ __forceinline__ bool next(int i, Unit& u) const {
        int pm, pn;
        if (G == 256 && nM == 96 && (nN & 1) == 0) {
            const int x = c & 7, e = i * 32 + (c >> 3), nA = 8 * nN;
            if (sh48 && nN == 16) {
                const int q = e & 31, r = e >> 5; if (r >= 6) return false;
                if (r < 4) { pm = 8 * x + 4 * (r >> 1) + (q & 3); pn = 8 * (r & 1) + (q >> 2); }
                else { pm = 64 + 8 * (x >> 1) + 4 * (r - 4) + (q & 3); pn = 8 * (x & 1) + (q >> 2); }
            } else
            if (e < nA) { pn = e >> 3; pm = 8 * x + (e & 7); }
            else { const int e2 = e - nA; if (e2 >= 4 * nN) return false; pn = (nN >> 1) * (x & 1) + (e2 >> 3); pm = 64 + 8 * (x >> 1) + (e2 & 7); }
        } else {
        const long L = (long)i * G + c; if (L >= nwg) return false;
        int wgid = (int)L; { const int q = nwg / NXCD, r = nwg % NXCD, xcd = wgid % NXCD, off = wgid / NXCD; wgid = (xcd < r ? xcd * (q + 1) : r * (q + 1) + (xcd - r) * q) + off; }
        const int nig = WGM * nN, gid = wgid / nig, fm = gid * WGM, gsz = (nM - fm) < WGM ? (nM - fm) : WGM;
        pm = fm + ((wgid % nig) % gsz); pn = (wgid % nig) / gsz;
        }
        u.A = A + (size_t)pm * atile; u.B = B + (size_t)pn * btile; u.row0 = pm * BM; u.col0 = pn * BM; u.ldc = ldc;
        u.C = C + ((size_t)u.row0 * ldc + u.col0) * esz; return true;
    }
};

__device__ __forceinline__ void load_rstd8(float (&rs)[8], const float* ssq, int row0, int wr, int fr, float scale) {
    if (ssq) {
#pragma unroll
        for (int g = 0; g < 8; ++g) rs[g] = ssq[row0 + (g >> 2) * HALF + wr * 64 + (g & 3) * 16 + fr];
#pragma unroll
        for (int g = 0; g < 8; ++g) rs[g] = __builtin_amdgcn_rsqf(rs[g] * (1.0f / DM) + RMS_EPS) * scale;
    } else {
#pragma unroll
        for (int g = 0; g < 8; ++g) rs[g] = scale;
    }
}
struct EpiBf16 {
    static constexpr bool PERM = true;
    const float* ssq; float scale;
    __device__ __forceinline__ void operator()(const f32x4 (&acc)[2][2][4][2], const Unit& u, int wr, int wc, int fr, int fq) const {
        bf16* base = (bf16*)u.C + wc * 32 + 8 * fq;
        float rs[8]; load_rstd8(rs, ssq, u.row0, wr, fr, scale);
#pragma unroll
        for (int ai = 0; ai < 2; ++ai)
#pragma unroll
            for (int m = 0; m < 4; ++m) { int r = ai * HALF + wr * 64 + m * 16 + fr; asm volatile("" : "+v"(r));
                const float s = rs[ai * 4 + m];
                bf16* rowp = base + (size_t)r * u.ldc;
#pragma unroll
                for (int bj = 0; bj < 2; ++bj) { const f32x4 v0 = acc[ai][bj][m][0] * s, v1 = acc[ai][bj][m][1] * s;
                    u32x4 w; w.x = cvt_pk_bf16(v0[0], v0[1]); w.y = cvt_pk_bf16(v0[2], v0[3]); w.z = cvt_pk_bf16(v1[0], v1[1]); w.w = cvt_pk_bf16(v1[2], v1[3]);
                    *(u32x4*)(rowp + bj * HALF) = w; } }
    }
};
struct EpiSwiglu {
    static constexpr bool PERM = true;
    const float* ssq; bf16* H;
    __device__ __forceinline__ void operator()(const f32x4 (&acc)[2][2][4][2], const Unit& u, int wr, int wc, int fr, int fq) const {
        bf16* base = H + (size_t)u.row0 * FF + (u.col0 >> 1) + wc * 32 + 8 * fq;
        float rs[8]; load_rstd8(rs, ssq, u.row0, wr, fr, 1.0f);
#pragma unroll
        for (int ai = 0; ai < 2; ++ai)
#pragma unroll
            for (int m = 0; m < 4; ++m) { int r = ai * HALF + wr * 64 + m * 16 + fr; asm volatile("" : "+v"(r));
                const float s = rs[ai * 4 + m];
                float hv[8];
#pragma unroll
                for (int n = 0; n < 2; ++n)
#pragma unroll
                    for (int j = 0; j < 4; ++j) { const float g = acc[ai][0][m][n][j] * s, up = acc[ai][1][m][n][j] * s;
                        const float e = __builtin_amdgcn_exp2f(-g * LOG2E); hv[n * 4 + j] = g * __builtin_amdgcn_rcpf(1.0f + e) * up; }
                u32x4 w; w.x = cvt_pk_bf16(hv[0], hv[1]); w.y = cvt_pk_bf16(hv[2], hv[3]); w.z = cvt_pk_bf16(hv[4], hv[5]); w.w = cvt_pk_bf16(hv[6], hv[7]);
                *(u32x4*)(base + (size_t)r * FF) = w; }
    }
};
struct EpiResid {
    static constexpr bool PERM = false;
    const float* xp; const float* xs; int from_input;
    float* X; bf16* XB; float* ssq; int write_xb; LAS float* red = nullptr;
    __device__ __forceinline__ void operator()(const f32x4 (&acc)[2][2][4][2], const Unit& u, int wr, int wc, int fr, int fq) const {
        const float* rbase = from_input ? (u.row0 < NTOK_P ? xp + (size_t)u.row0 * DM : xs + (size_t)(u.row0 - NTOK_P) * DM) : X + (size_t)u.row0 * DM;
        const int c0 = u.col0 + wc * 32 + 4 * fq;
        f32x4 rv[4], rn[4];
        { int r = wr * 64 + fr; asm volatile("" : "+v"(r)); const unsigned off = (unsigned)r * DM + c0;
#pragma unroll
          for (int q = 0; q < 4; ++q) rv[q] = *(const f32x4*)(rbase + off + (q >> 1) * HALF + (q & 1) * 16); }
#pragma unroll
        for (int g = 0; g < 8; ++g) { const int ai = g >> 2, m = g & 3;
            if (g < 7) { int r2 = ((g + 1) >> 2) * HALF + wr * 64 + ((g + 1) & 3) * 16 + fr; asm volatile("" : "+v"(r2)); const unsigned off2 = (unsigned)r2 * DM + c0;
#pragma unroll
                for (int q = 0; q < 4; ++q) rn[q] = *(const f32x4*)(rbase + off2 + (q >> 1) * HALF + (q & 1) * 16); }
            int r = ai * HALF + wr * 64 + m * 16 + fr; asm volatile("" : "+v"(r));
            const unsigned off = (unsigned)r * DM + c0, offx = (unsigned)r * LDX + c0;
            float s = 0.f;
#pragma unroll
            for (int bj = 0; bj < 2; ++bj)
#pragma unroll
                for (int n = 0; n < 2; ++n) { const f32x4 v = rv[bj * 2 + n] + acc[ai][bj][m][n];
                    *(f32x4*)(X + (size_t)u.row0 * DM + off + bj * HALF + n * 16) = v;
                    s += (v[0] * v[0] + v[1] * v[1]) + (v[2] * v[2] + v[3] * v[3]);
                    if (write_xb) { u32x2 w; w.x = cvt_pk_bf16(v[0], v[1]); w.y = cvt_pk_bf16(v[2], v[3]); *(u32x2*)(XB + (size_t)u.row0 * LDX + offx + bj * HALF + n * 16) = w; } }
            s = sum_halves32(sum_rows16(s));
            if (red) { if (fq == 0) red[((wr * 4 + wc) * 8 + g) * 16 + fr] = s; }
            else if (fq == 0) unsafeAtomicAdd(ssq + u.row0 + r, s);
#pragma unroll
            for (int q = 0; q < 4; ++q) rv[q] = rn[q];
        }
        if (red) {
            asm volatile("s_waitcnt lgkmcnt(0)" ::: "memory"); __builtin_amdgcn_s_barrier(); asm volatile("" ::: "memory");
            const int l32 = fq * 16 + fr;
            if (l32 < 32) { const int gg = 2 * wc + (l32 >> 4), f2 = l32 & 15;
                const float tot = (red[((wr * 4 + 0) * 8 + gg) * 16 + f2] + red[((wr * 4 + 1) * 8 + gg) * 16 + f2]) + (red[((wr * 4 + 2) * 8 + gg) * 16 + f2] + red[((wr * 4 + 3) * 8 + gg) * 16 + f2]);
                unsafeAtomicAdd(ssq + u.row0 + (gg >> 2) * HALF + wr * 64 + (gg & 3) * 16 + f2, tot); }
        }
    }
};

template <class Epi, class Sched>
__device__ __forceinline__ void gemm_phase(LAS unsigned char* lds, const int wave, const int K, const int lda, const int ldb, const Sched& S, const Epi& E) {
    const int lane = lane_id_opaque(), wid = wave, tid = wid * 64 + lane, wr = wid >> 2, wc = wid & 3, fr = lane & 15, fq = lane >> 4;
    const int nt = K / BK;
    unsigned voffA[2], voffB[2];
#pragma unroll
    for (int i = 0; i < 2; ++i) { int R, C; stage_rc(tid * 16 + i * 8192, R, C); const int Rb = Epi::PERM ? ((R & ~31) + perm32(R & 31)) : R;
        voffA[i] = (unsigned)(R * lda + C) * 2u; voffB[i] = (unsigned)(Rb * ldb + C) * 2u; }
    const size_t kstep = (size_t)(BK * 2);
    const size_t hstepA = (size_t)HALF * lda * 2, hstepB = (size_t)HALF * ldb * 2;
    const unsigned ldsw = (unsigned)wid * 1024u;
    const int aoff = lds_byte(wr * 64 + fr, fq * 8), boff = lds_byte(wc * 32 + fr, fq * 8);
#define PG8_SA(b, h) (((b) * 2 + (h)) * HTB)
#define PG8_SB(b, h) ((4 + (b) * 2 + (h)) * HTB)
#define PG8_STAGE(bufoff, gbase, voff) do { _Pragma("unroll") for (int _i = 0; _i < 2; ++_i) \
        __builtin_amdgcn_global_load_lds((const unsigned*)((const char*)(gbase) + (voff)[_i]), (LAS unsigned*)(lds + (bufoff) + ldsw + _i * 8192), 16, 0, 0); } while (0)
#define PG8_LDA(dst, b, h) do { _Pragma("unroll") for (int m = 0; m < 4; ++m) _Pragma("unroll") for (int k = 0; k < 2; ++k) dst[m][k] = *(const LAS bf16x8*)(lds + PG8_SA(b, h) + aoff + m * 2048 + k * 1024); } while (0)
#define PG8_LDB(dst, b, h) do { _Pragma("unroll") for (int n = 0; n < 2; ++n) _Pragma("unroll") for (int k = 0; k < 2; ++k) dst[n][k] = *(const LAS bf16x8*)(lds + PG8_SB(b, h) + boff + n * 2048 + k * 1024); } while (0)
#ifndef GEMM_PRIO
#define GEMM_PRIO 1
#endif
#define PG8_MMA(ai, bj, At, Bt) do { if (GEMM_PRIO) __builtin_amdgcn_s_setprio(GEMM_PRIO); _Pragma("unroll") for (int m = 0; m < 4; ++m) _Pragma("unroll") for (int n = 0; n < 2; ++n) _Pragma("unroll") for (int k = 0; k < 2; ++k) \
        acc[ai][bj][m][n] = __builtin_amdgcn_mfma_f32_16x16x32_bf16(Bt[n][k], At[m][k], acc[ai][bj][m][n], 0, 0, 0); if (GEMM_PRIO) __builtin_amdgcn_s_setprio(0); } while (0)
#define PG8_WAIT_V(n) asm volatile("s_waitcnt vmcnt(" #n ")" ::: "memory")
#define PG8_WAIT_L(n) asm volatile("s_waitcnt lgkmcnt(" #n ")" ::: "memory")
#define PG8_BAR __builtin_amdgcn_s_barrier()
#define PG8_SCHED __builtin_amdgcn_sched_barrier(0)
    Unit cur, nxt; int ui = 0;
    if (!S.next(0, cur)) return;
    f32x4 acc[2][2][4][2];
#pragma unroll
    for (int a = 0; a < 2; ++a)
#pragma unroll
        for (int b = 0; b < 2; ++b)
#pragma unroll
            for (int m = 0; m < 4; ++m)
#pragma unroll
                for (int n = 0; n < 2; ++n) acc[a][b][m][n] = (f32x4){0.f, 0.f, 0.f, 0.f};
    bf16x8 At[4][2], B0[2][2], B1[2][2];
    const char* cA = cur.A; const char* cB = cur.B;
#ifndef GEMM_SP2
#define GEMM_SP2 1
#endif
#if GEMM_SP2
    PG8_STAGE(PG8_SB(0, 0), cB, voffB); PG8_STAGE(PG8_SB(0, 1), cB + hstepB, voffB); PG8_STAGE(PG8_SA(0, 0), cA, voffA); PG8_STAGE(PG8_SA(0, 1), cA + hstepA, voffA);
    if (wr == 1) PG8_BAR;
    PG8_WAIT_V(2); PG8_BAR;
    PG8_STAGE(PG8_SB(1, 0), cB + kstep, voffB); PG8_STAGE(PG8_SA(1, 0), cA + kstep, voffA); PG8_STAGE(PG8_SB(1, 1), cB + hstepB + kstep, voffB);
    PG8_WAIT_V(6); PG8_BAR;
#else
    PG8_STAGE(PG8_SB(0, 0), cB, voffB); PG8_STAGE(PG8_SA(0, 0), cA, voffA); PG8_STAGE(PG8_SB(0, 1), cB + hstepB, voffB); PG8_STAGE(PG8_SA(0, 1), cA + hstepA, voffA);
    if (wr == 1) PG8_BAR;
    PG8_WAIT_V(4); PG8_BAR;
    PG8_STAGE(PG8_SB(1, 0), cB + kstep, voffB); PG8_STAGE(PG8_SA(1, 0), cA + kstep, voffA); PG8_STAGE(PG8_SB(1, 1), cB + hstepB + kstep, voffB);
    PG8_WAIT_V(6); PG8_BAR;
#endif
    for (;;) {
        const bool has_next = S.next(ui + 1, nxt);
        const char* nA = has_next ? nxt.A : cA; const char* nB = has_next ? nxt.B : cB;
        asm volatile(".p2align 7");
        for (int t = 0; t < nt; t += 2) {
            const bool last = (t == nt - 2);
            const char* a1 = cA + (size_t)(t + 1) * kstep;
            const char* a2 = last ? nA : cA + (size_t)(t + 2) * kstep; const char* b2 = last ? nB : cB + (size_t)(t + 2) * kstep;
            const char* a3 = a2 + kstep; const char* b3 = b2 + kstep;
#if GEMM_SP2
            PG8_LDB(B0, 0, 0); PG8_LDB(B1, 0, 1); PG8_SCHED; PG8_LDA(At, 0, 0); PG8_STAGE(PG8_SA(1, 1), a1 + hstepA, voffA);
            PG8_WAIT_V(8); PG8_WAIT_L(0); PG8_BAR; PG8_MMA(0, 0, At, B0); PG8_MMA(0, 1, At, B1); PG8_BAR; PG8_SCHED;
            PG8_LDA(At, 0, 1); PG8_STAGE(PG8_SB(0, 0), b2, voffB); PG8_STAGE(PG8_SB(0, 1), b2 + hstepB, voffB); PG8_STAGE(PG8_SA(0, 0), a2, voffA);
            PG8_WAIT_V(8); PG8_WAIT_L(0); PG8_BAR; PG8_MMA(1, 0, At, B0); PG8_MMA(1, 1, At, B1); PG8_BAR; PG8_SCHED;
            PG8_LDB(B0, 1, 0); PG8_LDB(B1, 1, 1); PG8_SCHED; PG8_LDA(At, 1, 0); PG8_STAGE(PG8_SA(0, 1), a2 + hstepA, voffA);
            PG8_WAIT_V(8); PG8_WAIT_L(0); PG8_BAR; PG8_MMA(0, 0, At, B0); PG8_MMA(0, 1, At, B1); PG8_BAR; PG8_SCHED;
            PG8_LDA(At, 1, 1); PG8_STAGE(PG8_SB(1, 0), b3, voffB); PG8_STAGE(PG8_SB(1, 1), b3 + hstepB, voffB); PG8_STAGE(PG8_SA(1, 0), a3, voffA);
            PG8_WAIT_V(8); PG8_WAIT_L(0); PG8_BAR; PG8_MMA(1, 0, At, B0); PG8_MMA(1, 1, At, B1); PG8_BAR; PG8_SCHED;
#else
            PG8_LDB(B0, 0, 0); PG8_SCHED; PG8_LDA(At, 0, 0); PG8_STAGE(PG8_SA(1, 1), a1 + hstepA, voffA);
            PG8_WAIT_L(8); PG8_BAR; PG8_WAIT_L(0); PG8_MMA(0, 0, At, B0); PG8_BAR; PG8_SCHED;
            PG8_LDB(B1, 0, 1); PG8_STAGE(PG8_SB(0, 0), b2, voffB);
            PG8_BAR; PG8_WAIT_L(0); PG8_MMA(0, 1, At, B1); PG8_BAR;
            PG8_LDA(At, 0, 1); PG8_STAGE(PG8_SA(0, 0), a2, voffA);
            PG8_BAR; PG8_WAIT_L(0); PG8_MMA(1, 0, At, B0); PG8_BAR; PG8_SCHED;
            PG8_STAGE(PG8_SB(0, 1), b2 + hstepB, voffB);
            PG8_WAIT_V(6); PG8_BAR; PG8_MMA(1, 1, At, B1); PG8_BAR;
            PG8_LDB(B0, 1, 0); PG8_SCHED; PG8_LDA(At, 1, 0); PG8_STAGE(PG8_SA(0, 1), a2 + hstepA, voffA);
            PG8_WAIT_L(8); PG8_BAR; PG8_WAIT_L(0); PG8_MMA(0, 0, At, B0); PG8_BAR; PG8_SCHED;
            PG8_LDB(B1, 1, 1); PG8_STAGE(PG8_SB(1, 0), b3, voffB);
            PG8_BAR; PG8_WAIT_L(0); PG8_MMA(0, 1, At, B1); PG8_BAR;
            PG8_LDA(At, 1, 1); PG8_STAGE(PG8_SA(1, 0), a3, voffA);
            PG8_BAR; PG8_WAIT_L(0); PG8_MMA(1, 0, At, B0); PG8_BAR; PG8_SCHED;
            PG8_STAGE(PG8_SB(1, 1), b3 + hstepB, voffB);
            PG8_WAIT_V(6); PG8_BAR; PG8_MMA(1, 1, At, B1); PG8_BAR;
#endif
        }
        if (wr == 0) PG8_BAR;
        E(acc, cur, wr, wc, fr, fq);
        if (!has_next) break;
#pragma unroll
        for (int a = 0; a < 2; ++a)
#pragma unroll
            for (int b = 0; b < 2; ++b)
#pragma unroll
                for (int m = 0; m < 4; ++m)
#pragma unroll
                    for (int n = 0; n < 2; ++n) acc[a][b][m][n] = (f32x4){0.f, 0.f, 0.f, 0.f};
        cur = nxt; cA = nA; cB = nB; ++ui;
        if (wr == 1) PG8_BAR;
    }
    PG8_WAIT_V(0);
    PG8_BAR;
#undef PG8_SA
#undef PG8_SB
#undef PG8_STAGE
#undef PG8_LDA
#undef PG8_LDB
#undef PG8_MMA
#undef PG8_WAIT_V
#undef PG8_WAIT_L
#undef PG8_BAR
#undef PG8_SCHED
}
}

struct Frame {
    LAS unsigned char* lds;
    int wave, vcu, G;
};
struct SeqInfo { int row0, S; };
__device__ __forceinline__ SeqInfo seq_info(int q) { SeqInfo s; if (q < 2) { s.row0 = q * 8192; s.S = 8192; } else { s.row0 = NTOK_P + (q - 2) * 2048; s.S = 2048; } return s; }

__device__ __forceinline__ float wave_sum(float v) {
#pragma unroll
    for (int o = 1; o < 64; o <<= 1) v += __shfl_xor(v, o);
    return v;
}

__device__ __forceinline__ void p0_load(f32x4 (&v)[8], float (&gs)[8], const float* W, int N, const float* g, int k0, int n0, int lane) {
    const int n4 = (lane & 7) * 4;
#pragma unroll
    for (int i = 0; i < 8; ++i) { const int kk = (lane >> 3) + 8 * i;
        v[i] = *(const f32x4*)(W + (size_t)(k0 + kk) * N + n0 + n4);
        gs[i] = g ? g[k0 + kk] : 1.0f; }
}
__device__ __forceinline__ void p0_store(const f32x4 (&vv)[8], const float (&gs)[8], bf16* WT, int ldw, int k0, int drow0, LAS float* scr, int lane) {
    const int n4 = (lane & 7) * 4;
#pragma unroll
    for (int i = 0; i < 8; ++i) { const int kk = (lane >> 3) + 8 * i; const f32x4 v = vv[i] * gs[i];
        scr[kk * 33 + n4 + 0] = v[0]; scr[kk * 33 + n4 + 1] = v[1]; scr[kk * 33 + n4 + 2] = v[2]; scr[kk * 33 + n4 + 3] = v[3]; }
    LDS_WAIT(); asm volatile("" ::: "memory");
    const int c = lane & 7;
#pragma unroll
    for (int j = 0; j < 4; ++j) { const int n = (lane >> 3) + 8 * j; const LAS float* s = scr + (8 * c) * 33 + n;
        u32x4 o; o.x = cvt_pk_bf16(s[0 * 33], s[1 * 33]); o.y = cvt_pk_bf16(s[2 * 33], s[3 * 33]); o.z = cvt_pk_bf16(s[4 * 33], s[5 * 33]); o.w = cvt_pk_bf16(s[6 * 33], s[7 * 33]);
        *(u32x4*)(WT + (size_t)(drow0 + n) * ldw + k0 + 8 * c) = o; }
    LDS_WAIT(); asm volatile("" ::: "memory");
}
struct WJob { const float* W; const float* g; bf16* WT; int K, N, mode; };

#define KSWZ(row, colB) ((row) * 256 + ((colB) ^ (((row) & 7) << 4)))
__device__ __forceinline__ int crow(int r, int hi) { return (r & 3) + 8 * (r >> 2) + 4 * hi; }
__device__ __forceinline__ int swap23(int k) { return (k & ~0xC) | ((k & 4) << 1) | ((k & 8) >> 1); }
__device__ __forceinline__ int v_rd_base(int lane) { return ((lane & 3) << 3) | (((lane >> 2) & 3) << 6) | (((lane >> 4) & 1) << 5) | (((lane >> 5) & 1) << 8); }
template <int OFF> __device__ __forceinline__ s16x4 tr_read(unsigned vb) {
    s16x4 r; asm volatile("ds_read_b64_tr_b16 %0, %1 offset:%2" : "=&v"(r) : "v"(vb), "i"(OFF) : "memory"); return r;
}
__device__ __forceinline__ void qkt(f32x16& p0, f32x16& p1, const LAS unsigned char* Ks, const bf16x8 (&qr)[8], int r32, int hi) {
    p0 = (f32x16){0.f, 0.f, 0.f, 0.f, 0.f, 0.f, 0.f, 0.f, 0.f, 0.f, 0.f, 0.f, 0.f, 0.f, 0.f, 0.f}; p1 = p0;
    const LAS unsigned char* k0p = Ks + r32 * 256; const LAS unsigned char* k1p = Ks + (32 + r32) * 256; const int sw = (r32 & 7) << 4;
    bf16x8 a0 = *(const LAS bf16x8*)(k0p + ((hi * 16) ^ sw)), a1 = *(const LAS bf16x8*)(k1p + ((hi * 16) ^ sw));
#pragma unroll
    for (int d0 = 0; d0 < 8; ++d0) {
        bf16x8 n0 = a0, n1 = a1;
        if (d0 < 7) { const int cb = ((d0 + 1) * 32 + hi * 16) ^ sw; n0 = *(const LAS bf16x8*)(k0p + cb); n1 = *(const LAS bf16x8*)(k1p + cb); }
        p0 = __builtin_amdgcn_mfma_f32_32x32x16_bf16(a0, qr[d0], p0, 0, 0, 0);
        p1 = __builtin_amdgcn_mfma_f32_32x32x16_bf16(a1, qr[d0], p1, 0, 0, 0);
        a0 = n0; a1 = n1;
        SBAR();
    }
}
template <int D0, int NCB> __device__ __forceinline__ void pv_one(f32x16& od, unsigned vb, bf16x8 pa0, bf16x8 pa1, bf16x8 pa2, bf16x8 pa3) {
#define VRO(ks, half) (D0 * 512 + (ks) * (NCB * 1024) + (half) * (NCB * 512))
    const s16x4 l0 = tr_read<VRO(0, 0)>(vb), h0 = tr_read<VRO(0, 1)>(vb), l1 = tr_read<VRO(1, 0)>(vb), h1 = tr_read<VRO(1, 1)>(vb);
    const s16x4 l2 = tr_read<VRO(2, 0)>(vb), h2 = tr_read<VRO(2, 1)>(vb), l3 = tr_read<VRO(3, 0)>(vb), h3 = tr_read<VRO(3, 1)>(vb);
#undef VRO
    asm volatile("s_waitcnt lgkmcnt(0)" ::: "memory"); SBAR();
#define PK(L, H) (bf16x8){L[0], L[1], L[2], L[3], H[0], H[1], H[2], H[3]}
    od = __builtin_amdgcn_mfma_f32_32x32x16_bf16(pa0, PK(l0, h0), od, 0, 0, 0);
    od = __builtin_amdgcn_mfma_f32_32x32x16_bf16(pa1, PK(l1, h1), od, 0, 0, 0);
    od = __builtin_amdgcn_mfma_f32_32x32x16_bf16(pa2, PK(l2, h2), od, 0, 0, 0);
    od = __builtin_amdgcn_mfma_f32_32x32x16_bf16(pa3, PK(l3, h3), od, 0, 0, 0);
#undef PK
}
__device__ __forceinline__ void softmax_tile(f32x16& p0, f32x16& p1, float& m_reg, float& l_reg, float& alpha, bf16x8& pa0, bf16x8& pa1, bf16x8& pa2, bf16x8& pa3) {
    float pmax = p0[0];
#pragma unroll
    for (int r = 1; r < 16; ++r) pmax = fmaxf(pmax, p0[r]);
#pragma unroll
    for (int r = 0; r < 16; ++r) pmax = fmaxf(pmax, p1[r]);
    { auto rr = __builtin_amdgcn_permlane32_swap(__float_as_uint(pmax), __float_as_uint(pmax), false, false);
      pmax = fmaxf(__uint_as_float(rr[0]), __uint_as_float(rr[1])); }
    if (__all(pmax - m_reg <= 6.0f)) { alpha = 1.0f; }
    else { const float mn_ = fmaxf(m_reg, pmax); alpha = __builtin_amdgcn_exp2f(m_reg - mn_); m_reg = mn_; }
    const float mn = m_reg;
#pragma unroll
    for (int r = 0; r < 16; ++r) p0[r] = __builtin_amdgcn_exp2f(p0[r] - mn);
#pragma unroll
    for (int r = 0; r < 16; ++r) p1[r] = __builtin_amdgcn_exp2f(p1[r] - mn);
    float ps = 0.f;
#pragma unroll
    for (int r = 0; r < 16; ++r) ps += p0[r];
#pragma unroll
    for (int r = 0; r < 16; ++r) ps += p1[r];
    { auto rr = __builtin_amdgcn_permlane32_swap(__float_as_uint(ps), __float_as_uint(ps), false, false);
      ps = __uint_as_float(rr[0]) + __uint_as_float(rr[1]); }
    l_reg = l_reg * alpha + ps;
#define PK4(P, BASE, OUT) do { unsigned a0 = cvt_pk_bf16(P[BASE + 0], P[BASE + 1]), a1 = cvt_pk_bf16(P[BASE + 2], P[BASE + 3]);   \
    unsigned b0 = cvt_pk_bf16(P[BASE + 4], P[BASE + 5]), b1 = cvt_pk_bf16(P[BASE + 6], P[BASE + 7]);                              \
    auto r0 = __builtin_amdgcn_permlane32_swap(a0, b0, false, false); auto r1 = __builtin_amdgcn_permlane32_swap(a1, b1, false, false); \
    u32x4 w = {r0[0], r1[0], r0[1], r1[1]}; OUT = *reinterpret_cast<bf16x8*>(&w); } while (0)
    PK4(p0, 0, pa0); PK4(p0, 8, pa1); PK4(p1, 0, pa2); PK4(p1, 8, pa3);
#undef PK4
}
constexpr float SM_THR = 6.0f;
__device__ __forceinline__ void softmax_far(f32x16& p0, f32x16& p1, const float b, float& m_reg, float& l_reg, float& alpha, bf16x8& pa0, bf16x8& pa1, bf16x8& pa2, bf16x8& pa3) {
    float pmax = p0[0];
#pragma unroll
    for (int r = 1; r < 16; ++r) pmax = fmaxf(pmax, p0[r]);
#pragma unroll
    for (int r = 0; r < 16; ++r) pmax = fmaxf(pmax, p1[r]);
    { auto rr = __builtin_amdgcn_permlane32_swap(__float_as_uint(pmax), __float_as_uint(pmax), false, false);
      pmax = fmaxf(__uint_as_float(rr[0]), __uint_as_float(rr[1])); }
    const float pm = fmaf(pmax, ATT_C, b);
    if (__all(pm - m_reg <= SM_THR)) { alpha = 1.0f; }
    else { const float mn = fmaxf(m_reg, pm); alpha = __builtin_amdgcn_exp2f(m_reg - mn); m_reg = mn; }
    const float c = b - m_reg;
#pragma unroll
    for (int r = 0; r < 16; ++r) p0[r] = __builtin_amdgcn_exp2f(fmaf(p0[r], ATT_C, c));
#pragma unroll
    for (int r = 0; r < 16; ++r) p1[r] = __builtin_amdgcn_exp2f(fmaf(p1[r], ATT_C, c));
    float ps = 0.f;
#pragma unroll
    for (int r = 0; r < 16; ++r) ps += p0[r];
#pragma unroll
    for (int r = 0; r < 16; ++r) ps += p1[r];
    { auto rr = __builtin_amdgcn_permlane32_swap(__float_as_uint(ps), __float_as_uint(ps), false, false);
      ps = __uint_as_float(rr[0]) + __uint_as_float(rr[1]); }
    l_reg = l_reg * alpha + ps;
#define PK4(P, BASE, OUT) do { unsigned a0 = cvt_pk_bf16(P[BASE + 0], P[BASE + 1]), a1 = cvt_pk_bf16(P[BASE + 2], P[BASE + 3]);   \
    unsigned b0 = cvt_pk_bf16(P[BASE + 4], P[BASE + 5]), b1 = cvt_pk_bf16(P[BASE + 6], P[BASE + 7]);                              \
    auto r0 = __builtin_amdgcn_permlane32_swap(a0, b0, false, false); auto r1 = __builtin_amdgcn_permlane32_swap(a1, b1, false, false); \
    u32x4 w = {r0[0], r1[0], r0[1], r1[1]}; OUT = *reinterpret_cast<bf16x8*>(&w); } while (0)
    PK4(p0, 0, pa0); PK4(p0, 8, pa1); PK4(p1, 0, pa2); PK4(p1, 8, pa3);
#undef PK4
}
#ifndef ATT_CPRIO
#define ATT_CPRIO 1
#endif
#ifndef ATT_SPRIO
#define ATT_SPRIO 0
#endif
__device__ __forceinline__ bf16x8 lds_rd128(unsigned a) { bf16x8 r; asm volatile("ds_read_b128 %0, %1" : "=&v"(r) : "v"(a) : "memory"); return r; }
__device__ __forceinline__ void qkt_h(f32x16& p, const LAS unsigned char* Ks32, const bf16x8 (&qr)[8], int r32, int hi) {
    p = (f32x16){0.f, 0.f, 0.f, 0.f, 0.f, 0.f, 0.f, 0.f, 0.f, 0.f, 0.f, 0.f, 0.f, 0.f, 0.f, 0.f};
    const unsigned kb = (unsigned)(uintptr_t)Ks32 + (unsigned)r32 * 256u; const unsigned sw = (unsigned)(r32 & 7) << 4, h16 = (unsigned)hi * 16u;
#define KA(d0) (kb + ((((unsigned)(d0)) * 32u + h16) ^ sw))
#define WTK(N, F) asm volatile("s_waitcnt lgkmcnt(" #N ")" : "+v"(F) :: "memory")
#define MMK(F, d0) p = __builtin_amdgcn_mfma_f32_32x32x16_bf16(F, qr[d0], p, 0, 0, 0)
    bf16x8 f0 = lds_rd128(KA(0)), f1 = lds_rd128(KA(1));
    if (ATT_CPRIO) __builtin_amdgcn_s_setprio(1);
    WTK(1, f0); MMK(f0, 0); f0 = lds_rd128(KA(2));
    WTK(1, f1); MMK(f1, 1); f1 = lds_rd128(KA(3));
    WTK(1, f0); MMK(f0, 2); f0 = lds_rd128(KA(4));
    WTK(1, f1); MMK(f1, 3); f1 = lds_rd128(KA(5));
    WTK(1, f0); MMK(f0, 4); f0 = lds_rd128(KA(6));
    WTK(1, f1); MMK(f1, 5); f1 = lds_rd128(KA(7));
    WTK(1, f0); MMK(f0, 6);
    WTK(0, f1); MMK(f1, 7);
    if (ATT_CPRIO) __builtin_amdgcn_s_setprio(0);
#undef KA
#undef WTK
#undef MMK
}
#define PK4H(P, BASE, OUT) do { unsigned a0_ = cvt_pk_bf16(P[BASE + 0], P[BASE + 1]), a1_ = cvt_pk_bf16(P[BASE + 2], P[BASE + 3]);   \
    unsigned b0_ = cvt_pk_bf16(P[BASE + 4], P[BASE + 5]), b1_ = cvt_pk_bf16(P[BASE + 6], P[BASE + 7]);                              \
    auto r0_ = __builtin_amdgcn_permlane32_swap(a0_, b0_, false, false); auto r1_ = __builtin_amdgcn_permlane32_swap(a1_, b1_, false, false); \
    u32x4 w_ = {r0_[0], r1_[0], r0_[1], r1_[1]}; OUT = *reinterpret_cast<bf16x8*>(&w_); } while (0)
__device__ __forceinline__ void sm_tail_h(f32x16& p, const float alpha, float& l_reg, bf16x8& pa0, bf16x8& pa1) {
#pragma unroll
    for (int r = 0; r < 16; ++r) p[r] = __builtin_amdgcn_exp2f(p[r]);
    float ps = 0.f;
#pragma unroll
    for (int r = 0; r < 16; ++r) ps += p[r];
    { auto rr = __builtin_amdgcn_permlane32_swap(__float_as_uint(ps), __float_as_uint(ps), false, false);
      ps = __uint_as_float(rr[0]) + __uint_as_float(rr[1]); }
    l_reg = l_reg * alpha + ps;
    PK4H(p, 0, pa0); PK4H(p, 8, pa1);
}
__device__ __forceinline__ float rowmax_h(const f32x16& p) {
    float pmax = p[0];
#pragma unroll
    for (int r = 1; r < 16; ++r) pmax = fmaxf(pmax, p[r]);
    auto rr = __builtin_amdgcn_permlane32_swap(__float_as_uint(pmax), __float_as_uint(pmax), false, false);
    return fmaxf(__uint_as_float(rr[0]), __uint_as_float(rr[1]));
}
__device__ __forceinline__ float sm_decide(const float pm, float& m_reg) {
    if (__all(pm - m_reg <= SM_THR)) return 1.0f;
    const float mn = fmaxf(m_reg, pm); const float alpha = __builtin_amdgcn_exp2f(m_reg - mn); m_reg = mn; return alpha;
}
__device__ __forceinline__ void softmax_far_h(f32x16& p, const float b, float& m_reg, float& l_reg, float& alpha, bf16x8& pa0, bf16x8& pa1) {
    const float pm = fmaf(rowmax_h(p), ATT_C, b);
    alpha = sm_decide(pm, m_reg);
    const float c = b - m_reg;
#pragma unroll
    for (int r = 0; r < 16; ++r) p[r] = fmaf(p[r], ATT_C, c);
    sm_tail_h(p, alpha, l_reg, pa0, pa1);
}
__device__ __forceinline__ void softmax_near_h(f32x16& p, float& m_reg, float& l_reg, float& alpha, bf16x8& pa0, bf16x8& pa1) {
    alpha = sm_decide(rowmax_h(p), m_reg);
#pragma unroll
    for (int r = 0; r < 16; ++r) p[r] = p[r] - m_reg;
    sm_tail_h(p, alpha, l_reg, pa0, pa1);
}
template <int D0, int NCB, int HF> __device__ __forceinline__ void pv_half(f32x16& od, unsigned vb, bf16x8 pa0, bf16x8 pa1) {
#define VRO(ks, half) (D0 * 512 + (ks) * (NCB * 1024) + (half) * (NCB * 512))
    const s16x4 l0 = tr_read<VRO(2 * HF, 0)>(vb), h0 = tr_read<VRO(2 * HF, 1)>(vb), l1 = tr_read<VRO(2 * HF + 1, 0)>(vb), h1 = tr_read<VRO(2 * HF + 1, 1)>(vb);
#undef VRO
    asm volatile("s_waitcnt lgkmcnt(0)" ::: "memory"); SBAR();
#define PK(L, H) (bf16x8){L[0], L[1], L[2], L[3], H[0], H[1], H[2], H[3]}
    od = __builtin_amdgcn_mfma_f32_32x32x16_bf16(pa0, PK(l0, h0), od, 0, 0, 0);
    od = __builtin_amdgcn_mfma_f32_32x32x16_bf16(pa1, PK(l1, h1), od, 0, 0, 0);
#undef PK
}
struct NoHook { __device__ __forceinline__ void operator()(int) const {} };
template <int HF, class Hook = NoHook> __device__ __forceinline__ void pv_half8(f32x16 (&o)[8], unsigned vb, bf16x8 pa0, bf16x8 pa1, const Hook& hook = Hook()) {
#define VRO(d0, ks, half) ((d0) * 512 + (ks) * (8 * 1024) + (half) * (8 * 512))
#define RD4(d0, A, B, C, D) do { A = tr_read<VRO(d0, 2 * HF, 0)>(vb); B = tr_read<VRO(d0, 2 * HF, 1)>(vb); C = tr_read<VRO(d0, 2 * HF + 1, 0)>(vb); D = tr_read<VRO(d0, 2 * HF + 1, 1)>(vb); } while (0)
#define PK(L, H) (bf16x8){L[0], L[1], L[2], L[3], H[0], H[1], H[2], H[3]}
#define MM(d0, A, B, C, D) do { o[d0] = __builtin_amdgcn_mfma_f32_32x32x16_bf16(pa0, PK(A, B), o[d0], 0, 0, 0); o[d0] = __builtin_amdgcn_mfma_f32_32x32x16_bf16(pa1, PK(C, D), o[d0], 0, 0, 0); } while (0)
#define WT4(A, B, C, D) asm volatile("s_waitcnt lgkmcnt(4)" : "+v"(A), "+v"(B), "+v"(C), "+v"(D) :: "memory")
#define WT0(A, B, C, D) asm volatile("s_waitcnt lgkmcnt(0)" : "+v"(A), "+v"(B), "+v"(C), "+v"(D) :: "memory")
    s16x4 a0, a1, a2, a3, b0, b1, b2, b3;
    RD4(0, a0, a1, a2, a3);
    if (ATT_CPRIO) __builtin_amdgcn_s_setprio(1);
    RD4(1, b0, b1, b2, b3); WT4(a0, a1, a2, a3); MM(0, a0, a1, a2, a3); hook(0);
    RD4(2, a0, a1, a2, a3); WT4(b0, b1, b2, b3); MM(1, b0, b1, b2, b3);
    RD4(3, b0, b1, b2, b3); WT4(a0, a1, a2, a3); MM(2, a0, a1, a2, a3); hook(1);
    RD4(4, a0, a1, a2, a3); WT4(b0, b1, b2, b3); MM(3, b0, b1, b2, b3);
    RD4(5, b0, b1, b2, b3); WT4(a0, a1, a2, a3); MM(4, a0, a1, a2, a3); hook(2);
    RD4(6, a0, a1, a2, a3); WT4(b0, b1, b2, b3); MM(5, b0, b1, b2, b3);
    RD4(7, b0, b1, b2, b3); WT4(a0, a1, a2, a3); MM(6, a0, a1, a2, a3); hook(3);
    WT0(b0, b1, b2, b3); MM(7, b0, b1, b2, b3);
    if (ATT_CPRIO) __builtin_amdgcn_s_setprio(0);
#undef VRO
#undef RD4
#undef PK
#undef MM
#undef WT4
#undef WT0
}
__device__ __forceinline__ void k_src(int b, int& row, int& col) { row = b >> 8; const int cb = (b & 255) ^ ((row & 7) << 4); col = cb >> 1; }
template <int NCB> __device__ __forceinline__ void v_src(int b, int& key, int& col) {
    const int st = b >> 9, e = (b & 511) >> 1; const int kk = (st / NCB) * 8 + (e >> 5); key = swap23(kk); col = (st % NCB) * 32 + (e & 31);
}
__device__ __forceinline__ void glds16(const void* g, LAS unsigned char* l) { __builtin_amdgcn_global_load_lds((const unsigned*)g, (LAS unsigned*)l, 16, 0, 0); }

__device__ __forceinline__ const void* karg_ptr(int off) {
    asm volatile("" : "+s"(off));
    const __attribute__((address_space(4))) char* ka = (const __attribute__((address_space(4))) char*)__builtin_amdgcn_kernarg_segment_ptr();
    return *(const void* const __attribute__((address_space(4)))*)(ka + off);
}
#define KIN(i) ((const float*)karg_ptr(8 * (i)))
#define KOUT() ((float*)karg_ptr(152))
#define KWS() ((unsigned char*)karg_ptr(160))

struct Args { const float* in[19]; float* out; unsigned char* ws; };

__global__ void __launch_bounds__(512, 2) mega_fwd(Args args) {
    extern __shared__ __attribute__((aligned(16))) unsigned char lds_raw[];
    Frame F; F.lds = (LAS unsigned char*)lds_raw;
    F.wave = __builtin_amdgcn_readfirstlane(threadIdx.x >> 6);
    F.G = gridDim.x; { const int bx = blockIdx.x; F.vcu = (F.G % 8 == 0) ? (bx % 8) * (F.G / 8) + bx / 8 : bx; }
    volatile LAS unsigned* MISC = (volatile LAS unsigned*)(F.lds + EX_MISC);
    if (threadIdx.x < 64) MISC[threadIdx.x] = 0u;
    __syncthreads();
    (void)xcd_barrier_post((unsigned*)KWS() + CW_BAR, MISC + 8);
#ifndef PH_MASK
#define PH_MASK 0x3FFF
#endif
#define IN(k) ((PH_MASK >> (k)) & 1)
#ifndef REP_PHASE
#define REP_PHASE -1
#endif
#define REPS(k) _Pragma("unroll 1") for (int rep_ = 0; rep_ < ((REP_PHASE) == (k) ? 2 : 1); ++rep_)
#define SEAMX(a_, b_) do { if (IN(a_) && IN(b_)) { XcdBarrier b_x; b_x.bar = (unsigned*)KWS() + CW_BAR; b_x.x = xb_xcc_id(); b_x.st = MISC + 8; xcd_barrier(b_x); } } while (0)
#define SEAM(k) do { if (IN(k) && IN((k) + 1)) { XcdBarrier b_; b_.bar = (unsigned*)KWS() + CW_BAR; b_.x = xb_xcc_id(); b_.st = MISC + 8; xcd_barrier(b_); } } while (0)
#define P_XPROMPT KIN(0)
#define P_XSAMPLE KIN(1)
#define P_SSQ ((float*)(KWS() + WS_CTL + CTL_SSQ))
#define P_X KOUT()
#define P_WS(off) ((bf16*)(KWS() + (off)))

    if (IN(0)) REPS(0) {
        const float* x_prompt = KIN(0); const float* x_sample = KIN(1); const float* norm_mix = KIN(2); const float* norm_ffn = KIN(3);
        const float* w_in_even = KIN(4); const float* w_out_even = KIN(6); const float* w_in_odd = KIN(7); const float* w_out_odd = KIN(13);
        const float* w_gate = KIN(15); const float* w_up = KIN(16); const float* w_down = KIN(17);
        unsigned char* ws = KWS(); float* ssq = (float*)(ws + WS_CTL + CTL_SSQ); unsigned* ctl = (unsigned*)ws;
        bf16* WIE = (bf16*)(ws + WS_WIE); bf16* WOE = (bf16*)(ws + WS_WOE); bf16* WIO = (bf16*)(ws + WS_WIO); bf16* WOO = (bf16*)(ws + WS_WOO);
        bf16* WGU0 = (bf16*)(ws + WS_WGU0); bf16* WGU1 = (bf16*)(ws + WS_WGU1); bf16* WD0 = (bf16*)(ws + WS_WD0); bf16* WD1 = (bf16*)(ws + WS_WD1);
        bf16* XB = (bf16*)(ws + WS_XB);
        unsigned char* outb = (unsigned char*)KOUT(); bf16* T8 = (bf16*)(outb + DO_T8); bf16* T2 = (bf16*)(outb + DO_T2); bf16* FC = (bf16*)(outb + DO_FC);
        const int p0lane = lane_id_opaque(), p0tid = F.wave * 64 + p0lane;
        LAS float* scr = (LAS float*)(F.lds + F.wave * 16384);
        const int gw = F.vcu * 8 + F.wave, NGW = F.G * 8;
        const size_t WFF = (size_t)DM * FF;
        {
            constexpr int I0 = 64 * 256, I1 = 64 * 128, I2 = 64 * 384, I3 = 64 * 128, IG = 64 * 344, ID = 172 * 128;
            constexpr int NITEMS = I0 + I1 + I2 + I3 + 4 * IG + 2 * ID;
#define P0_ISSUE(X, it_) do { int r = (it_); WJob j; \
                if (r < I0) j = WJob{w_in_even, norm_mix, WIE, DM, EVEN_IN, 0}; \
                else if ((r -= I0) < I1) j = WJob{w_out_even, nullptr, WOE, DM, DM, 0}; \
                else if ((r -= I1) < I2) j = WJob{w_in_odd, norm_mix + DM, WIO, DM, ODD_IN, 0}; \
                else if ((r -= I2) < I3) j = WJob{w_out_odd, nullptr, WOO, DM, DM, 0}; \
                else if ((r -= I3) < IG) j = WJob{w_gate, norm_ffn, WGU0, DM, FF, 1}; \
                else if ((r -= IG) < IG) j = WJob{w_up, norm_ffn, WGU0, DM, FF, 2}; \
                else if ((r -= IG) < IG) j = WJob{w_gate + WFF, norm_ffn + DM, WGU1, DM, FF, 1}; \
                else if ((r -= IG) < IG) j = WJob{w_up + WFF, norm_ffn + DM, WGU1, DM, FF, 2}; \
                else if ((r -= IG) < ID) j = WJob{w_down, nullptr, WD0, FF, DM, 0}; \
                else { r -= ID; j = WJob{w_down + WFF, nullptr, WD1, FF, DM, 0}; } \
                const int nblk = j.N / 32, kb = r / nblk, nb = r % nblk, n0 = nb * 32; \
                wt##X = j.WT; ldw##X = j.K == DM ? LDX : j.K; k0##X = kb * 64; dr##X = j.mode == 0 ? n0 : (256 * (n0 >> 7) + (n0 & 127) + (j.mode == 2 ? 128 : 0)); \
                p0_load(v##X, g##X, j.W, j.N, j.g, kb * 64, n0, p0lane); } while (0)
            f32x4 vA[8], vB[8]; float gA[8], gB[8]; bf16* wtA = nullptr; bf16* wtB = nullptr; int ldwA = 0, ldwB = 0, k0A = 0, k0B = 0, drA = 0, drB = 0;
            if (gw < NITEMS) P0_ISSUE(A, gw);
            for (int it = gw; it < NITEMS; it += 2 * NGW) {
                const bool hasB = it + NGW < NITEMS, hasA2 = it + 2 * NGW < NITEMS;
                if (hasB) P0_ISSUE(B, it + NGW);
                p0_store(vA, gA, wtA, ldwA, k0A, drA, scr, p0lane);
                if (hasA2) P0_ISSUE(A, it + 2 * NGW);
                if (hasB) p0_store(vB, gB, wtB, ldwB, k0B, drB, scr, p0lane);
            }
#undef P0_ISSUE
        }
        for (int m = gw; m < NTOK; m += NGW) {
            const float* xr = (m < NTOK_P ? x_prompt + (size_t)m * DM : x_sample + (size_t)(m - NTOK_P) * DM);
            float s = 0.f;
#pragma unroll 4
            for (int j = 0; j < 16; ++j) { const f32x4 v = *(const f32x4*)(xr + j * 256 + p0lane * 4);
                s += (v[0] * v[0] + v[1] * v[1]) + (v[2] * v[2] + v[3] * v[3]);
                u32x2 w; w.x = cvt_pk_bf16(v[0], v[1]); w.y = cvt_pk_bf16(v[2], v[3]); *(u32x2*)(XB + (size_t)m * LDX + j * 256 + p0lane * 4) = w; }
            s = wave_sum(s);
            if (p0lane == 0) ssq[m] = s;
        }
        {
            const long gt = (long)F.vcu * 512 + p0tid, NGT = (long)F.G * 512;
            constexpr long C8 = 2L * 4096 * 8192 / 8, C2 = 2L * 1024 * 2048 / 8, CF = 1024L * 512 / 8, CS = DFT_HERM ? 4L * 4096 * 2048 / 8 : 0;
            bf16* T8S = (bf16*)(outb + DO_T8S);
            for (long ch = gt; ch < C8 + C2 + CF + CS; ch += NGT) {
                bf16* dst; int k, j0, S; bool sn;
                if (ch >= C8 + C2 + CF) { const long c = ch - (C8 + C2 + CF); const int kc = (int)(c / (4096L * 256)); const long c1 = c % (4096L * 256); k = (int)(c1 / 256); const int jj = (int)(c1 % 256) * 8; j0 = kc * 2048 + jj; S = 8192; sn = false; dst = T8S + ((size_t)kc * 4096 + k) * 2048 + jj; } else
                if (ch < C8) { const int wh = (int)(ch / (4096L * 1024)); const long c = ch % (4096L * 1024); k = (int)(c / 1024); j0 = (int)(c % 1024) * 8; S = 8192; sn = wh != 0; dst = T8 + ((size_t)wh * 4096 + k) * 8192 + j0; }
                else if (ch < C8 + C2) { const long c0 = ch - C8; const int wh = (int)(c0 / (1024L * 256)); const long c = c0 % (1024L * 256); k = (int)(c / 256); j0 = (int)(c % 256) * 8; S = 2048; sn = wh != 0; dst = T2 + ((size_t)wh * 1024 + k) * 2048 + j0; }
                else { const long c = ch - C8 - C2; k = (int)(c / 64); j0 = (int)(c % 64) * 8; S = 512; sn = k >= 512; if (sn) k -= 512; dst = FC + (size_t)(sn ? k + 512 : k) * 512 + j0; }
                float v[8];
#pragma unroll
                for (int e = 0; e < 8; ++e) { const int r = (k * (j0 + e)) & (S - 1); const float fr = (float)r / (float)S;
                    v[e] = sn ? __builtin_amdgcn_sinf(fr) : __builtin_amdgcn_cosf(fr); }
                u32x4 w; w.x = cvt_pk_bf16(v[0], v[1]); w.y = cvt_pk_bf16(v[2], v[3]); w.z = cvt_pk_bf16(v[4], v[5]); w.w = cvt_pk_bf16(v[6], v[7]);
                *(u32x4*)dst = w;
            }
        }
        if (blockIdx.x == 0 && F.wave == 0) {
            float a = 0.f, b = 0.f;
            const float* lambda_q1 = KIN(8); const float* lambda_k1 = KIN(9); const float* lambda_q2 = KIN(10); const float* lambda_k2 = KIN(11);
            for (int i = p0lane; i < 128; i += 64) { a += lambda_q1[i] * lambda_k1[i]; b += lambda_q2[i] * lambda_k2[i]; }
            a = wave_sum(a); b = wave_sum(b);
            if (p0lane == 0) ((float*)ctl)[CW_LAM] = __expf(a) - __expf(b) + LAM_INIT;
        }
    }
    SEAM(0);

    if (IN(1)) REPS(1) {
        unsigned char* ws = KWS(); float* ssq = (float*)(ws + WS_CTL + CTL_SSQ); bf16* XB = (bf16*)(ws + WS_XB); bf16* WIE = (bf16*)(ws + WS_WIE); bf16* PROJ = (bf16*)(ws + WS_PROJ);
        gm::GridOrder S; S.init(NTOK, EVEN_IN, F.G, (int)blockIdx.x, XB, (size_t)LDX * 2, WIE, (size_t)LDX * 2, PROJ, EVEN_IN, 2);
        gm::EpiBf16 E{ssq, 1.0f};
        gm::gemm_phase(F.lds, F.wave, DM, LDX, LDX, S, E);
    }
    SEAM(1);

    if (IN(2)) REPS(2) {
        unsigned char* ws = KWS(); bf16* PROJ = (bf16*)(ws + WS_PROJ); bf16* VT = (bf16*)(ws + WS_VT); bf16* MIX = (bf16*)(ws + WS_MIX);
        bf16* FC = (bf16*)((unsigned char*)KOUT() + DO_FC); const float* rpb_na = KIN(5);
        {
            struct Sch { int G, c; const bf16* FC; const bf16* PROJ; bf16* VT;
                __device__ __forceinline__ bool next(int i, gm::Unit& u) const {
                    int q, g, pm, pn;
#if DFT_HERM
                    const int L = i * G + c; if (L >= 768) return false;
                    if (L < 512) { q = L >> 8; const int r = L & 255; g = r >> 6; pm = ((r >> 5) & 1) * 2; pn = r & 31; }
                    else { const int l2 = L - 512; q = 2 + (l2 >> 6); const int r = l2 & 63; g = r >> 4; pm = ((r >> 3) & 1) * 2; pn = r & 7; }
#else
                    const int L = i * G + c; if (L >= 1536) return false;
                    if (L < 1024) { q = L >> 9; const int r = L & 511; g = r >> 7; pm = (r >> 5) & 3; pn = r & 31; }
                    else { const int l2 = L - 1024; q = 2 + (l2 >> 7); const int r = l2 & 127; g = r >> 5; pm = (r >> 3) & 3; pn = r & 7; }
#endif
                    const SeqInfo si = seq_info(q);
                    u.A = (const char*)(FC + (size_t)pm * 256 * 512);
                    u.B = (const char*)(PROJ + (size_t)(si.row0 + pn * 256) * EVEN_IN + 6144 + g * 512);
                    u.ldc = 2 * si.S; u.row0 = 0; u.col0 = 0;
                    u.C = (char*)(VT + (size_t)4096 * si.row0 + (size_t)(g * 512 + (pm & 1) * 256) * (2 * si.S) + (size_t)(pm >> 1) * si.S + pn * 256);
                    return true; } };
            Sch S{F.G, (int)blockIdx.x, FC, PROJ, VT};
            gm::EpiBf16 E{nullptr, 1.0f};
            gm::gemm_phase(F.lds, F.wave, 512, 512, EVEN_IN, S, E);
        }
#if DFT_HERM
        {
            unsigned char* outb = (unsigned char*)KOUT(); bf16* WSP = (bf16*)(outb + DO_WSP); float* WS2 = (float*)(outb + DO_WS2);
            const int lane = lane_id_opaque(), gw = F.vcu * 8 + F.wave, NGW = F.G * 8;
            for (int tok = gw; tok < NTOK; tok += NGW) {
                const bf16* ur = PROJ + (size_t)tok * EVEN_IN + 6144 + lane * 8; float acc4[4];
#pragma unroll
                for (int g = 0; g < 4; ++g) { const u32x4 v = *(const u32x4*)(ur + g * 512); float a = 0.f;
#pragma unroll
                    for (int e = 0; e < 4; ++e) a += __uint_as_float(v[e] << 16) - __uint_as_float(v[e] & 0xffff0000u);
                    acc4[g] = wave_sum(a); }
                if (lane < 4) { const float wv = lane == 0 ? acc4[0] : lane == 1 ? acc4[1] : lane == 2 ? acc4[2] : acc4[3];
                    if (tok < NTOK_P) { const int q = tok >> 13, s_ = tok & 8191; WSP[((size_t)(q * 4 + (s_ >> 11)) * 256 + lane) * 4096 + (s_ & 2047)] = (bf16)(cvt_pk_bf16(wv, 0.f) & 0xffffu); }
                    else { const int t2 = tok - NTOK_P; WS2[((t2 >> 11) * 4 + lane) * 2048 + (t2 & 2047)] = wv; } }
            }
        }
#endif
        {
            const int w = F.wave, rsel = w >> 2, hh = (w >> 1) & 1, c0 = 32 * (w & 1);
            LAS float* tab = (LAS float*)(F.lds + EX_TAB);
            LAS float* wsl = (LAS float*)(F.lds + EX_WS) + w * 64;
            const int upw = 1536 / F.G;
            const bool chunked = upw * F.G == 1536;
            for (int U = chunked ? F.vcu * upw : F.vcu; U < (chunked ? (F.vcu + 1) * upw : 1536); U += chunked ? 1 : F.G) {
                int q, hp, rp;
                if (U < 1024) { q = U >> 9; const int t = U & 511; hp = t >> 6; rp = t & 63; } else { const int t2 = U - 1024; q = 2 + (t2 >> 7); const int t = t2 & 127; hp = t >> 4; rp = t & 15; }
                const SeqInfo si = seq_info(q); const int rows = si.S >> 6;
                const int lane = lane_id_opaque(), tid = w * 64 + lane, r32 = lane & 31, hi = lane >> 5;
                const int r0 = 2 * rp, r = r0 + rsel;
                int rs0 = r0 - 4; rs0 = rs0 < 0 ? 0 : (rs0 > rows - 8 ? rows - 8 : rs0);
                int rs1 = r0 - 3; rs1 = rs1 < 0 ? 0 : (rs1 > rows - 8 ? rows - 8 : rs1);
                const int rsw = rsel ? rs1 : rs0, nrow = rs1 + 8 - rs0;
                const int h = 2 * hp + hh;
                __syncthreads();
                for (int e = tid; e < 2 * 2 * 8 * 32; e += 512) { const int dc = e & 31, i = (e >> 5) & 7, hd = (e >> 8) & 1, rsl = e >> 9; const int dr = (rsl ? rs1 : rs0) + i - (r0 + rsl) + 7;
                    tab[e] = dc < 31 ? rpb_na[((size_t)(2 * hp + hd) * 15 + dr) * 31 + dc] * LOG2E : 0.f; }
                bf16x8 qr[8];
                { const bf16* Qw = PROJ + (size_t)(si.row0 + r * 64 + c0 + r32) * EVEN_IN + h * 128 + hi * 8;
#pragma unroll
                  for (int d0 = 0; d0 < 8; ++d0) qr[d0] = *(const bf16x8*)(Qw + d0 * 16); }
                float m_reg = -1e30f, l_reg = 0.f; f32x16 o[4];
#pragma unroll
                for (int d = 0; d < 4; ++d) o[d] = (f32x16){0.f, 0.f, 0.f, 0.f, 0.f, 0.f, 0.f, 0.f, 0.f, 0.f, 0.f, 0.f, 0.f, 0.f, 0.f, 0.f};
                const int c = c0 + r32; int cs = c - 8; cs = cs < 0 ? 0 : (cs > 48 ? 48 : cs);
                constexpr unsigned LDE = EVEN_IN * 2;
                unsigned offA, offB;
                if (w < 4) { offA = (unsigned)(lane >> 4) * LDE + (unsigned)(((lane & 15) ^ ((lane >> 4) & 7)) << 4); offB = (unsigned)(lane >> 4) * LDE + (unsigned)(((lane & 15) ^ ((4 + (lane >> 4)) & 7)) << 4); }
                else { const int t = (lane & 31) >> 2; offA = (unsigned)((t & 3) + 8 * (t >> 2)) * LDE + (unsigned)(32 * hi + 8 * (lane & 3)) * 2u; offB = offA; }
                const char* kvb = (const char*)(PROJ + (size_t)si.row0 * EVEN_IN + (w < 4 ? 2048 : 4096) + (2 * hp + ((w >> 1) & 1)) * 128);
#define NA_DMA(kr_, bs_) do { const char* tb_ = kvb + (size_t)((kr_) * 64) * LDE; LAS unsigned char* dst_ = F.lds + (bs_) * 65536 + (w >> 1) * 16384 + (w & 1) * 8192; \
                if (w < 4) { _Pragma("unroll") for (int j_ = 0; j_ < 8; ++j_) glds16(tb_ + (size_t)(4 * (8 * (w & 1) + j_)) * LDE + ((j_ & 1) ? offB : offA), dst_ + j_ * 1024); } \
                else { _Pragma("unroll") for (int j_ = 0; j_ < 8; ++j_) { const int pi_ = 8 * (w & 1) + j_; glds16(tb_ + (size_t)(4 * ((pi_ >> 1) & 1) + 16 * (pi_ >> 2)) * LDE + 128 * (pi_ & 1) + offA, dst_ + j_ * 1024); } } } while (0)
                NA_DMA(rs0, 0);
                for (int t = 0; t < nrow; ++t) {
                    asm volatile("s_waitcnt vmcnt(0) lgkmcnt(0)" ::: "memory"); __builtin_amdgcn_s_barrier(); asm volatile("" ::: "memory");
                    if (t + 1 < nrow) NA_DMA(rs0 + t + 1, (t + 1) & 1);
                    const int i = rs0 + t - rsw;
                    if (i >= 0 && i < 8) {
                        const LAS unsigned char* Kl = F.lds + (t & 1) * 65536 + hh * 16384; const unsigned vb = (unsigned)(uintptr_t)(F.lds + (t & 1) * 65536 + 32768 + hh * 16384) + v_rd_base(lane);
                        f32x16 p0, p1; LDS_WAIT(); qkt(p0, p1, Kl, qr, r32, hi);
                        const LAS float* tb = tab + ((rsel * 2 + hh) * 8 + i) * 32;
#pragma unroll
                        for (int rr = 0; rr < 16; ++rr) {
                            { const int kc = crow(rr, hi); const bool ok = (unsigned)(kc - cs) < 16u; const int dc = kc - c + 15; const float bv = tb[ok ? dc : 0];
                              p0[rr] = ok ? fmaf(p0[rr], ATT_C, bv) : -1e30f; }
                            { const int kc = 32 + crow(rr, hi); const bool ok = (unsigned)(kc - cs) < 16u; const int dc = kc - c + 15; const float bv = tb[ok ? dc : 0];
                              p1[rr] = ok ? fmaf(p1[rr], ATT_C, bv) : -1e30f; }
                        }
                        float alpha; bf16x8 pa0, pa1, pa2, pa3;
                        softmax_tile(p0, p1, m_reg, l_reg, alpha, pa0, pa1, pa2, pa3);
                        if (__any(alpha < 1.f)) {
                            if (hi == 0) wsl[r32] = alpha; LDS_WAIT();
#pragma unroll
                            for (int d = 0; d < 4; ++d)
#pragma unroll
                                for (int rr = 0; rr < 16; ++rr) o[d][rr] *= wsl[crow(rr, hi)];
                        }
                        pv_one<0, 4>(o[0], vb, pa0, pa1, pa2, pa3); pv_one<1, 4>(o[1], vb, pa0, pa1, pa2, pa3); pv_one<2, 4>(o[2], vb, pa0, pa1, pa2, pa3); pv_one<3, 4>(o[3], vb, pa0, pa1, pa2, pa3);
                    }
                }
#undef NA_DMA
                if (hi == 0) wsl[32 + r32] = l_reg; LDS_WAIT();
                __syncthreads();
                LAS unsigned short* img = (LAS unsigned short*)(F.lds + w * 8192);
#pragma unroll
                for (int rr = 0; rr < 16; ++rr) { const int orow = crow(rr, hi); const float rl = __builtin_amdgcn_rcpf(wsl[32 + orow]);
#pragma unroll
                    for (int d = 0; d < 4; ++d) img[orow * 128 + d * 32 + r32] = (unsigned short)(cvt_pk_bf16(o[d][rr] * rl, 0.f) & 0xffffu); }
                LDS_WAIT();
                bf16* Ob = MIX + (size_t)(si.row0 + r * 64 + c0) * LDX + h * 128;
#pragma unroll
                for (int i2 = 0; i2 < 8; ++i2) { const int row = 4 * i2 + (lane >> 4); const u32x4 v = *(const LAS u32x4*)(img + row * 128 + (lane & 15) * 8);
                    *(u32x4*)(Ob + (size_t)row * LDX + (lane & 15) * 8) = v; }
            }
            __syncthreads();
        }
    }
    SEAM(2);

#if DFT_HERM
    if (IN(3)) REPS(3) {
        unsigned char* ws = KWS(); bf16* VT = (bf16*)(ws + WS_VT);
        unsigned char* outb = (unsigned char*)KOUT(); bf16* T8 = (bf16*)(outb + DO_T8); bf16* T2 = (bf16*)(outb + DO_T2); bf16* PQ8 = (bf16*)(outb + DO_PQ8); bf16* PQ2 = (bf16*)(outb + DO_PQ2);
        bf16* T8S = (bf16*)(outb + DO_T8S); bf16* WSP = (bf16*)(outb + DO_WSP); bf16* P256 = (bf16*)(outb + DO_P256);
        {
            struct Sch { int G, c; const bf16* T8; const bf16* VT; bf16* PQ;
                __device__ __forceinline__ bool next(int i, gm::Unit& u) const {
                    int q, wh, pm, g;
                    if (G == 256) { if (i >= 1) return false; const int x = c & 7, j = c >> 3; q = x >> 2; wh = (x >> 1) & 1; pm = (x & 1) * 8 + (j >> 2); g = j & 3; }
                    else { const int L = i * G + c; if (L >= 256) return false; q = L >> 7; wh = (L >> 6) & 1; pm = (L >> 2) & 15; g = L & 3; }
                    u.A = (const char*)(T8 + ((size_t)wh * 4096 + pm * 256) * 8192); u.B = (const char*)(VT + (size_t)4096 * (q * 8192) + (size_t)(2 * g) * 256 * 16384 + wh * 8192);
                    u.ldc = 2048; u.row0 = 0; u.col0 = 0; u.C = (char*)(PQ + ((size_t)(q * 2 + wh) * 4096 + pm * 256) * 2048 + (2 * g) * 256); return true; } };
            Sch S{F.G, (int)blockIdx.x, T8, VT, PQ8};
            gm::EpiBf16 E{nullptr, 1.0f / 2048.0f};
            gm::gemm_phase(F.lds, F.wave, 8192, 8192, 16384, S, E);
        }
        {
            struct Sch { int G, c; const bf16* T2; const bf16* VT; bf16* PQ; const bf16* T8S; const bf16* WSP; bf16* P256;
                __device__ __forceinline__ bool next(int i, gm::Unit& u) const {
                    const int L = i * G + c; if (L >= 256) return false;
                    u.row0 = 0; u.col0 = 0;
                    if (L < 128) { const int q = L >> 5, wh = (L >> 4) & 1, pm = (L >> 2) & 3, g = L & 3; const int row0 = NTOK_P + q * 2048;
                        u.A = (const char*)(T2 + ((size_t)wh * 1024 + pm * 256) * 2048); u.B = (const char*)(VT + (size_t)4096 * row0 + (size_t)(2 * g) * 256 * 4096 + wh * 2048);
                        u.ldc = 2048; u.C = (char*)(PQ + ((size_t)(q * 2 + wh) * 1024 + pm * 256) * 2048 + (2 * g) * 256); }
                    else { const int l2 = L - 128, q = l2 >> 6, pm = (l2 >> 2) & 15, kc = l2 & 3;
                        u.A = (const char*)(T8S + ((size_t)kc * 4096 + pm * 256) * 2048); u.B = (const char*)(WSP + (size_t)(q * 4 + kc) * 256 * 4096);
                        u.ldc = 256; u.C = (char*)(P256 + ((size_t)(q * 4 + kc) * 4096 + pm * 256) * 256); }
                    return true; } };
            Sch S{F.G, (int)blockIdx.x, T2, VT, PQ2, T8S, WSP, P256};
            gm::EpiBf16 E{nullptr, 1.0f / 1024.0f};
            gm::gemm_phase(F.lds, F.wave, 2048, 2048, 4096, S, E);
        }
    }
    SEAMX(3, 13);
    if (IN(13)) REPS(13) {
        unsigned char* ws = KWS(); const bf16* VT = (const bf16*)(ws + WS_VT); bf16* MIX = (bf16*)(ws + WS_MIX);
        unsigned char* outb = (unsigned char*)KOUT(); const bf16* PQ8 = (const bf16*)(outb + DO_PQ8); const bf16* PQ2 = (const bf16*)(outb + DO_PQ2);
        const bf16* T2 = (const bf16*)(outb + DO_T2); const bf16* WSP = (const bf16*)(outb + DO_WSP); const bf16* P256 = (const bf16*)(outb + DO_P256); const float* WS2 = (const float*)(outb + DO_WS2);
        const int lane = lane_id_opaque(), gw = F.vcu * 8 + F.wave, NGW = F.G * 8;
        for (int it = gw; it < NTOK * 4; it += NGW) {
            const int tok = it >> 2, g = it & 3;
            int q, row; if (tok < NTOK_P) { q = tok >> 13; row = tok & 8191; } else { const int t2 = tok - NTOK_P; q = 2 + (t2 >> 11); row = t2 & 2047; }
            const SeqInfo si = seq_info(q); const int Sh = si.S >> 1;
            if (row == Sh) continue;
            const bool fk = row > Sh; const int kp = fk ? si.S - row : row;
            const bf16* Pp = (q < 2 ? PQ8 + (size_t)q * 2 * 4096 * 2048 : PQ2 + (size_t)(q - 2) * 2 * 1024 * 2048) + (size_t)kp * 2048 + g * 512;
            const bf16* Qp = Pp + (size_t)Sh * 2048;
            float sp;
            if (q < 2) { float a = 0.f;
#pragma unroll
                for (int kc = 0; kc < 4; ++kc) a += __uint_as_float((unsigned)P256[((size_t)(q * 4 + kc) * 4096 + kp) * 256 + g] << 16);
                sp = 0.5f * a; }
            else { const bf16* tr = T2 + (size_t)kp * 2048 + lane * 32; const float* wr_ = WS2 + ((q - 2) * 4 + g) * 2048 + lane * 32; float a = 0.f;
#pragma unroll
                for (int e = 0; e < 4; ++e) { const u32x4 tv = *(const u32x4*)(tr + e * 8); const f32x4 w0 = *(const f32x4*)(wr_ + e * 8), w1 = *(const f32x4*)(wr_ + e * 8 + 4);
                    a += __uint_as_float(tv[0] << 16) * w0[0] + __uint_as_float(tv[0] & 0xffff0000u) * w0[1] + __uint_as_float(tv[1] << 16) * w0[2] + __uint_as_float(tv[1] & 0xffff0000u) * w0[3]
                       + __uint_as_float(tv[2] << 16) * w1[0] + __uint_as_float(tv[2] & 0xffff0000u) * w1[1] + __uint_as_float(tv[3] << 16) * w1[2] + __uint_as_float(tv[3] & 0xffff0000u) * w1[3]; }
                sp = wave_sum(a) * (1.0f / 1024.0f); }
            const int l0 = lane * 8; float pv[8], qv[8];
            if (lane < 32) { const u32x4 a = *(const u32x4*)(Pp + l0), b = *(const u32x4*)(Qp + l0);
#pragma unroll
                for (int e = 0; e < 4; ++e) { pv[2 * e] = __uint_as_float(a[e] << 16); pv[2 * e + 1] = __uint_as_float(a[e] & 0xffff0000u); qv[2 * e] = __uint_as_float(b[e] << 16); qv[2 * e + 1] = __uint_as_float(b[e] & 0xffff0000u); } }
            else {
                const u32x4 a = *(const u32x4*)(Pp + 504 - l0), b = *(const u32x4*)(Qp + 504 - l0); float ta[8], tb[8];
#pragma unroll
                for (int e = 0; e < 4; ++e) { ta[2 * e] = __uint_as_float(a[e] << 16); ta[2 * e + 1] = __uint_as_float(a[e] & 0xffff0000u); tb[2 * e] = __uint_as_float(b[e] << 16); tb[2 * e + 1] = __uint_as_float(b[e] & 0xffff0000u); }
#pragma unroll
                for (int j = 1; j < 8; ++j) { pv[j] = ta[8 - j]; qv[j] = -tb[8 - j]; }
                if (lane == 32) { pv[0] = sp; qv[0] = 0.f; }
                else { pv[0] = __uint_as_float((unsigned)Pp[512 - l0] << 16); qv[0] = -__uint_as_float((unsigned)Qp[512 - l0] << 16); } }
            float o8[8];
#pragma unroll
            for (int j = 0; j < 8; ++j) o8[j] = fk ? pv[j] + qv[j] : pv[j] - qv[j];
            u32x4 w; w.x = cvt_pk_bf16(o8[0], o8[1]); w.y = cvt_pk_bf16(o8[2], o8[3]); w.z = cvt_pk_bf16(o8[4], o8[5]); w.w = cvt_pk_bf16(o8[6], o8[7]);
            *(u32x4*)(MIX + (size_t)tok * LDX + 2048 + g * 512 + l0) = w;
        }
        for (int it = gw; it < 6 * 4 * 257; it += NGW) {
            const int q = it / (4 * 257), r = it % (4 * 257), g = r / 257, lp = r % 257; const SeqInfo si = seq_info(q);
            float acc = 0.f;
            if (lp < 256) { const bf16* vr = VT + (size_t)4096 * si.row0 + (size_t)(g * 512 + lp) * (2 * si.S);
                for (int s0 = lane * 8; s0 < si.S; s0 += 512) { const u32x4 v = *(const u32x4*)(vr + s0);
#pragma unroll
                    for (int e = 0; e < 4; ++e) acc += __uint_as_float(v[e] << 16) - __uint_as_float(v[e] & 0xffff0000u); } }
            else if (q < 2) { for (int s0 = lane * 8; s0 < 8192; s0 += 512) { const u32x4 v = *(const u32x4*)(WSP + ((size_t)(q * 4 + (s0 >> 11)) * 256 + g) * 4096 + (s0 & 2047));
#pragma unroll
                    for (int e = 0; e < 4; ++e) acc += __uint_as_float(v[e] << 16) - __uint_as_float(v[e] & 0xffff0000u); } }
            else { const float* wr_ = WS2 + ((q - 2) * 4 + g) * 2048; for (int s0 = lane * 4; s0 < 2048; s0 += 256) { const f32x4 v = *(const f32x4*)(wr_ + s0); acc += (v[0] - v[1]) + (v[2] - v[3]); } }
            acc = wave_sum(acc) * (si.S == 8192 ? 1.0f / 2048.0f : 1.0f / 1024.0f);
            if (lane == 0) { bf16* orow = MIX + (size_t)(si.row0 + (si.S >> 1)) * LDX + 2048 + g * 512; const bf16 hv = (bf16)(cvt_pk_bf16(acc, 0.f) & 0xffffu);
                orow[lp] = hv; if (lp > 0 && lp < 256) orow[512 - lp] = hv; }
        }
    }
#else
    if (IN(3)) REPS(3) {
        unsigned char* ws = KWS(); bf16* VT = (bf16*)(ws + WS_VT);
        unsigned char* outb = (unsigned char*)KOUT(); bf16* T8 = (bf16*)(outb + DO_T8); bf16* T2 = (bf16*)(outb + DO_T2); bf16* PQ8 = (bf16*)(outb + DO_PQ8); bf16* PQ2 = (bf16*)(outb + DO_PQ2);
        {
            struct Sch { int G, c; const bf16* T8; const bf16* VT; bf16* PQ;
                __device__ __forceinline__ bool next(int i, gm::Unit& u) const {
                    int q, wh, pm, pn;
                    if (G == 256) { if (i >= 2) return false; const int xcd = c & 7, j = c >> 3; q = i; wh = xcd >> 2; pm = (xcd & 3) * 4 + (j >> 3); pn = j & 7; }
                    else { const int L = i * G + c; if (L >= 512) return false; q = L >> 8; wh = (L >> 7) & 1; pm = (L >> 3) & 15; pn = L & 7; }
                    u.A = (const char*)(T8 + ((size_t)wh * 4096 + pm * 256) * 8192); u.B = (const char*)(VT + (size_t)4096 * (q * 8192) + (size_t)pn * 256 * 16384 + wh * 8192);
                    u.ldc = 2048; u.row0 = 0; u.col0 = 0; u.C = (char*)(PQ + ((size_t)(q * 2 + wh) * 4096 + pm * 256) * 2048 + pn * 256); return true; } };
            Sch S{F.G, (int)blockIdx.x, T8, VT, PQ8};
            gm::EpiBf16 E{nullptr, 1.0f / 2048.0f};
            gm::gemm_phase(F.lds, F.wave, 8192, 8192, 16384, S, E);
        }
        {
            struct Sch { int G, c; const bf16* T2; const bf16* VT; bf16* PQ;
                __device__ __forceinline__ bool next(int i, gm::Unit& u) const {
                    int q, wh, pm, pn;
                    if (G == 256) { if (i >= 1) return false; const int xcd = c & 7, j = c >> 3; q = xcd >> 1; wh = xcd & 1; pm = j >> 3; pn = j & 7; }
                    else { const int L = i * G + c; if (L >= 256) return false; q = L >> 6; wh = (L >> 5) & 1; pm = (L >> 3) & 3; pn = L & 7; }
                    const int row0 = NTOK_P + q * 2048;
                    u.A = (const char*)(T2 + ((size_t)wh * 1024 + pm * 256) * 2048); u.B = (const char*)(VT + (size_t)4096 * row0 + (size_t)pn * 256 * 4096 + wh * 2048);
                    u.ldc = 2048; u.row0 = 0; u.col0 = 0; u.C = (char*)(PQ + ((size_t)(q * 2 + wh) * 1024 + pm * 256) * 2048 + pn * 256); return true; } };
            Sch S{F.G, (int)blockIdx.x, T2, VT, PQ2};
            gm::EpiBf16 E{nullptr, 1.0f / 1024.0f};
            gm::gemm_phase(F.lds, F.wave, 2048, 2048, 4096, S, E);
        }
    }
    SEAMX(3, 13);
    if (IN(13)) REPS(13) {
        unsigned char* ws = KWS(); const bf16* VT = (const bf16*)(ws + WS_VT); bf16* MIX = (bf16*)(ws + WS_MIX);
        unsigned char* outb = (unsigned char*)KOUT(); const bf16* PQ8 = (const bf16*)(outb + DO_PQ8); const bf16* PQ2 = (const bf16*)(outb + DO_PQ2);
        const int lane = lane_id_opaque(), gw = F.vcu * 8 + F.wave, NGW = F.G * 8;
        for (int it = gw; it < 2 * 4096 * 4 + 4 * 1024 * 4; it += NGW) {
            int q, k, qt, Sh; const bf16* PQ;
            if (it < 32768) { q = it >> 14; k = (it >> 2) & 4095; qt = it & 3; Sh = 4096; PQ = PQ8 + (size_t)q * 2 * 4096 * 2048; }
            else { const int i2 = it - 32768; q = i2 >> 12; k = (i2 >> 2) & 1023; qt = i2 & 3; Sh = 1024; PQ = PQ2 + (size_t)q * 2 * 1024 * 2048; q += 2; }
            const SeqInfo si = seq_info(q); const int col = qt * 512 + lane * 8;
            const u32x4 pv = *(const u32x4*)(PQ + (size_t)k * 2048 + col), qv = *(const u32x4*)(PQ + ((size_t)Sh + k) * 2048 + col);
            u32x4 d, a;
#pragma unroll
            for (int e = 0; e < 4; ++e) { const float p0 = __uint_as_float(pv[e] << 16), p1 = __uint_as_float(pv[e] & 0xffff0000u), q0 = __uint_as_float(qv[e] << 16), q1 = __uint_as_float(qv[e] & 0xffff0000u);
                d[e] = cvt_pk_bf16(p0 - q0, p1 - q1); a[e] = cvt_pk_bf16(p0 + q0, p1 + q1); }
            *(u32x4*)(MIX + (size_t)(si.row0 + k) * LDX + 2048 + col) = d;
            if (k) *(u32x4*)(MIX + (size_t)(si.row0 + si.S - k) * LDX + 2048 + col) = a;
        }
        for (int it = gw; it < 6 * 2048; it += NGW) {
            const int q = it >> 11, c = it & 2047; const SeqInfo si = seq_info(q);
            const bf16* vr = VT + (size_t)4096 * si.row0 + (size_t)c * (2 * si.S);
            float acc = 0.f;
            for (int s0 = lane * 8; s0 < si.S; s0 += 512) { const u32x4 v = *(const u32x4*)(vr + s0);
#pragma unroll
                for (int e = 0; e < 4; ++e) acc += __uint_as_float(v[e] << 16) - __uint_as_float(v[e] & 0xffff0000u); }
            acc = wave_sum(acc) * (si.S == 8192 ? 1.0f / 2048.0f : 1.0f / 1024.0f);
            if (lane == 0) MIX[(size_t)(si.row0 + (si.S >> 1)) * LDX + 2048 + c] = (bf16)(cvt_pk_bf16(acc, 0.f) & 0xffffu);
        }
    }
#endif
    SEAMX(13, 4);

    if (IN(4)) REPS(4) {
        unsigned char* ws = KWS(); float* ssq = (float*)(ws + WS_CTL + CTL_SSQ); bf16* XB = (bf16*)(ws + WS_XB); bf16* MIX = (bf16*)(ws + WS_MIX); bf16* HMID = (bf16*)(ws + WS_PROJ); bf16* PROJ = HMID;
        float* X = KOUT(); const float* x_prompt = KIN(0); const float* x_sample = KIN(1);
        bf16* WOE = (bf16*)(ws + WS_WOE); bf16* WIO = (bf16*)(ws + WS_WIO); bf16* WOO = (bf16*)(ws + WS_WOO);
        bf16* WGU0 = (bf16*)(ws + WS_WGU0); bf16* WGU1 = (bf16*)(ws + WS_WGU1); bf16* WD0 = (bf16*)(ws + WS_WD0); bf16* WD1 = (bf16*)(ws + WS_WD1);
        (void)ssq; (void)XB; (void)MIX; (void)HMID; (void)PROJ; (void)X; (void)x_prompt; (void)x_sample; (void)WOE; (void)WIO; (void)WOO; (void)WGU0; (void)WGU1; (void)WD0; (void)WD1;
        gm::GridOrder S; S.init(NTOK, DM, F.G, (int)blockIdx.x, MIX, (size_t)LDX * 2, WOE, (size_t)LDX * 2, X, DM, 4); S.sh48 = (ORD48 & 2) != 0;
        gm::EpiResid E{x_prompt, x_sample, 1, X, XB, ssq + NTOK, 1}; E.red = (LAS float*)(F.lds + EX_OFF + 8192);
        gm::gemm_phase(F.lds, F.wave, DM, LDX, LDX, S, E);
    }
    SEAM(4);
    if (IN(5)) REPS(5) {
        unsigned char* ws = KWS(); float* ssq = (float*)(ws + WS_CTL + CTL_SSQ); bf16* XB = (bf16*)(ws + WS_XB); bf16* MIX = (bf16*)(ws + WS_MIX); bf16* HMID = (bf16*)(ws + WS_PROJ); bf16* PROJ = HMID;
        float* X = KOUT(); const float* x_prompt = KIN(0); const float* x_sample = KIN(1);
        bf16* WOE = (bf16*)(ws + WS_WOE); bf16* WIO = (bf16*)(ws + WS_WIO); bf16* WOO = (bf16*)(ws + WS_WOO);
        bf16* WGU0 = (bf16*)(ws + WS_WGU0); bf16* WGU1 = (bf16*)(ws + WS_WGU1); bf16* WD0 = (bf16*)(ws + WS_WD0); bf16* WD1 = (bf16*)(ws + WS_WD1);
        (void)ssq; (void)XB; (void)MIX; (void)HMID; (void)PROJ; (void)X; (void)x_prompt; (void)x_sample; (void)WOE; (void)WIO; (void)WOO; (void)WGU0; (void)WGU1; (void)WD0; (void)WD1;
        gm::GridOrder S; S.init(NTOK, 2 * FF, F.G, (int)blockIdx.x, XB, (size_t)LDX * 2, WGU0, (size_t)LDX * 2, HMID, FF, 2);
        gm::EpiSwiglu E{ssq + NTOK, HMID};
        gm::gemm_phase(F.lds, F.wave, DM, LDX, LDX, S, E);
    }
    SEAM(5);
    if (IN(6)) REPS(6) {
        unsigned char* ws = KWS(); float* ssq = (float*)(ws + WS_CTL + CTL_SSQ); bf16* XB = (bf16*)(ws + WS_XB); bf16* MIX = (bf16*)(ws + WS_MIX); bf16* HMID = (bf16*)(ws + WS_PROJ); bf16* PROJ = HMID;
        float* X = KOUT(); const float* x_prompt = KIN(0); const float* x_sample = KIN(1);
        bf16* WOE = (bf16*)(ws + WS_WOE); bf16* WIO = (bf16*)(ws + WS_WIO); bf16* WOO = (bf16*)(ws + WS_WOO);
        bf16* WGU0 = (bf16*)(ws + WS_WGU0); bf16* WGU1 = (bf16*)(ws + WS_WGU1); bf16* WD0 = (bf16*)(ws + WS_WD0); bf16* WD1 = (bf16*)(ws + WS_WD1);
        (void)ssq; (void)XB; (void)MIX; (void)HMID; (void)PROJ; (void)X; (void)x_prompt; (void)x_sample; (void)WOE; (void)WIO; (void)WOO; (void)WGU0; (void)WGU1; (void)WD0; (void)WD1;
        gm::GridOrder S; S.init(NTOK, DM, F.G, (int)blockIdx.x, HMID, (size_t)FF * 2, WD0, (size_t)FF * 2, X, DM, 4); S.sh48 = (ORD48 & 1) != 0;
        gm::EpiResid E{x_prompt, x_sample, 0, X, XB, ssq + 2 * NTOK, 1}; E.red = (LAS float*)(F.lds + EX_OFF + 8192);
        gm::gemm_phase(F.lds, F.wave, FF, FF, FF, S, E);
    }
    SEAM(6);
    if (IN(7)) REPS(7) {
        unsigned char* ws = KWS(); float* ssq = (float*)(ws + WS_CTL + CTL_SSQ); bf16* XB = (bf16*)(ws + WS_XB); bf16* MIX = (bf16*)(ws + WS_MIX); bf16* HMID = (bf16*)(ws + WS_PROJ); bf16* PROJ = HMID;
        float* X = KOUT(); const float* x_prompt = KIN(0); const float* x_sample = KIN(1);
        bf16* WOE = (bf16*)(ws + WS_WOE); bf16* WIO = (bf16*)(ws + WS_WIO); bf16* WOO = (bf16*)(ws + WS_WOO);
        bf16* WGU0 = (bf16*)(ws + WS_WGU0); bf16* WGU1 = (bf16*)(ws + WS_WGU1); bf16* WD0 = (bf16*)(ws + WS_WD0); bf16* WD1 = (bf16*)(ws + WS_WD1);
        (void)ssq; (void)XB; (void)MIX; (void)HMID; (void)PROJ; (void)X; (void)x_prompt; (void)x_sample; (void)WOE; (void)WIO; (void)WOO; (void)WGU0; (void)WGU1; (void)WD0; (void)WD1;
        gm::GridOrder S; S.init(NTOK, ODD_IN, F.G, (int)blockIdx.x, XB, (size_t)LDX * 2, WIO, (size_t)LDX * 2, PROJ, ODD_IN, 2);
        gm::EpiBf16 E{ssq + 2 * NTOK, 1.0f};
        gm::gemm_phase(F.lds, F.wave, DM, LDX, LDX, S, E);
    }
    SEAM(7);

    if (IN(8)) REPS(8) {
        unsigned char* ws = KWS(); bf16* PROJ = (bf16*)(ws + WS_PROJ); bf16* MIX = (bf16*)(ws + WS_MIX); const unsigned* ctl = (const unsigned*)ws;
        const float* subln_w = KIN(12); const float* t5_bias = KIN(14);
        const int w = F.wave, mp = w >> 2, wq = w & 3;
        LAS float* tab = (LAS float*)(F.lds + EX_TAB);
        LAS float* wsl = (LAS float*)(F.lds + EX_WS) + w * 64;
        const int NU = 3072;
        for (int uix = 0; ; ++uix) {
            int q, h, qb;
            if (F.G == 256) {
                if (uix >= 12) break;
                const int xv = F.vcu >> 5, lw = F.vcu & 31;
                if (uix < 8) { const int pair = xv * 4 + (uix >> 1); q = pair >> 4; h = pair & 15; qb = lw * 2 + (uix & 1); }
                else { const int pair = xv * 8 + (uix - 8) * 2 + (lw >> 4); q = 2 + (pair >> 4); h = pair & 15; qb = lw & 15; }
            } else {
                const int U = uix * F.G + F.vcu; if (U >= NU) break;
                if (U < 2048) { q = U >> 10; const int t = U & 1023; h = t >> 6; qb = t & 63; } else { const int t2 = U - 2048; q = 2 + (t2 >> 8); const int t = t2 & 255; h = t >> 4; qb = t & 15; }
            }
            const SeqInfo si = seq_info(q); const int NT = si.S >> 6;
            const int lane = lane_id_opaque(), tid = w * 64 + lane, r32 = lane & 31, hi = lane >> 5;
            __syncthreads();
            for (int e = tid; e < 257; e += 512) { const int rel = e - 128; const int n = rel < 0 ? -rel : rel; int bk = rel > 0 ? 16 : 0;
                if (n < 8) bk += n; else { int lg = 2 + (31 - __builtin_clz((unsigned)(n * n))); bk += lg > 15 ? 15 : lg; }
                tab[e] = t5_bias[bk * 16 + h] * LOG2E; }
            const int qpos0 = 128 * qb + 32 * wq;
            bf16x8 qr[8];
            { const bf16* Qw = PROJ + (size_t)(si.row0 + qpos0 + r32) * ODD_IN + h * 256 + mp * 128 + hi * 8;
#pragma unroll
              for (int d0 = 0; d0 < 8; ++d0) qr[d0] = *(const bf16x8*)(Qw + d0 * 16); }
            float m_reg = -1e30f, l_reg = 0.f; f32x16 o[8];
#pragma unroll
            for (int d = 0; d < 8; ++d) o[d] = (f32x16){0.f, 0.f, 0.f, 0.f, 0.f, 0.f, 0.f, 0.f, 0.f, 0.f, 0.f, 0.f, 0.f, 0.f, 0.f, 0.f};
            constexpr unsigned LDB = ODD_IN * 2;
            unsigned offA;
            if (w < 4) offA = (unsigned)(lane >> 4) * LDB + (unsigned)(((lane & 15) ^ ((lane >> 4) & 7)) << 4);
            else { const int t = (lane & 31) >> 2; offA = (unsigned)((t & 3) + 8 * (t >> 2)) * LDB + (unsigned)(32 * hi + 8 * (lane & 3)) * 2u; }
            const char* kvbase = (const char*)(PROJ + (size_t)si.row0 * ODD_IN + h * 256);
            const int NS = si.S >> 5;
            struct DmaHook { const char* kvbase; LAS unsigned char* ldsb; unsigned offA; int w, NS, step;
                __device__ __forceinline__ void operator()(int j_) const {
                    const int st_ = step < NS ? step : NS - 1; const char* tb_ = kvbase + (size_t)(st_ * 32) * (ODD_IN * 2); LAS unsigned char* dst_ = ldsb + (step & 3) * 32768 + w * 4096 + j_ * 1024;
                    if (w < 4) glds16(tb_ + (size_t)(4 * (w & 1)) * 4 * (ODD_IN * 2) + (4096 + (w >> 1) * 128) * 2 + (size_t)j_ * 4 * (ODD_IN * 2) + ((j_ & 1) ? (offA ^ 64u) : offA), dst_);
                    else glds16(tb_ + (size_t)(4 * ((w - 4) & 1) + 16 * ((w - 4) >> 1)) * (ODD_IN * 2) + 8192 * 2 + 128 * j_ + offA, dst_); } };
#define DA_DMA(step) do { const int st_ = (step) < NS ? (step) : NS - 1;      \
            const char* tb_ = kvbase + (size_t)(st_ * 32) * LDB; LAS unsigned char* dst_ = F.lds + ((step) & 3) * 32768 + w * 4096; \
            if (w < 4) { const char* t2_ = tb_ + (size_t)(4 * (w & 1)) * 4 * LDB + (4096 + (w >> 1) * 128) * 2; \
                _Pragma("unroll") for (int j_ = 0; j_ < 4; ++j_) glds16(t2_ + (size_t)j_ * 4 * LDB + ((j_ & 1) ? (offA ^ 64u) : offA), dst_ + j_ * 1024); } \
            else { const char* t2_ = tb_ + (size_t)(4 * ((w - 4) & 1) + 16 * ((w - 4) >> 1)) * LDB + 8192 * 2; \
                _Pragma("unroll") for (int j_ = 0; j_ < 4; ++j_) glds16(t2_ + 128 * j_ + offA, dst_ + j_ * 1024); } } while (0)
#ifndef ATT_PIPE
#define ATT_PIPE 0
#endif
            DA_DMA(0); DA_DMA(1);
#if ATT_PIPE
            DA_DMA(2);
#endif
            __syncthreads();
            const float bfarL = __builtin_bit_cast(float, __builtin_amdgcn_readfirstlane(__builtin_bit_cast(int, tab[0])));
            const float bfarR = __builtin_bit_cast(float, __builtin_amdgcn_readfirstlane(__builtin_bit_cast(int, tab[256])));
#define DA_QK(s_, P_) do { LDS_WAIT(); qkt_h(P_, F.lds + ((s_) & 3) * 32768 + mp * 8192, qr, r32, hi); } while (0)
#define DA_SM(s_, P_) do { \
                const int relmin = 32 * (s_) - (qpos0 + 31), relmax = 32 * (s_) + 31 - qpos0;     \
                SBAR(); \
                if (relmax <= -128 || relmin >= 128) { softmax_far_h(P_, relmax <= -128 ? bfarL : bfarR, m_reg, l_reg, alpha, pa0, pa1); } \
                else { const int relb = 32 * (s_) - (qpos0 + r32) + 128 + 4 * hi; \
                    _Pragma("unroll") for (int g4 = 0; g4 < 2; ++g4) { \
                        _Pragma("unroll") for (int r8 = 0; r8 < 8; ++r8) { const int rr = g4 * 8 + r8; int ix = relb + (rr & 3) + 8 * (rr >> 2); ix = ix < 0 ? 0 : (ix > 256 ? 256 : ix); P_[rr] = fmaf(P_[rr], ATT_C, tab[ix]); } \
                        SBAR(); } \
                    softmax_near_h(P_, m_reg, l_reg, alpha, pa0, pa1); } \
                SBAR(); \
                if (__any(alpha < 1.f)) { \
                    if (hi == 0) wsl[r32] = alpha; LDS_WAIT(); \
                    _Pragma("unroll") for (int g4 = 0; g4 < 4; ++g4) { \
                        _Pragma("unroll") for (int r4 = 0; r4 < 4; ++r4) { const int rr = g4 * 4 + r4; const float a = wsl[crow(rr, hi)]; \
                            _Pragma("unroll") for (int d = 0; d < 8; ++d) o[d][rr] *= a; } \
                        SBAR(); } } \
                SBAR(); } while (0)
#define DA_PV(s_) do { LDS_WAIT(); pv_half8<0>(o, (unsigned)(uintptr_t)(F.lds + ((s_) & 3) * 32768 + 16384) + v_rd_base(lane), pa0, pa1); } while (0)
#define DA_PVD(s_, dstep_) do { LDS_WAIT(); const DmaHook hk_{kvbase, F.lds, offA, w, NS, (dstep_)}; pv_half8<0>(o, (unsigned)(uintptr_t)(F.lds + ((s_) & 3) * 32768 + 16384) + v_rd_base(lane), pa0, pa1, hk_); } while (0)
#define DA_SYNC() do { asm volatile("s_waitcnt vmcnt(4)" ::: "memory"); __builtin_amdgcn_s_barrier(); asm volatile("" ::: "memory"); } while (0)
            float alpha; bf16x8 pa0, pa1;
#if ATT_PIPE
            f32x16 pA, pB;
            asm volatile("s_waitcnt vmcnt(8)" ::: "memory"); __builtin_amdgcn_s_barrier(); asm volatile("" ::: "memory");
            DA_QK(0, pA);
            for (int s_ = 0; s_ < NS; s_ += 2) {
                DA_SYNC();
                DA_QK(s_ + 1, pB); SBAR();
                DA_SM(s_, pA); DA_PVD(s_, s_ + 3);
                DA_SYNC();
                if (s_ + 2 < NS) { DA_QK(s_ + 2, pA); } SBAR();
                DA_SM(s_ + 1, pB); DA_PVD(s_ + 1, s_ + 4);
            }
#else
            if (ATT_SPRIO && mp == 1) __builtin_amdgcn_s_setprio(1);
#ifndef ATT_CUT
#define ATT_CUT 1
#endif
#if ATT_CUT
            if (mp == 0) {
                DA_SYNC(); DA_DMA(2);
                { f32x16 p; DA_QK(0, p); DA_SM(0, p); }
                for (int s_ = 1; s_ < NS; ++s_) {
                    DA_SYNC();
                    DA_PVD(s_ - 1, s_ + 2); SBAR(); { f32x16 p; DA_QK(s_, p); DA_SM(s_, p); }
                }
                DA_SYNC();
                DA_PV(NS - 1);
            } else {
                f32x16 p;
                DA_SYNC(); DA_DMA(2);
                DA_QK(0, p);
                for (int s_ = 1; s_ < NS; ++s_) {
                    DA_SYNC();
                    DA_SM(s_ - 1, p); DA_PVD(s_ - 1, s_ + 2); SBAR(); DA_QK(s_, p);
                }
                DA_SYNC();
                DA_SM(NS - 1, p); DA_PV(NS - 1);
            }
#else
            if (mp == 0) {
                for (int s_ = 0; s_ < NS; ++s_) {
                    DA_SYNC();
                    { f32x16 p; DA_QK(s_, p); DA_SM(s_, p); } DA_PVD(s_, s_ + 2);
                }
            } else {
                DA_SYNC(); DA_DMA(2);
                { f32x16 p; DA_QK(0, p); DA_SM(0, p); }
                for (int s_ = 1; s_ < NS; ++s_) {
                    DA_SYNC();
                    DA_PVD(s_ - 1, s_ + 2); SBAR(); { f32x16 p; DA_QK(s_, p); DA_SM(s_, p); }
                }
                DA_PV(NS - 1);
            }
#endif
            if (ATT_SPRIO) __builtin_amdgcn_s_setprio(0);
#endif
            VM_WAIT(); __syncthreads();
#undef DA_QK
#undef DA_SM
#undef DA_PV
#undef DA_PVD
#undef DA_SYNC
#undef DA_DMA
            if (hi == 0) wsl[32 + r32] = l_reg; LDS_WAIT();
            LAS float* xch = (LAS float*)(F.lds + wq * 32768);
            const float lsc = mp ? ((const float*)ctl)[CW_LAM] : 1.0f;
#pragma unroll
            for (int rr = 0; rr < 16; ++rr) { const float rl = __builtin_amdgcn_rcpf(wsl[32 + crow(rr, hi)]) * lsc;
#pragma unroll
                for (int d = 0; d < 8; ++d) o[d][rr] *= rl;
                if ((rr & 3) == 3) SBAR(); }
            if (mp == 1) {
#pragma unroll
                for (int d = 0; d < 8; ++d) {
#pragma unroll
                    for (int rr = 0; rr < 16; ++rr) xch[(d * 16 + rr) * 64 + lane] = o[d][rr];
                    SBAR(); }
            }
            __syncthreads();
            if (mp == 0) {
#pragma unroll
                for (int d = 0; d < 8; ++d) {
#pragma unroll
                    for (int rr = 0; rr < 16; ++rr) o[d][rr] -= xch[(d * 16 + rr) * 64 + lane];
                    SBAR(); }
                float gw_[8];
#pragma unroll
                for (int d = 0; d < 8; ++d) gw_[d] = subln_w[d * 32 + r32] * (1.0f - LAM_INIT);
                LAS unsigned short* img = (LAS unsigned short*)(F.lds + wq * 32768);
#pragma unroll
                for (int rr = 0; rr < 16; ++rr) { float s = 0.f;
#pragma unroll
                    for (int d = 0; d < 8; ++d) s += o[d][rr] * o[d][rr];
                    s = sum_rows16(sum_row16(s));
                    const float rs_ = __builtin_amdgcn_rsqf(s * (1.0f / 256.0f) + SUBLN_EPS);
#pragma unroll
                    for (int d = 0; d < 8; ++d) img[crow(rr, hi) * 256 + d * 32 + r32] = (unsigned short)(cvt_pk_bf16(o[d][rr] * rs_ * gw_[d], 0.f) & 0xffffu);
                    if ((rr & 3) == 3) SBAR(); }
                LDS_WAIT();
                bf16* Ob = MIX + (size_t)(si.row0 + qpos0) * LDX + h * 256;
#pragma unroll
                for (int i = 0; i < 16; ++i) { const int row = 2 * i + hi; const u32x4 v = *(const LAS u32x4*)(img + row * 256 + r32 * 8);
                    *(u32x4*)(Ob + (size_t)row * LDX + r32 * 8) = v; }
            }
        }
        __syncthreads();
    }
    SEAM(8);

    if (IN(9)) REPS(9) {
        unsigned char* ws = KWS(); float* ssq = (float*)(ws + WS_CTL + CTL_SSQ); bf16* XB = (bf16*)(ws + WS_XB); bf16* MIX = (bf16*)(ws + WS_MIX); bf16* HMID = (bf16*)(ws + WS_PROJ); bf16* PROJ = HMID;
        float* X = KOUT(); const float* x_prompt = KIN(0); const float* x_sample = KIN(1);
        bf16* WOE = (bf16*)(ws + WS_WOE); bf16* WIO = (bf16*)(ws + WS_WIO); bf16* WOO = (bf16*)(ws + WS_WOO);
        bf16* WGU0 = (bf16*)(ws + WS_WGU0); bf16* WGU1 = (bf16*)(ws + WS_WGU1); bf16* WD0 = (bf16*)(ws + WS_WD0); bf16* WD1 = (bf16*)(ws + WS_WD1);
        (void)ssq; (void)XB; (void)MIX; (void)HMID; (void)PROJ; (void)X; (void)x_prompt; (void)x_sample; (void)WOE; (void)WIO; (void)WOO; (void)WGU0; (void)WGU1; (void)WD0; (void)WD1;
        gm::GridOrder S; S.init(NTOK, DM, F.G, (int)blockIdx.x, MIX, (size_t)LDX * 2, WOO, (size_t)LDX * 2, X, DM, 4); S.sh48 = (ORD48 & 2) != 0;
        gm::EpiResid E{x_prompt, x_sample, 0, X, XB, ssq + 3 * NTOK, 1}; E.red = (LAS float*)(F.lds + EX_OFF + 8192);
        gm::gemm_phase(F.lds, F.wave, DM, LDX, LDX, S, E);
    }
    SEAM(9);
    if (IN(10)) REPS(10) {
        unsigned char* ws = KWS(); float* ssq = (float*)(ws + WS_CTL + CTL_SSQ); bf16* XB = (bf16*)(ws + WS_XB); bf16* MIX = (bf16*)(ws + WS_MIX); bf16* HMID = (bf16*)(ws + WS_PROJ); bf16* PROJ = HMID;
        float* X = KOUT(); const float* x_prompt = KIN(0); const float* x_sample = KIN(1);
        bf16* WOE = (bf16*)(ws + WS_WOE); bf16* WIO = (bf16*)(ws + WS_WIO); bf16* WOO = (bf16*)(ws + WS_WOO);
        bf16* WGU0 = (bf16*)(ws + WS_WGU0); bf16* WGU1 = (bf16*)(ws + WS_WGU1); bf16* WD0 = (bf16*)(ws + WS_WD0); bf16* WD1 = (bf16*)(ws + WS_WD1);
        (void)ssq; (void)XB; (void)MIX; (void)HMID; (void)PROJ; (void)X; (void)x_prompt; (void)x_sample; (void)WOE; (void)WIO; (void)WOO; (void)WGU0; (void)WGU1; (void)WD0; (void)WD1;
        gm::GridOrder S; S.init(NTOK, 2 * FF, F.G, (int)blockIdx.x, XB, (size_t)LDX * 2, WGU1, (size_t)LDX * 2, HMID, FF, 2);
        gm::EpiSwiglu E{ssq + 3 * NTOK, HMID};
        gm::gemm_phase(F.lds, F.wave, DM, LDX, LDX, S, E);
    }
    SEAM(10);
    if (IN(11)) REPS(11) {
        unsigned char* ws = KWS(); float* ssq = (float*)(ws + WS_CTL + CTL_SSQ); bf16* XB = (bf16*)(ws + WS_XB); bf16* MIX = (bf16*)(ws + WS_MIX); bf16* HMID = (bf16*)(ws + WS_PROJ); bf16* PROJ = HMID;
        float* X = KOUT(); const float* x_prompt = KIN(0); const float* x_sample = KIN(1);
        bf16* WOE = (bf16*)(ws + WS_WOE); bf16* WIO = (bf16*)(ws + WS_WIO); bf16* WOO = (bf16*)(ws + WS_WOO);
        bf16* WGU0 = (bf16*)(ws + WS_WGU0); bf16* WGU1 = (bf16*)(ws + WS_WGU1); bf16* WD0 = (bf16*)(ws + WS_WD0); bf16* WD1 = (bf16*)(ws + WS_WD1);
        (void)ssq; (void)XB; (void)MIX; (void)HMID; (void)PROJ; (void)X; (void)x_prompt; (void)x_sample; (void)WOE; (void)WIO; (void)WOO; (void)WGU0; (void)WGU1; (void)WD0; (void)WD1;
        gm::GridOrder S; S.init(NTOK, DM, F.G, (int)blockIdx.x, HMID, (size_t)FF * 2, WD1, (size_t)FF * 2, X, DM, 4); S.sh48 = (ORD48 & 1) != 0;
        gm::EpiResid E{x_prompt, x_sample, 0, X, XB, ssq + 4 * NTOK, 0}; E.red = (LAS float*)(F.lds + EX_OFF + 8192);
        gm::gemm_phase(F.lds, F.wave, FF, FF, FF, S, E);
    }
    SEAM(11);
    if (IN(12)) REPS(12) {
        float* X = KOUT(); const float* norm_final = KIN(18); float* ssq = (float*)(KWS() + WS_CTL + CTL_SSQ);
        const int gw = F.vcu * 8 + F.wave, NGW = F.G * 8, fl = lane_id_opaque();
        for (int m = gw; m < NTOK; m += NGW) {
            const float rs = __builtin_amdgcn_rsqf(ssq[4 * NTOK + m] * (1.0f / DM) + RMS_EPS);
            float* xr = X + (size_t)m * DM;
#pragma unroll 4
            for (int j = 0; j < 16; ++j) { const int cidx = j * 256 + fl * 4; const f32x4 v = *(const f32x4*)(xr + cidx); const f32x4 g = *(const f32x4*)(norm_final + cidx);
                *(f32x4*)(xr + cidx) = v * rs * g; }
        }
    }
#undef IN
#undef SEAM
}

extern "C" void kernel_launch(void* const* d_in, const int* in_sizes, int n_in, void* d_out, int out_size, void* d_ws, size_t ws_size, hipStream_t stream) {
    static int grid = 0;
    if (grid == 0) {
        if (n_in != 19 || out_size != NTOK * DM || ws_size < WS_END) { fprintf(stderr, "kernel_launch: unexpected shapes: n_in %d out %d ws %zu (need %zu)\n", n_in, out_size, ws_size, (size_t)WS_END); grid = -1; return; }
        int dev = 0, cus = 0, per_cu = 0;
        if (hipGetDevice(&dev) != hipSuccess || hipDeviceGetAttribute(&cus, hipDeviceAttributeMultiprocessorCount, dev) != hipSuccess) { grid = -1; return; }
        if (hipFuncSetAttribute((const void*)mega_fwd, hipFuncAttributeMaxDynamicSharedMemorySize, LDS_BYTES) != hipSuccess) { fprintf(stderr, "kernel_launch: hipFuncSetAttribute failed\n"); grid = -1; return; }
        if (hipOccupancyMaxActiveBlocksPerMultiprocessor(&per_cu, (const void*)mega_fwd, 512, LDS_BYTES) != hipSuccess || per_cu < 1)
            fprintf(stderr, "kernel_launch: occupancy query reports %d\n", per_cu);
        (void)hipGetLastError();
        grid = cus;
    }
    if (grid < 0) return;
    (void)hipMemsetAsync((char*)d_ws + WS_CTL, 0, CTL_ZERO_BYTES, stream);
    Args a{};
    for (int i = 0; i < 19; ++i) a.in[i] = (const float*)d_in[i];
    a.out = (float*)d_out; a.ws = (unsigned char*)d_ws;
    hipLaunchKernelGGL(mega_fwd, dim3(grid), dim3(512), LDS_BYTES, stream, a);
    const hipError_t le = hipPeekAtLastError();
    if (le != hipSuccess) fprintf(stderr, "kernel_launch: launch failed: %s\n", hipGetErrorName(le));
}
```

```cpp
#include <hip/hip_runtime.h>
#include <cstdio>
#include <cstdint>

#define GAS __attribute__((address_space(1)))
#define LAS __attribute__((address_space(3)))
typedef unsigned short bf16;
typedef short bf16x8 __attribute__((ext_vector_type(8)));
typedef short s16x4 __attribute__((ext_vector_type(4)));
typedef float f32x4 __attribute__((ext_vector_type(4)));
typedef float f32x16 __attribute__((ext_vector_type(16)));
typedef unsigned u32x4 __attribute__((ext_vector_type(4)));
typedef unsigned u32x2 __attribute__((ext_vector_type(2)));

constexpr int DM = 4096, NTOK = 24576, NTOK_P = 16384, FF = 11008;
constexpr int LDX = DM + 128;
constexpr int EVEN_IN = 8192, ODD_IN = 12288;
constexpr float RMS_EPS = 1e-6f, SUBLN_EPS = 1e-5f;
constexpr float LOG2E = 1.4426950408889634f;
constexpr float ATT_C = 0.088388347648318440f * LOG2E;
constexpr float LAM_INIT = 0.35550906759f;

constexpr size_t MiB = 1u << 20;
constexpr size_t WS_CTL = 0, CTL_ZERO_BYTES = 1 * MiB;
constexpr size_t WROW = (size_t)LDX * 2;
constexpr size_t WS_WIE = 2 * MiB, WS_WOE = WS_WIE + 8192 * WROW, WS_WIO = WS_WOE + 4096 * WROW, WS_WOO = WS_WIO + 12288 * WROW;
constexpr size_t WS_WGU0 = WS_WOO + 4096 * WROW, WS_WGU1 = WS_WGU0 + 22016 * WROW, WS_WD0 = WS_WGU1 + 22016 * WROW, WS_WD1 = WS_WD0 + 86 * MiB;
constexpr size_t WS_XB = WS_WD1 + 86 * MiB, WS_MIX = WS_XB + (size_t)NTOK * WROW, WS_PROJ = WS_MIX + (size_t)NTOK * WROW, WS_VT = WS_PROJ + 384 * MiB, WS_END = WS_PROJ + 576 * MiB;
static_assert(WS_END <= (size_t)1864 * MiB && WS_WGU0 % 256 == 0 && WS_XB % 256 == 0 && WS_PROJ % 256 == 0, "workspace map");
constexpr size_t DO_T8 = 0, DO_T2 = 128 * MiB, DO_FC = 136 * MiB, DO_PQ8 = 144 * MiB, DO_PQ2 = 208 * MiB;
#ifndef DFT_HERM
#define DFT_HERM 1
#endif
constexpr size_t DO_T8S = 240 * MiB, DO_P256 = 304 * MiB, DO_WS2 = 320 * MiB, DO_WSP = 321 * MiB;
constexpr int CW_BAR = 4096;
constexpr int CW_LAM = 64;
constexpr size_t CTL_SSQ = 65536;
static_assert(CTL_SSQ + 5 * (size_t)NTOK * 4 <= CTL_ZERO_BYTES, "ctl");

constexpr int RING_BYTES = 131072;
constexpr int EX_OFF = RING_BYTES, EX_MISC = EX_OFF, EX_WS = EX_OFF + 256, EX_TAB = EX_OFF + 2304;
constexpr int LDS_BYTES = 147456;

#define LDS_WAIT() asm volatile("s_waitcnt lgkmcnt(0)" ::: "memory")
#define VM_WAIT() asm volatile("s_waitcnt vmcnt(0)" ::: "memory")
#define SBAR() __builtin_amdgcn_sched_barrier(0)

__device__ __forceinline__ unsigned cvt_pk_bf16(float lo, float hi) { unsigned r; asm volatile("v_cvt_pk_bf16_f32 %0, %1, %2" : "=v"(r) : "v"(lo), "v"(hi)); return r; }

#define XB_TMO      128
#define XB_XCNT(j)  (256  + 64 * (j))
#define XB_XSUB(j)  (1280 + 64 * (j))
#define XB_XGEN(j)  (2304 + 64 * (j))
#define XB_TOP      3328
#define XB_TOPGEN   3392
#define XCD_BAR_WORDS 3456
#define XB_SPIN_CAP (1u << 20)
__device__ __forceinline__ unsigned xb_ld(unsigned* p)              { return __hip_atomic_load(p, __ATOMIC_RELAXED, __HIP_MEMORY_SCOPE_AGENT); }
__device__ __forceinline__ unsigned xb_add(unsigned* p, unsigned v) { return __hip_atomic_fetch_add(p, v, __ATOMIC_RELAXED, __HIP_MEMORY_SCOPE_AGENT); }
__device__ __forceinline__ unsigned xb_xcc_id() { return (unsigned)__builtin_amdgcn_s_getreg((3 << 11) | 20) & 0xFu; }
#define XB_SPIN(cond, bar) do { unsigned _sp = 0; while (cond) { __builtin_amdgcn_s_sleep(1); \
    if ((++_sp & 255u) == 0u) { if (xb_ld(&(bar)[XB_TMO])) break; if (_sp > XB_SPIN_CAP) { atomicAdd(&(bar)[XB_TMO], 1u); break; } } } } while (0)
struct XcdBarrier { unsigned* bar; unsigned x; volatile LAS unsigned* st; };
__device__ __forceinline__ XcdBarrier xcd_barrier_post(unsigned* bar, volatile LAS unsigned* st) {
    XcdBarrier b; b.bar = bar; b.x = xb_xcc_id(); b.st = st;
    if (threadIdx.x == 0) (void)xb_add(&bar[XB_XCNT(b.x)], 1u);
    return b;
}
__device__ __forceinline__ void xcd_barrier_complete(unsigned* bar, unsigned x, unsigned& nloc, unsigned& nx) {
    const unsigned G = gridDim.x * gridDim.y * gridDim.z;
    unsigned sum, cnt, mine, sp = 0u;
    for (;;) {
        sum = 0u; cnt = 0u; mine = 0u;
#pragma unroll
        for (unsigned j = 0; j < 16; ++j) { const unsigned c = xb_ld(&bar[XB_XCNT(j)]); sum += c; cnt += (c > 0u) ? 1u : 0u; mine = (j == x) ? c : mine; }
        if (sum == G) break;
        __builtin_amdgcn_s_sleep(1);
        if ((++sp & 255u) == 0u) { if (xb_ld(&bar[XB_TMO])) break; if (sp > XB_SPIN_CAP) { atomicAdd(&bar[XB_TMO], 1u); break; } }
    }
    nloc = mine > 0u ? mine : 1u; nx = cnt > 0u ? cnt : 1u;
}
__device__ __forceinline__ void xcd_barrier(const XcdBarrier& b) {
    asm volatile("s_waitcnt vmcnt(0)" ::: "memory");
    __syncthreads();
    if (threadIdx.x == 0) {
        unsigned* bar = b.bar;
        __builtin_amdgcn_s_waitcnt(0);
        unsigned nloc = b.st[0], nx = b.st[1];
        if (nloc == 0u) { xcd_barrier_complete(bar, b.x, nloc, nx); b.st[0] = nloc; b.st[1] = nx; }
        const unsigned old = xb_add(&bar[XB_XSUB(b.x)], 1u);
        const unsigned gen = old / nloc;
        if (old + 1u == (gen + 1u) * nloc) {
            __builtin_amdgcn_fence(__ATOMIC_RELEASE, "agent");
            asm volatile("s_waitcnt vmcnt(0)" ::: "memory");
            const unsigned og = xb_add(&bar[XB_TOP], 1u);
            const unsigned tg = og / nx;
            if (og + 1u == (tg + 1u) * nx) xb_add(&bar[XB_TOPGEN], 1u);
            else XB_SPIN(xb_ld(&bar[XB_TOPGEN]) == tg, bar);
            __builtin_amdgcn_fence(__ATOMIC_ACQUIRE, "agent");
            xb_add(&bar[XB_XGEN(b.x)], 1u);
            asm volatile("s_waitcnt vmcnt(0)" ::: "memory");
        } else {
            XB_SPIN(xb_ld(&bar[XB_XGEN(b.x)]) == gen, bar);
            __builtin_amdgcn_fence(__ATOMIC_ACQUIRE, "agent");
            asm volatile("s_waitcnt vmcnt(0)" ::: "memory");
        }
    }
    __syncthreads();
}

__device__ __forceinline__ int lane_id_opaque() { int l = (int)__builtin_amdgcn_mbcnt_hi(~0u, __builtin_amdgcn_mbcnt_lo(~0u, 0u)); asm volatile("" : "+v"(l)); return l & 63; }

__device__ __forceinline__ float dpp_f(float v, int ctrl_sel) {
    const int x = __float_as_int(v); int r;
    if (ctrl_sel == 0) r = __builtin_amdgcn_mov_dpp(x, 0xB1, 0xF, 0xF, true);
    else if (ctrl_sel == 1) r = __builtin_amdgcn_mov_dpp(x, 0x4E, 0xF, 0xF, true);
    else if (ctrl_sel == 2) r = __builtin_amdgcn_mov_dpp(x, 0x141, 0xF, 0xF, true);
    else r = __builtin_amdgcn_mov_dpp(x, 0x140, 0xF, 0xF, true);
    return __int_as_float(r);
}
__device__ __forceinline__ float sum_rows16(float v) {
    auto rr = __builtin_amdgcn_permlane16_swap(__float_as_uint(v), __float_as_uint(v), false, false); return __uint_as_float(rr[0]) + __uint_as_float(rr[1]);
}
__device__ __forceinline__ float sum_halves32(float v) {
    auto rr = __builtin_amdgcn_permlane32_swap(__float_as_uint(v), __float_as_uint(v), false, false); return __uint_as_float(rr[0]) + __uint_as_float(rr[1]);
}
__device__ __forceinline__ float sum_row16(float v) {
    v += dpp_f(v, 0); v += dpp_f(v, 1); v += dpp_f(v, 2); v += dpp_f(v, 3); return v;
}

namespace gm {
constexpr int BM = 256, BK = 64, HALF = 128, HTB = HALF * BK * 2, NXCD = 8, WGM = 8;
__host__ __device__ __forceinline__ int lds_byte(int r, int c) { const int st = (r >> 4) * 2 + (c >> 5), rr = r & 15, cc = c & 31, ob = rr * 64 + cc * 2; return st * 1024 + (ob ^ (((ob >> 9) & 1) << 5)); }
__host__ __device__ __forceinline__ void stage_rc(int b, int& R, int& C) { const int st = b / 1024, sb = b % 1024, swz = sb ^ (((sb >> 9) & 1) << 5); R = (st >> 1) * 16 + swz / 64; C = (st & 1) * 32 + (swz % 64) / 2; }
__host__ __device__ __forceinline__ int perm32(int rho) { const int n = rho >> 4, i = rho & 15; return 8 * (i >> 2) + 4 * n + (i & 3); }

struct Unit { const char* A; const char* B; char* C; int ldc; int row0; int col0; };

#ifndef ORD48
#define ORD48 3
#endif
struct GridOrder {
    int nM, nN, nwg, G, c; const char* A; const char* B; char* C; size_t atile, btile; int ldc, esz; bool sh48 = false;
    __device__ __forceinline__ void init(int M, int N, int G_, int c_, const void* A_, size_t lda_bytes, const void* B_, size_t ldb_bytes, void* C_, int ldc_, int esz_) {
        nM = M / BM; nN = N / BM; nwg = nM * nN; G = G_; c = c_; A = (const char*)A_; B = (const char*)B_; C = (char*)C_; atile = lda_bytes * BM; btile = ldb_bytes * BM; ldc = ldc_; esz = esz_; }
    __device__ __forceinline__ bool next(int i, Unit& u) const {
        int pm, pn;
        if (G == 256 && nM == 96 && (nN & 1) == 0) {
            const int x = c & 7, e = i * 32 + (c >> 3), nA = 8 * nN;
            if (sh48 && nN == 16) {
                const int q = e & 31, r = e >> 5; if (r >= 6) return false;
                if (r < 4) { pm = 8 * x + 4 * (r >> 1) + (q & 3); pn = 8 * (r & 1) + (q >> 2); }
                else { pm = 64 + 8 * (x >> 1) + 4 * (r - 4) + (q & 3); pn = 8 * (x & 1) + (q >> 2); }
            } else
            if (e < nA) { pn = e >> 3; pm = 8 * x + (e & 7); }
            else { const int e2 = e - nA; if (e2 >= 4 * nN) return false; pn = (nN >> 1) * (x & 1) + (e2 >> 3); pm = 64 + 8 * (x >> 1) + (e2 & 7); }
        } else {
        const long L = (long)i * G + c; if (L >= nwg) return false;
        int wgid = (int)L; { const int q = nwg / NXCD, r = nwg % NXCD, xcd = wgid % NXCD, off = wgid / NXCD; wgid = (xcd < r ? xcd * (q + 1) : r * (q + 1) + (xcd - r) * q) + off; }
        const int nig = WGM * nN, gid = wgid / nig, fm = gid * WGM, gsz = (nM - fm) < WGM ? (nM - fm) : WGM;
        pm = fm + ((wgid % nig) % gsz); pn = (wgid % nig) / gsz;
        }
        u.A = A + (size_t)pm * atile; u.B = B + (size_t)pn * btile; u.row0 = pm * BM; u.col0 = pn * BM; u.ldc = ldc;
        u.C = C + ((size_t)u.row0 * ldc + u.col0) * esz; return true;
    }
};

__device__ __forceinline__ void load_rstd8(float (&rs)[8], const float* ssq, int row0, int wr, int fr, float scale) {
    if (ssq) {
#pragma unroll
        for (int g = 0; g < 8; ++g) rs[g] = ssq[row0 + (g >> 2) * HALF + wr * 64 + (g & 3) * 16 + fr];
#pragma unroll
        for (int g = 0; g < 8; ++g) rs[g] = __builtin_amdgcn_rsqf(rs[g] * (1.0f / DM) + RMS_EPS) * scale;
    } else {
#pragma unroll
        for (int g = 0; g < 8; ++g) rs[g] = scale;
    }
}
struct EpiBf16 {
    static constexpr bool PERM = true;
    const float* ssq; float scale;
    __device__ __forceinline__ void operator()(const f32x4 (&acc)[2][2][4][2], const Unit& u, int wr, int wc, int fr, int fq) const {
        bf16* base = (bf16*)u.C + wc * 32 + 8 * fq;
        float rs[8]; load_rstd8(rs, ssq, u.row0, wr, fr, scale);
#pragma unroll
        for (int ai = 0; ai < 2; ++ai)
#pragma unroll
            for (int m = 0; m < 4; ++m) { int r = ai * HALF + wr * 64 + m * 16 + fr; asm volatile("" : "+v"(r));
                const float s = rs[ai * 4 + m];
                bf16* rowp = base + (size_t)r * u.ldc;
#pragma unroll
                for (int bj = 0; bj < 2; ++bj) { const f32x4 v0 = acc[ai][bj][m][0] * s, v1 = acc[ai][bj][m][1] * s;
                    u32x4 w; w.x = cvt_pk_bf16(v0[0], v0[1]); w.y = cvt_pk_bf16(v0[2], v0[3]); w.z = cvt_pk_bf16(v1[0], v1[1]); w.w = cvt_pk_bf16(v1[2], v1[3]);
                    *(u32x4*)(rowp + bj * HALF) = w; } }
    }
};
struct EpiSwiglu {
    static constexpr bool PERM = true;
    const float* ssq; bf16* H;
    __device__ __forceinline__ void operator()(const f32x4 (&acc)[2][2][4][2], const Unit& u, int wr, int wc, int fr, int fq) const {
        bf16* base = H + (size_t)u.row0 * FF + (u.col0 >> 1) + wc * 32 + 8 * fq;
        float rs[8]; load_rstd8(rs, ssq, u.row0, wr, fr, 1.0f);
#pragma unroll
        for (int ai = 0; ai < 2; ++ai)
#pragma unroll
            for (int m = 0; m < 4; ++m) { int r = ai * HALF + wr * 64 + m * 16 + fr; asm volatile("" : "+v"(r));
                const float s = rs[ai * 4 + m];
                float hv[8];
#pragma unroll
                for (int n = 0; n < 2; ++n)
#pragma unroll
                    for (int j = 0; j < 4; ++j) { const float g = acc[ai][0][m][n][j] * s, up = acc[ai][1][m][n][j] * s;
                        const float e = __builtin_amdgcn_exp2f(-g * LOG2E); hv[n * 4 + j] = g * __builtin_amdgcn_rcpf(1.0f + e) * up; }
                u32x4 w; w.x = cvt_pk_bf16(hv[0], hv[1]); w.y = cvt_pk_bf16(hv[2], hv[3]); w.z = cvt_pk_bf16(hv[4], hv[5]); w.w = cvt_pk_bf16(hv[6], hv[7]);
                *(u32x4*)(base + (size_t)r * FF) = w; }
    }
};
struct EpiResid {
    static constexpr bool PERM = false;
    const float* xp; const float* xs; int from_input;
    float* X; bf16* XB; float* ssq; int write_xb;
    __device__ __forceinline__ void operator()(const f32x4 (&acc)[2][2][4][2], const Unit& u, int wr, int wc, int fr, int fq) const {
        const float* rbase = from_input ? (u.row0 < NTOK_P ? xp + (size_t)u.row0 * DM : xs + (size_t)(u.row0 - NTOK_P) * DM) : X + (size_t)u.row0 * DM;
        const int c0 = u.col0 + wc * 32 + 4 * fq;
        f32x4 rv[4], rn[4];
        { int r = wr * 64 + fr; asm volatile("" : "+v"(r)); const unsigned off = (unsigned)r * DM + c0;
#pragma unroll
          for (int q = 0; q < 4; ++q) rv[q] = *(const f32x4*)(rbase + off + (q >> 1) * HALF + (q & 1) * 16); }
#pragma unroll
        for (int g = 0; g < 8; ++g) { const int ai = g >> 2, m = g & 3;
            if (g < 7) { int r2 = ((g + 1) >> 2) * HALF + wr * 64 + ((g + 1) & 3) * 16 + fr; asm volatile("" : "+v"(r2)); const unsigned off2 = (unsigned)r2 * DM + c0;
#pragma unroll
                for (int q = 0; q < 4; ++q) rn[q] = *(const f32x4*)(rbase + off2 + (q >> 1) * HALF + (q & 1) * 16); }
            int r = ai * HALF + wr * 64 + m * 16 + fr; asm volatile("" : "+v"(r));
            const unsigned off = (unsigned)r * DM + c0, offx = (unsigned)r * LDX + c0;
            float s = 0.f;
#pragma unroll
            for (int bj = 0; bj < 2; ++bj)
#pragma unroll
                for (int n = 0; n < 2; ++n) { const f32x4 v = rv[bj * 2 + n] + acc[ai][bj][m][n];
                    *(f32x4*)(X + (size_t)u.row0 * DM + off + bj * HALF + n * 16) = v;
                    s += (v[0] * v[0] + v[1] * v[1]) + (v[2] * v[2] + v[3] * v[3]);
                    if (write_xb) { u32x2 w; w.x = cvt_pk_bf16(v[0], v[1]); w.y = cvt_pk_bf16(v[2], v[3]); *(u32x2*)(XB + (size_t)u.row0 * LDX + offx + bj * HALF + n * 16) = w; } }
            s = sum_halves32(sum_rows16(s));
            if (fq == 0) unsafeAtomicAdd(ssq + u.row0 + r, s);
#pragma unroll
            for (int q = 0; q < 4; ++q) rv[q] = rn[q];
        }
    }
};

template <class Epi, class Sched>
__device__ __forceinline__ void gemm_phase(LAS unsigned char* lds, const int wave, const int K, const int lda, const int ldb, const Sched& S, const Epi& E) {
    const int lane = lane_id_opaque(), wid = wave, tid = wid * 64 + lane, wr = wid >> 2, wc = wid & 3, fr = lane & 15, fq = lane >> 4;
    const int nt = K / BK;
    unsigned voffA[2], voffB[2];
#pragma unroll
    for (int i = 0; i < 2; ++i) { int R, C; stage_rc(tid * 16 + i * 8192, R, C); const int Rb = Epi::PERM ? ((R & ~31) + perm32(R & 31)) : R;
        voffA[i] = (unsigned)(R * lda + C) * 2u; voffB[i] = (unsigned)(Rb * ldb + C) * 2u; }
    const size_t kstep = (size_t)(BK * 2);
    const size_t hstepA = (size_t)HALF * lda * 2, hstepB = (size_t)HALF * ldb * 2;
    const unsigned ldsw = (unsigned)wid * 1024u;
    const int aoff = lds_byte(wr * 64 + fr, fq * 8), boff = lds_byte(wc * 32 + fr, fq * 8);
#define PG8_SA(b, h) (((b) * 2 + (h)) * HTB)
#define PG8_SB(b, h) ((4 + (b) * 2 + (h)) * HTB)
#define PG8_STAGE(bufoff, gbase, voff) do { _Pragma("unroll") for (int _i = 0; _i < 2; ++_i) \
        __builtin_amdgcn_global_load_lds((const unsigned*)((const char*)(gbase) + (voff)[_i]), (LAS unsigned*)(lds + (bufoff) + ldsw + _i * 8192), 16, 0, 0); } while (0)
#define PG8_LDA(dst, b, h) do { _Pragma("unroll") for (int m = 0; m < 4; ++m) _Pragma("unroll") for (int k = 0; k < 2; ++k) dst[m][k] = *(const LAS bf16x8*)(lds + PG8_SA(b, h) + aoff + m * 2048 + k * 1024); } while (0)
#define PG8_LDB(dst, b, h) do { _Pragma("unroll") for (int n = 0; n < 2; ++n) _Pragma("unroll") for (int k = 0; k < 2; ++k) dst[n][k] = *(const LAS bf16x8*)(lds + PG8_SB(b, h) + boff + n * 2048 + k * 1024); } while (0)
#ifndef GEMM_PRIO
#define GEMM_PRIO 1
#endif
#define PG8_MMA(ai, bj, At, Bt) do { if (GEMM_PRIO) __builtin_amdgcn_s_setprio(GEMM_PRIO); _Pragma("unroll") for (int m = 0; m < 4; ++m) _Pragma("unroll") for (int n = 0; n < 2; ++n) _Pragma("unroll") for (int k = 0; k < 2; ++k) \
        acc[ai][bj][m][n] = __builtin_amdgcn_mfma_f32_16x16x32_bf16(Bt[n][k], At[m][k], acc[ai][bj][m][n], 0, 0, 0); if (GEMM_PRIO) __builtin_amdgcn_s_setprio(0); } while (0)
#define PG8_WAIT_V(n) asm volatile("s_waitcnt vmcnt(" #n ")" ::: "memory")
#define PG8_WAIT_L(n) asm volatile("s_waitcnt lgkmcnt(" #n ")" ::: "memory")
#define PG8_BAR __builtin_amdgcn_s_barrier()
#define PG8_SCHED __builtin_amdgcn_sched_barrier(0)
    Unit cur, nxt; int ui = 0;
    if (!S.next(0, cur)) return;
    f32x4 acc[2][2][4][2];
#pragma unroll
    for (int a = 0; a < 2; ++a)
#pragma unroll
        for (int b = 0; b < 2; ++b)
#pragma unroll
            for (int m = 0; m < 4; ++m)
#pragma unroll
                for (int n = 0; n < 2; ++n) acc[a][b][m][n] = (f32x4){0.f, 0.f, 0.f, 0.f};
    bf16x8 At[4][2], B0[2][2], B1[2][2];
    const char* cA = cur.A; const char* cB = cur.B;
#ifndef GEMM_SP2
#define GEMM_SP2 1
#endif
#if GEMM_SP2
    PG8_STAGE(PG8_SB(0, 0), cB, voffB); PG8_STAGE(PG8_SB(0, 1), cB + hstepB, voffB); PG8_STAGE(PG8_SA(0, 0), cA, voffA); PG8_STAGE(PG8_SA(0, 1), cA + hstepA, voffA);
    if (wr == 1) PG8_BAR;
    PG8_WAIT_V(2); PG8_BAR;
    PG8_STAGE(PG8_SB(1, 0), cB + kstep, voffB); PG8_STAGE(PG8_SA(1, 0), cA + kstep, voffA); PG8_STAGE(PG8_SB(1, 1), cB + hstepB + kstep, voffB);
    PG8_WAIT_V(6); PG8_BAR;
#else
    PG8_STAGE(PG8_SB(0, 0), cB, voffB); PG8_STAGE(PG8_SA(0, 0), cA, voffA); PG8_STAGE(PG8_SB(0, 1), cB + hstepB, voffB); PG8_STAGE(PG8_SA(0, 1), cA + hstepA, voffA);
    if (wr == 1) PG8_BAR;
    PG8_WAIT_V(4); PG8_BAR;
    PG8_STAGE(PG8_SB(1, 0), cB + kstep, voffB); PG8_STAGE(PG8_SA(1, 0), cA + kstep, voffA); PG8_STAGE(PG8_SB(1, 1), cB + hstepB + kstep, voffB);
    PG8_WAIT_V(6); PG8_BAR;
#endif
    for (;;) {
        const bool has_next = S.next(ui + 1, nxt);
        const char* nA = has_next ? nxt.A : cA; const char* nB = has_next ? nxt.B : cB;
        asm volatile(".p2align 7");
        for (int t = 0; t < nt; t += 2) {
            const bool last = (t == nt - 2);
            const char* a1 = cA + (size_t)(t + 1) * kstep;
            const char* a2 = last ? nA : cA + (size_t)(t + 2) * kstep; const char* b2 = last ? nB : cB + (size_t)(t + 2) * kstep;
            const char* a3 = a2 + kstep; const char* b3 = b2 + kstep;
#if GEMM_SP2
            PG8_LDB(B0, 0, 0); PG8_LDB(B1, 0, 1); PG8_SCHED; PG8_LDA(At, 0, 0); PG8_STAGE(PG8_SA(1, 1), a1 + hstepA, voffA);
            PG8_WAIT_V(8); PG8_WAIT_L(0); PG8_BAR; PG8_MMA(0, 0, At, B0); PG8_MMA(0, 1, At, B1); PG8_BAR; PG8_SCHED;
            PG8_LDA(At, 0, 1); PG8_STAGE(PG8_SB(0, 0), b2, voffB); PG8_STAGE(PG8_SB(0, 1), b2 + hstepB, voffB); PG8_STAGE(PG8_SA(0, 0), a2, voffA);
            PG8_WAIT_V(8); PG8_WAIT_L(0); PG8_BAR; PG8_MMA(1, 0, At, B0); PG8_MMA(1, 1, At, B1); PG8_BAR; PG8_SCHED;
            PG8_LDB(B0, 1, 0); PG8_LDB(B1, 1, 1); PG8_SCHED; PG8_LDA(At, 1, 0); PG8_STAGE(PG8_SA(0, 1), a2 + hstepA, voffA);
            PG8_WAIT_V(8); PG8_WAIT_L(0); PG8_BAR; PG8_MMA(0, 0, At, B0); PG8_MMA(0, 1, At, B1); PG8_BAR; PG8_SCHED;
            PG8_LDA(At, 1, 1); PG8_STAGE(PG8_SB(1, 0), b3, voffB); PG8_STAGE(PG8_SB(1, 1), b3 + hstepB, voffB); PG8_STAGE(PG8_SA(1, 0), a3, voffA);
            PG8_WAIT_V(8); PG8_WAIT_L(0); PG8_BAR; PG8_MMA(1, 0, At, B0); PG8_MMA(1, 1, At, B1); PG8_BAR; PG8_SCHED;
#else
            PG8_LDB(B0, 0, 0); PG8_SCHED; PG8_LDA(At, 0, 0); PG8_STAGE(PG8_SA(1, 1), a1 + hstepA, voffA);
            PG8_WAIT_L(8); PG8_BAR; PG8_WAIT_L(0); PG8_MMA(0, 0, At, B0); PG8_BAR; PG8_SCHED;
            PG8_LDB(B1, 0, 1); PG8_STAGE(PG8_SB(0, 0), b2, voffB);
            PG8_BAR; PG8_WAIT_L(0); PG8_MMA(0, 1, At, B1); PG8_BAR;
            PG8_LDA(At, 0, 1); PG8_STAGE(PG8_SA(0, 0), a2, voffA);
            PG8_BAR; PG8_WAIT_L(0); PG8_MMA(1, 0, At, B0); PG8_BAR; PG8_SCHED;
            PG8_STAGE(PG8_SB(0, 1), b2 + hstepB, voffB);
            PG8_WAIT_V(6); PG8_BAR; PG8_MMA(1, 1, At, B1); PG8_BAR;
            PG8_LDB(B0, 1, 0); PG8_SCHED; PG8_LDA(At, 1, 0); PG8_STAGE(PG8_SA(0, 1), a2 + hstepA, voffA);
            PG8_WAIT_L(8); PG8_BAR; PG8_WAIT_L(0); PG8_MMA(0, 0, At, B0); PG8_BAR; PG8_SCHED;
            PG8_LDB(B1, 1, 1); PG8_STAGE(PG8_SB(1, 0), b3, voffB);
            PG8_BAR; PG8_WAIT_L(0); PG8_MMA(0, 1, At, B1); PG8_BAR;
            PG8_LDA(At, 1, 1); PG8_STAGE(PG8_SA(1, 0), a3, voffA);
            PG8_BAR; PG8_WAIT_L(0); PG8_MMA(1, 0, At, B0); PG8_BAR; PG8_SCHED;
            PG8_STAGE(PG8_SB(1, 1), b3 + hstepB, voffB);
            PG8_WAIT_V(6); PG8_BAR; PG8_MMA(1, 1, At, B1); PG8_BAR;
#endif
        }
        if (wr == 0) PG8_BAR;
        E(acc, cur, wr, wc, fr, fq);
        if (!has_next) break;
#pragma unroll
        for (int a = 0; a < 2; ++a)
#pragma unroll
            for (int b = 0; b < 2; ++b)
#pragma unroll
                for (int m = 0; m < 4; ++m)
#pragma unroll
                    for (int n = 0; n < 2; ++n) acc[a][b][m][n] = (f32x4){0.f, 0.f, 0.f, 0.f};
        cur = nxt; cA = nA; cB = nB; ++ui;
        if (wr == 1) PG8_BAR;
    }
    PG8_WAIT_V(0);
    PG8_BAR;
#undef PG8_SA
#undef PG8_SB
#undef PG8_STAGE
#undef PG8_LDA
#undef PG8_LDB
#undef PG8_MMA
#undef PG8_WAIT_V
#undef PG8_WAIT_L
#undef PG8_BAR
#undef PG8_SCHED
}
}

struct Frame {
    LAS unsigned char* lds;
    int wave, vcu, G;
};
struct SeqInfo { int row0, S; };
__device__ __forceinline__ SeqInfo seq_info(int q) { SeqInfo s; if (q < 2) { s.row0 = q * 8192; s.S = 8192; } else { s.row0 = NTOK_P + (q - 2) * 2048; s.S = 2048; } return s; }

__device__ __forceinline__ float wave_sum(float v) {
#pragma unroll
    for (int o = 1; o < 64; o <<= 1) v += __shfl_xor(v, o);
    return v;
}

__device__ __forceinline__ void p0_load(f32x4 (&v)[8], float (&gs)[8], const float* W, int N, const float* g, int k0, int n0, int lane) {
    const int n4 = (lane & 7) * 4;
#pragma unroll
    for (int i = 0; i < 8; ++i) { const int kk = (lane >> 3) + 8 * i;
        v[i] = *(const f32x4*)(W + (size_t)(k0 + kk) * N + n0 + n4);
        gs[i] = g ? g[k0 + kk] : 1.0f; }
}
__device__ __forceinline__ void p0_store(const f32x4 (&vv)[8], const float (&gs)[8], bf16* WT, int ldw, int k0, int drow0, LAS float* scr, int lane) {
    const int n4 = (lane & 7) * 4;
#pragma unroll
    for (int i = 0; i < 8; ++i) { const int kk = (lane >> 3) + 8 * i; const f32x4 v = vv[i] * gs[i];
        scr[kk * 33 + n4 + 0] = v[0]; scr[kk * 33 + n4 + 1] = v[1]; scr[kk * 33 + n4 + 2] = v[2]; scr[kk * 33 + n4 + 3] = v[3]; }
    LDS_WAIT(); asm volatile("" ::: "memory");
    const int c = lane & 7;
#pragma unroll
    for (int j = 0; j < 4; ++j) { const int n = (lane >> 3) + 8 * j; const LAS float* s = scr + (8 * c) * 33 + n;
        u32x4 o; o.x = cvt_pk_bf16(s[0 * 33], s[1 * 33]); o.y = cvt_pk_bf16(s[2 * 33], s[3 * 33]); o.z = cvt_pk_bf16(s[4 * 33], s[5 * 33]); o.w = cvt_pk_bf16(s[6 * 33], s[7 * 33]);
        *(u32x4*)(WT + (size_t)(drow0 + n) * ldw + k0 + 8 * c) = o; }
    LDS_WAIT(); asm volatile("" ::: "memory");
}
struct WJob { const float* W; const float* g; bf16* WT; int K, N, mode; };

#define KSWZ(row, colB) ((row) * 256 + ((colB) ^ (((row) & 7) << 4)))
__device__ __forceinline__ int crow(int r, int hi) { return (r & 3) + 8 * (r >> 2) + 4 * hi; }
__device__ __forceinline__ int swap23(int k) { return (k & ~0xC) | ((k & 4) << 1) | ((k & 8) >> 1); }
__device__ __forceinline__ int v_rd_base(int lane) { return ((lane & 3) << 3) | (((lane >> 2) & 3) << 6) | (((lane >> 4) & 1) << 5) | (((lane >> 5) & 1) << 8); }
template <int OFF> __device__ __forceinline__ s16x4 tr_read(unsigned vb) {
    s16x4 r; asm volatile("ds_read_b64_tr_b16 %0, %1 offset:%2" : "=&v"(r) : "v"(vb), "i"(OFF) : "memory"); return r;
}
__device__ __forceinline__ void qkt(f32x16& p0, f32x16& p1, const LAS unsigned char* Ks, const bf16x8 (&qr)[8], int r32, int hi) {
    p0 = (f32x16){0.f, 0.f, 0.f, 0.f, 0.f, 0.f, 0.f, 0.f, 0.f, 0.f, 0.f, 0.f, 0.f, 0.f, 0.f, 0.f}; p1 = p0;
    const LAS unsigned char* k0p = Ks + r32 * 256; const LAS unsigned char* k1p = Ks + (32 + r32) * 256; const int sw = (r32 & 7) << 4;
    bf16x8 a0 = *(const LAS bf16x8*)(k0p + ((hi * 16) ^ sw)), a1 = *(const LAS bf16x8*)(k1p + ((hi * 16) ^ sw));
#pragma unroll
    for (int d0 = 0; d0 < 8; ++d0) {
        bf16x8 n0 = a0, n1 = a1;
        if (d0 < 7) { const int cb = ((d0 + 1) * 32 + hi * 16) ^ sw; n0 = *(const LAS bf16x8*)(k0p + cb); n1 = *(const LAS bf16x8*)(k1p + cb); }
        p0 = __builtin_amdgcn_mfma_f32_32x32x16_bf16(a0, qr[d0], p0, 0, 0, 0);
        p1 = __builtin_amdgcn_mfma_f32_32x32x16_bf16(a1, qr[d0], p1, 0, 0, 0);
        a0 = n0; a1 = n1;
        SBAR();
    }
}
template <int D0, int NCB> __device__ __forceinline__ void pv_one(f32x16& od, unsigned vb, bf16x8 pa0, bf16x8 pa1, bf16x8 pa2, bf16x8 pa3) {
#define VRO(ks, half) (D0 * 512 + (ks) * (NCB * 1024) + (half) * (NCB * 512))
    const s16x4 l0 = tr_read<VRO(0, 0)>(vb), h0 = tr_read<VRO(0, 1)>(vb), l1 = tr_read<VRO(1, 0)>(vb), h1 = tr_read<VRO(1, 1)>(vb);
    const s16x4 l2 = tr_read<VRO(2, 0)>(vb), h2 = tr_read<VRO(2, 1)>(vb), l3 = tr_read<VRO(3, 0)>(vb), h3 = tr_read<VRO(3, 1)>(vb);
#undef VRO
    asm volatile("s_waitcnt lgkmcnt(0)" ::: "memory"); SBAR();
#define PK(L, H) (bf16x8){L[0], L[1], L[2], L[3], H[0], H[1], H[2], H[3]}
    od = __builtin_amdgcn_mfma_f32_32x32x16_bf16(pa0, PK(l0, h0), od, 0, 0, 0);
    od = __builtin_amdgcn_mfma_f32_32x32x16_bf16(pa1, PK(l1, h1), od, 0, 0, 0);
    od = __builtin_amdgcn_mfma_f32_32x32x16_bf16(pa2, PK(l2, h2), od, 0, 0, 0);
    od = __builtin_amdgcn_mfma_f32_32x32x16_bf16(pa3, PK(l3, h3), od, 0, 0, 0);
#undef PK
}
__device__ __forceinline__ void softmax_tile(f32x16& p0, f32x16& p1, float& m_reg, float& l_reg, float& alpha, bf16x8& pa0, bf16x8& pa1, bf16x8& pa2, bf16x8& pa3) {
    float pmax = p0[0];
#pragma unroll
    for (int r = 1; r < 16; ++r) pmax = fmaxf(pmax, p0[r]);
#pragma unroll
    for (int r = 0; r < 16; ++r) pmax = fmaxf(pmax, p1[r]);
    { auto rr = __builtin_amdgcn_permlane32_swap(__float_as_uint(pmax), __float_as_uint(pmax), false, false);
      pmax = fmaxf(__uint_as_float(rr[0]), __uint_as_float(rr[1])); }
    if (__all(pmax - m_reg <= 6.0f)) { alpha = 1.0f; }
    else { const float mn_ = fmaxf(m_reg, pmax); alpha = __builtin_amdgcn_exp2f(m_reg - mn_); m_reg = mn_; }
    const float mn = m_reg;
#pragma unroll
    for (int r = 0; r < 16; ++r) p0[r] = __builtin_amdgcn_exp2f(p0[r] - mn);
#pragma unroll
    for (int r = 0; r < 16; ++r) p1[r] = __builtin_amdgcn_exp2f(p1[r] - mn);
    float ps = 0.f;
#pragma unroll
    for (int r = 0; r < 16; ++r) ps += p0[r];
#pragma unroll
    for (int r = 0; r < 16; ++r) ps += p1[r];
    { auto rr = __builtin_amdgcn_permlane32_swap(__float_as_uint(ps), __float_as_uint(ps), false, false);
      ps = __uint_as_float(rr[0]) + __uint_as_float(rr[1]); }
    l_reg = l_reg * alpha + ps;
#define PK4(P, BASE, OUT) do { unsigned a0 = cvt_pk_bf16(P[BASE + 0], P[BASE + 1]), a1 = cvt_pk_bf16(P[BASE + 2], P[BASE + 3]);   \
    unsigned b0 = cvt_pk_bf16(P[BASE + 4], P[BASE + 5]), b1 = cvt_pk_bf16(P[BASE + 6], P[BASE + 7]);                              \
    auto r0 = __builtin_amdgcn_permlane32_swap(a0, b0, false, false); auto r1 = __builtin_amdgcn_permlane32_swap(a1, b1, false, false); \
    u32x4 w = {r0[0], r1[0], r0[1], r1[1]}; OUT = *reinterpret_cast<bf16x8*>(&w); } while (0)
    PK4(p0, 0, pa0); PK4(p0, 8, pa1); PK4(p1, 0, pa2); PK4(p1, 8, pa3);
#undef PK4
}
constexpr float SM_THR = 6.0f;
__device__ __forceinline__ void softmax_far(f32x16& p0, f32x16& p1, const float b, float& m_reg, float& l_reg, float& alpha, bf16x8& pa0, bf16x8& pa1, bf16x8& pa2, bf16x8& pa3) {
    float pmax = p0[0];
#pragma unroll
    for (int r = 1; r < 16; ++r) pmax = fmaxf(pmax, p0[r]);
#pragma unroll
    for (int r = 0; r < 16; ++r) pmax = fmaxf(pmax, p1[r]);
    { auto rr = __builtin_amdgcn_permlane32_swap(__float_as_uint(pmax), __float_as_uint(pmax), false, false);
      pmax = fmaxf(__uint_as_float(rr[0]), __uint_as_float(rr[1])); }
    const float pm = fmaf(pmax, ATT_C, b);
    if (__all(pm - m_reg <= SM_THR)) { alpha = 1.0f; }
    else { const float mn = fmaxf(m_reg, pm); alpha = __builtin_amdgcn_exp2f(m_reg - mn); m_reg = mn; }
    const float c = b - m_reg;
#pragma unroll
    for (int r = 0; r < 16; ++r) p0[r] = __builtin_amdgcn_exp2f(fmaf(p0[r], ATT_C, c));
#pragma unroll
    for (int r = 0; r < 16; ++r) p1[r] = __builtin_amdgcn_exp2f(fmaf(p1[r], ATT_C, c));
    float ps = 0.f;
#pragma unroll
    for (int r = 0; r < 16; ++r) ps += p0[r];
#pragma unroll
    for (int r = 0; r < 16; ++r) ps += p1[r];
    { auto rr = __builtin_amdgcn_permlane32_swap(__float_as_uint(ps), __float_as_uint(ps), false, false);
      ps = __uint_as_float(rr[0]) + __uint_as_float(rr[1]); }
    l_reg = l_reg * alpha + ps;
#define PK4(P, BASE, OUT) do { unsigned a0 = cvt_pk_bf16(P[BASE + 0], P[BASE + 1]), a1 = cvt_pk_bf16(P[BASE + 2], P[BASE + 3]);   \
    unsigned b0 = cvt_pk_bf16(P[BASE + 4], P[BASE + 5]), b1 = cvt_pk_bf16(P[BASE + 6], P[BASE + 7]);                              \
    auto r0 = __builtin_amdgcn_permlane32_swap(a0, b0, false, false); auto r1 = __builtin_amdgcn_permlane32_swap(a1, b1, false, false); \
    u32x4 w = {r0[0], r1[0], r0[1], r1[1]}; OUT = *reinterpret_cast<bf16x8*>(&w); } while (0)
    PK4(p0, 0, pa0); PK4(p0, 8, pa1); PK4(p1, 0, pa2); PK4(p1, 8, pa3);
#undef PK4
}
#ifndef ATT_CPRIO
#define ATT_CPRIO 1
#endif
#ifndef ATT_SPRIO
#define ATT_SPRIO 0
#endif
__device__ __forceinline__ bf16x8 lds_rd128(unsigned a) { bf16x8 r; asm volatile("ds_read_b128 %0, %1" : "=&v"(r) : "v"(a) : "memory"); return r; }
__device__ __forceinline__ void qkt_h(f32x16& p, const LAS unsigned char* Ks32, const bf16x8 (&qr)[8], int r32, int hi) {
    p = (f32x16){0.f, 0.f, 0.f, 0.f, 0.f, 0.f, 0.f, 0.f, 0.f, 0.f, 0.f, 0.f, 0.f, 0.f, 0.f, 0.f};
    const unsigned kb = (unsigned)(uintptr_t)Ks32 + (unsigned)r32 * 256u; const unsigned sw = (unsigned)(r32 & 7) << 4, h16 = (unsigned)hi * 16u;
#define KA(d0) (kb + ((((unsigned)(d0)) * 32u + h16) ^ sw))
#define WTK(N, F) asm volatile("s_waitcnt lgkmcnt(" #N ")" : "+v"(F) :: "memory")
#define MMK(F, d0) p = __builtin_amdgcn_mfma_f32_32x32x16_bf16(F, qr[d0], p, 0, 0, 0)
    bf16x8 f0 = lds_rd128(KA(0)), f1 = lds_rd128(KA(1));
    if (ATT_CPRIO) __builtin_amdgcn_s_setprio(1);
    WTK(1, f0); MMK(f0, 0); f0 = lds_rd128(KA(2));
    WTK(1, f1); MMK(f1, 1); f1 = lds_rd128(KA(3));
    WTK(1, f0); MMK(f0, 2); f0 = lds_rd128(KA(4));
    WTK(1, f1); MMK(f1, 3); f1 = lds_rd128(KA(5));
    WTK(1, f0); MMK(f0, 4); f0 = lds_rd128(KA(6));
    WTK(1, f1); MMK(f1, 5); f1 = lds_rd128(KA(7));
    WTK(1, f0); MMK(f0, 6);
    WTK(0, f1); MMK(f1, 7);
    if (ATT_CPRIO) __builtin_amdgcn_s_setprio(0);
#undef KA
#undef WTK
#undef MMK
}
#define PK4H(P, BASE, OUT) do { unsigned a0_ = cvt_pk_bf16(P[BASE + 0], P[BASE + 1]), a1_ = cvt_pk_bf16(P[BASE + 2], P[BASE + 3]);   \
    unsigned b0_ = cvt_pk_bf16(P[BASE + 4], P[BASE + 5]), b1_ = cvt_pk_bf16(P[BASE + 6], P[BASE + 7]);                              \
    auto r0_ = __builtin_amdgcn_permlane32_swap(a0_, b0_, false, false); auto r1_ = __builtin_amdgcn_permlane32_swap(a1_, b1_, false, false); \
    u32x4 w_ = {r0_[0], r1_[0], r0_[1], r1_[1]}; OUT = *reinterpret_cast<bf16x8*>(&w_); } while (0)
__device__ __forceinline__ void sm_tail_h(f32x16& p, const float alpha, float& l_reg, bf16x8& pa0, bf16x8& pa1) {
#pragma unroll
    for (int r = 0; r < 16; ++r) p[r] = __builtin_amdgcn_exp2f(p[r]);
    float ps = 0.f;
#pragma unroll
    for (int r = 0; r < 16; ++r) ps += p[r];
    { auto rr = __builtin_amdgcn_permlane32_swap(__float_as_uint(ps), __float_as_uint(ps), false, false);
      ps = __uint_as_float(rr[0]) + __uint_as_float(rr[1]); }
    l_reg = l_reg * alpha + ps;
    PK4H(p, 0, pa0); PK4H(p, 8, pa1);
}
__device__ __forceinline__ float rowmax_h(const f32x16& p) {
    float pmax = p[0];
#pragma unroll
    for (int r = 1; r < 16; ++r) pmax = fmaxf(pmax, p[r]);
    auto rr = __builtin_amdgcn_permlane32_swap(__float_as_uint(pmax), __float_as_uint(pmax), false, false);
    return fmaxf(__uint_as_float(rr[0]), __uint_as_float(rr[1]));
}
__device__ __forceinline__ float sm_decide(const float pm, float& m_reg) {
    if (__all(pm - m_reg <= SM_THR)) return 1.0f;
    const float mn = fmaxf(m_reg, pm); const float alpha = __builtin_amdgcn_exp2f(m_reg - mn); m_reg = mn; return alpha;
}
__device__ __forceinline__ void softmax_far_h(f32x16& p, const float b, float& m_reg, float& l_reg, float& alpha, bf16x8& pa0, bf16x8& pa1) {
    const float pm = fmaf(rowmax_h(p), ATT_C, b);
    alpha = sm_decide(pm, m_reg);
    const float c = b - m_reg;
#pragma unroll
    for (int r = 0; r < 16; ++r) p[r] = fmaf(p[r], ATT_C, c);
    sm_tail_h(p, alpha, l_reg, pa0, pa1);
}
__device__ __forceinline__ void softmax_near_h(f32x16& p, float& m_reg, float& l_reg, float& alpha, bf16x8& pa0, bf16x8& pa1) {
    alpha = sm_decide(rowmax_h(p), m_reg);
#pragma unroll
    for (int r = 0; r < 16; ++r) p[r] = p[r] - m_reg;
    sm_tail_h(p, alpha, l_reg, pa0, pa1);
}
template <int D0, int NCB, int HF> __device__ __forceinline__ void pv_half(f32x16& od, unsigned vb, bf16x8 pa0, bf16x8 pa1) {
#define VRO(ks, half) (D0 * 512 + (ks) * (NCB * 1024) + (half) * (NCB * 512))
    const s16x4 l0 = tr_read<VRO(2 * HF, 0)>(vb), h0 = tr_read<VRO(2 * HF, 1)>(vb), l1 = tr_read<VRO(2 * HF + 1, 0)>(vb), h1 = tr_read<VRO(2 * HF + 1, 1)>(vb);
#undef VRO
    asm volatile("s_waitcnt lgkmcnt(0)" ::: "memory"); SBAR();
#define PK(L, H) (bf16x8){L[0], L[1], L[2], L[3], H[0], H[1], H[2], H[3]}
    od = __builtin_amdgcn_mfma_f32_32x32x16_bf16(pa0, PK(l0, h0), od, 0, 0, 0);
    od = __builtin_amdgcn_mfma_f32_32x32x16_bf16(pa1, PK(l1, h1), od, 0, 0, 0);
#undef PK
}
struct NoHook { __device__ __forceinline__ void operator()(int) const {} };
template <int HF, class Hook = NoHook> __device__ __forceinline__ void pv_half8(f32x16 (&o)[8], unsigned vb, bf16x8 pa0, bf16x8 pa1, const Hook& hook = Hook()) {
#define VRO(d0, ks, half) ((d0) * 512 + (ks) * (8 * 1024) + (half) * (8 * 512))
#define RD4(d0, A, B, C, D) do { A = tr_read<VRO(d0, 2 * HF, 0)>(vb); B = tr_read<VRO(d0, 2 * HF, 1)>(vb); C = tr_read<VRO(d0, 2 * HF + 1, 0)>(vb); D = tr_read<VRO(d0, 2 * HF + 1, 1)>(vb); } while (0)
#define PK(L, H) (bf16x8){L[0], L[1], L[2], L[3], H[0], H[1], H[2], H[3]}
#define MM(d0, A, B, C, D) do { o[d0] = __builtin_amdgcn_mfma_f32_32x32x16_bf16(pa0, PK(A, B), o[d0], 0, 0, 0); o[d0] = __builtin_amdgcn_mfma_f32_32x32x16_bf16(pa1, PK(C, D), o[d0], 0, 0, 0); } while (0)
#define WT4(A, B, C, D) asm volatile("s_waitcnt lgkmcnt(4)" : "+v"(A), "+v"(B), "+v"(C), "+v"(D) :: "memory")
#define WT0(A, B, C, D) asm volatile("s_waitcnt lgkmcnt(0)" : "+v"(A), "+v"(B), "+v"(C), "+v"(D) :: "memory")
    s16x4 a0, a1, a2, a3, b0, b1, b2, b3;
    RD4(0, a0, a1, a2, a3);
    if (ATT_CPRIO) __builtin_amdgcn_s_setprio(1);
    RD4(1, b0, b1, b2, b3); WT4(a0, a1, a2, a3); MM(0, a0, a1, a2, a3); hook(0);
    RD4(2, a0, a1, a2, a3); WT4(b0, b1, b2, b3); MM(1, b0, b1, b2, b3);
    RD4(3, b0, b1, b2, b3); WT4(a0, a1, a2, a3); MM(2, a0, a1, a2, a3); hook(1);
    RD4(4, a0, a1, a2, a3); WT4(b0, b1, b2, b3); MM(3, b0, b1, b2, b3);
    RD4(5, b0, b1, b2, b3); WT4(a0, a1, a2, a3); MM(4, a0, a1, a2, a3); hook(2);
    RD4(6, a0, a1, a2, a3); WT4(b0, b1, b2, b3); MM(5, b0, b1, b2, b3);
    RD4(7, b0, b1, b2, b3); WT4(a0, a1, a2, a3); MM(6, a0, a1, a2, a3); hook(3);
    WT0(b0, b1, b2, b3); MM(7, b0, b1, b2, b3);
    if (ATT_CPRIO) __builtin_amdgcn_s_setprio(0);
#undef VRO
#undef RD4
#undef PK
#undef MM
#undef WT4
#undef WT0
}
__device__ __forceinline__ void k_src(int b, int& row, int& col) { row = b >> 8; const int cb = (b & 255) ^ ((row & 7) << 4); col = cb >> 1; }
template <int NCB> __device__ __forceinline__ void v_src(int b, int& key, int& col) {
    const int st = b >> 9, e = (b & 511) >> 1; const int kk = (st / NCB) * 8 + (e >> 5); key = swap23(kk); col = (st % NCB) * 32 + (e & 31);
}
__device__ __forceinline__ void glds16(const void* g, LAS unsigned char* l) { __builtin_amdgcn_global_load_lds((const unsigned*)g, (LAS unsigned*)l, 16, 0, 0); }

__device__ __forceinline__ const void* karg_ptr(int off) {
    asm volatile("" : "+s"(off));
    const __attribute__((address_space(4))) char* ka = (const __attribute__((address_space(4))) char*)__builtin_amdgcn_kernarg_segment_ptr();
    return *(const void* const __attribute__((address_space(4)))*)(ka + off);
}
#define KIN(i) ((const float*)karg_ptr(8 * (i)))
#define KOUT() ((float*)karg_ptr(152))
#define KWS() ((unsigned char*)karg_ptr(160))

struct Args { const float* in[19]; float* out; unsigned char* ws; };

__global__ void __launch_bounds__(512, 2) mega_fwd(Args args) {
    extern __shared__ __attribute__((aligned(16))) unsigned char lds_raw[];
    Frame F; F.lds = (LAS unsigned char*)lds_raw;
    F.wave = __builtin_amdgcn_readfirstlane(threadIdx.x >> 6);
    F.G = gridDim.x; { const int bx = blockIdx.x; F.vcu = (F.G % 8 == 0) ? (bx % 8) * (F.G / 8) + bx / 8 : bx; }
    volatile LAS unsigned* MISC = (volatile LAS unsigned*)(F.lds + EX_MISC);
    if (threadIdx.x < 64) MISC[threadIdx.x] = 0u;
    __syncthreads();
    (void)xcd_barrier_post((unsigned*)KWS() + CW_BAR, MISC + 8);
#ifndef PH_MASK
#define PH_MASK 0x3FFF
#endif
#define IN(k) ((PH_MASK >> (k)) & 1)
#ifndef REP_PHASE
#define REP_PHASE -1
#endif
#define REPS(k) _Pragma("unroll 1") for (int rep_ = 0; rep_ < ((REP_PHASE) == (k) ? 2 : 1); ++rep_)
#define SEAMX(a_, b_) do { if (IN(a_) && IN(b_)) { XcdBarrier b_x; b_x.bar = (unsigned*)KWS() + CW_BAR; b_x.x = xb_xcc_id(); b_x.st = MISC + 8; xcd_barrier(b_x); } } while (0)
#define SEAM(k) do { if (IN(k) && IN((k) + 1)) { XcdBarrier b_; b_.bar = (unsigned*)KWS() + CW_BAR; b_.x = xb_xcc_id(); b_.st = MISC + 8; xcd_barrier(b_); } } while (0)
#define P_XPROMPT KIN(0)
#define P_XSAMPLE KIN(1)
#define P_SSQ ((float*)(KWS() + WS_CTL + CTL_SSQ))
#define P_X KOUT()
#define P_WS(off) ((bf16*)(KWS() + (off)))

    if (IN(0)) REPS(0) {
        const float* x_prompt = KIN(0); const float* x_sample = KIN(1); const float* norm_mix = KIN(2); const float* norm_ffn = KIN(3);
        const float* w_in_even = KIN(4); const float* w_out_even = KIN(6); const float* w_in_odd = KIN(7); const float* w_out_odd = KIN(13);
        const float* w_gate = KIN(15); const float* w_up = KIN(16); const float* w_down = KIN(17);
        unsigned char* ws = KWS(); float* ssq = (float*)(ws + WS_CTL + CTL_SSQ); unsigned* ctl = (unsigned*)ws;
        bf16* WIE = (bf16*)(ws + WS_WIE); bf16* WOE = (bf16*)(ws + WS_WOE); bf16* WIO = (bf16*)(ws + WS_WIO); bf16* WOO = (bf16*)(ws + WS_WOO);
        bf16* WGU0 = (bf16*)(ws + WS_WGU0); bf16* WGU1 = (bf16*)(ws + WS_WGU1); bf16* WD0 = (bf16*)(ws + WS_WD0); bf16* WD1 = (bf16*)(ws + WS_WD1);
        bf16* XB = (bf16*)(ws + WS_XB);
        unsigned char* outb = (unsigned char*)KOUT(); bf16* T8 = (bf16*)(outb + DO_T8); bf16* T2 = (bf16*)(outb + DO_T2); bf16* FC = (bf16*)(outb + DO_FC);
        const int p0lane = lane_id_opaque(), p0tid = F.wave * 64 + p0lane;
        LAS float* scr = (LAS float*)(F.lds + F.wave * 16384);
        const int gw = F.vcu * 8 + F.wave, NGW = F.G * 8;
        const size_t WFF = (size_t)DM * FF;
        {
            constexpr int I0 = 64 * 256, I1 = 64 * 128, I2 = 64 * 384, I3 = 64 * 128, IG = 64 * 344, ID = 172 * 128;
            constexpr int NITEMS = I0 + I1 + I2 + I3 + 4 * IG + 2 * ID;
#define P0_ISSUE(X, it_) do { int r = (it_); WJob j; \
                if (r < I0) j = WJob{w_in_even, norm_mix, WIE, DM, EVEN_IN, 0}; \
                else if ((r -= I0) < I1) j = WJob{w_out_even, nullptr, WOE, DM, DM, 0}; \
                else if ((r -= I1) < I2) j = WJob{w_in_odd, norm_mix + DM, WIO, DM, ODD_IN, 0}; \
                else if ((r -= I2) < I3) j = WJob{w_out_odd, nullptr, WOO, DM, DM, 0}; \
                else if ((r -= I3) < IG) j = WJob{w_gate, norm_ffn, WGU0, DM, FF, 1}; \
                else if ((r -= IG) < IG) j = WJob{w_up, norm_ffn, WGU0, DM, FF, 2}; \
                else if ((r -= IG) < IG) j = WJob{w_gate + WFF, norm_ffn + DM, WGU1, DM, FF, 1}; \
                else if ((r -= IG) < IG) j = WJob{w_up + WFF, norm_ffn + DM, WGU1, DM, FF, 2}; \
                else if ((r -= IG) < ID) j = WJob{w_down, nullptr, WD0, FF, DM, 0}; \
                else { r -= ID; j = WJob{w_down + WFF, nullptr, WD1, FF, DM, 0}; } \
                const int nblk = j.N / 32, kb = r / nblk, nb = r % nblk, n0 = nb * 32; \
                wt##X = j.WT; ldw##X = j.K == DM ? LDX : j.K; k0##X = kb * 64; dr##X = j.mode == 0 ? n0 : (256 * (n0 >> 7) + (n0 & 127) + (j.mode == 2 ? 128 : 0)); \
                p0_load(v##X, g##X, j.W, j.N, j.g, kb * 64, n0, p0lane); } while (0)
            f32x4 vA[8], vB[8]; float gA[8], gB[8]; bf16* wtA = nullptr; bf16* wtB = nullptr; int ldwA = 0, ldwB = 0, k0A = 0, k0B = 0, drA = 0, drB = 0;
            if (gw < NITEMS) P0_ISSUE(A, gw);
            for (int it = gw; it < NITEMS; it += 2 * NGW) {
                const bool hasB = it + NGW < NITEMS, hasA2 = it + 2 * NGW < NITEMS;
                if (hasB) P0_ISSUE(B, it + NGW);
                p0_store(vA, gA, wtA, ldwA, k0A, drA, scr, p0lane);
                if (hasA2) P0_ISSUE(A, it + 2 * NGW);
                if (hasB) p0_store(vB, gB, wtB, ldwB, k0B, drB, scr, p0lane);
            }
#undef P0_ISSUE
        }
        for (int m = gw; m < NTOK; m += NGW) {
            const float* xr = (m < NTOK_P ? x_prompt + (size_t)m * DM : x_sample + (size_t)(m - NTOK_P) * DM);
            float s = 0.f;
#pragma unroll 4
            for (int j = 0; j < 16; ++j) { const f32x4 v = *(const f32x4*)(xr + j * 256 + p0lane * 4);
                s += (v[0] * v[0] + v[1] * v[1]) + (v[2] * v[2] + v[3] * v[3]);
                u32x2 w; w.x = cvt_pk_bf16(v[0], v[1]); w.y = cvt_pk_bf16(v[2], v[3]); *(u32x2*)(XB + (size_t)m * LDX + j * 256 + p0lane * 4) = w; }
            s = wave_sum(s);
            if (p0lane == 0) ssq[m] = s;
        }
        {
            const long gt = (long)F.vcu * 512 + p0tid, NGT = (long)F.G * 512;
            constexpr long C8 = 2L * 4096 * 8192 / 8, C2 = 2L * 1024 * 2048 / 8, CF = 1024L * 512 / 8, CS = DFT_HERM ? 4L * 4096 * 2048 / 8 : 0;
            bf16* T8S = (bf16*)(outb + DO_T8S);
            for (long ch = gt; ch < C8 + C2 + CF + CS; ch += NGT) {
                bf16* dst; int k, j0, S; bool sn;
                if (ch >= C8 + C2 + CF) { const long c = ch - (C8 + C2 + CF); const int kc = (int)(c / (4096L * 256)); const long c1 = c % (4096L * 256); k = (int)(c1 / 256); const int jj = (int)(c1 % 256) * 8; j0 = kc * 2048 + jj; S = 8192; sn = false; dst = T8S + ((size_t)kc * 4096 + k) * 2048 + jj; } else
                if (ch < C8) { const int wh = (int)(ch / (4096L * 1024)); const long c = ch % (4096L * 1024); k = (int)(c / 1024); j0 = (int)(c % 1024) * 8; S = 8192; sn = wh != 0; dst = T8 + ((size_t)wh * 4096 + k) * 8192 + j0; }
                else if (ch < C8 + C2) { const long c0 = ch - C8; const int wh = (int)(c0 / (1024L * 256)); const long c = c0 % (1024L * 256); k = (int)(c / 256); j0 = (int)(c % 256) * 8; S = 2048; sn = wh != 0; dst = T2 + ((size_t)wh * 1024 + k) * 2048 + j0; }
                else { const long c = ch - C8 - C2; k = (int)(c / 64); j0 = (int)(c % 64) * 8; S = 512; sn = k >= 512; if (sn) k -= 512; dst = FC + (size_t)(sn ? k + 512 : k) * 512 + j0; }
                float v[8];
#pragma unroll
                for (int e = 0; e < 8; ++e) { const int r = (k * (j0 + e)) & (S - 1); const float fr = (float)r / (float)S;
                    v[e] = sn ? __builtin_amdgcn_sinf(fr) : __builtin_amdgcn_cosf(fr); }
                u32x4 w; w.x = cvt_pk_bf16(v[0], v[1]); w.y = cvt_pk_bf16(v[2], v[3]); w.z = cvt_pk_bf16(v[4], v[5]); w.w = cvt_pk_bf16(v[6], v[7]);
                *(u32x4*)dst = w;
            }
        }
        if (blockIdx.x == 0 && F.wave == 0) {
            float a = 0.f, b = 0.f;
            const float* lambda_q1 = KIN(8); const float* lambda_k1 = KIN(9); const float* lambda_q2 = KIN(10); const float* lambda_k2 = KIN(11);
            for (int i = p0lane; i < 128; i += 64) { a += lambda_q1[i] * lambda_k1[i]; b += lambda_q2[i] * lambda_k2[i]; }
            a = wave_sum(a); b = wave_sum(b);
            if (p0lane == 0) ((float*)ctl)[CW_LAM] = __expf(a) - __expf(b) + LAM_INIT;
        }
    }
    SEAM(0);

    if (IN(1)) REPS(1) {
        unsigned char* ws = KWS(); float* ssq = (float*)(ws + WS_CTL + CTL_SSQ); bf16* XB = (bf16*)(ws + WS_XB); bf16* WIE = (bf16*)(ws + WS_WIE); bf16* PROJ = (bf16*)(ws + WS_PROJ);
        gm::GridOrder S; S.init(NTOK, EVEN_IN, F.G, (int)blockIdx.x, XB, (size_t)LDX * 2, WIE, (size_t)LDX * 2, PROJ, EVEN_IN, 2);
        gm::EpiBf16 E{ssq, 1.0f};
        gm::gemm_phase(F.lds, F.wave, DM, LDX, LDX, S, E);
    }
    SEAM(1);

    if (IN(2)) REPS(2) {
        unsigned char* ws = KWS(); bf16* PROJ = (bf16*)(ws + WS_PROJ); bf16* VT = (bf16*)(ws + WS_VT); bf16* MIX = (bf16*)(ws + WS_MIX);
        bf16* FC = (bf16*)((unsigned char*)KOUT() + DO_FC); const float* rpb_na = KIN(5);
        {
            struct Sch { int G, c; const bf16* FC; const bf16* PROJ; bf16* VT;
                __device__ __forceinline__ bool next(int i, gm::Unit& u) const {
                    int q, g, pm, pn;
#if DFT_HERM
                    const int L = i * G + c; if (L >= 768) return false;
                    if (L < 512) { q = L >> 8; const int r = L & 255; g = r >> 6; pm = ((r >> 5) & 1) * 2; pn = r & 31; }
                    else { const int l2 = L - 512; q = 2 + (l2 >> 6); const int r = l2 & 63; g = r >> 4; pm = ((r >> 3) & 1) * 2; pn = r & 7; }
#else
                    const int L = i * G + c; if (L >= 1536) return false;
                    if (L < 1024) { q = L >> 9; const int r = L & 511; g = r >> 7; pm = (r >> 5) & 3; pn = r & 31; }
                    else { const int l2 = L - 1024; q = 2 + (l2 >> 7); const int r = l2 & 127; g = r >> 5; pm = (r >> 3) & 3; pn = r & 7; }
#endif
                    const SeqInfo si = seq_info(q);
                    u.A = (const char*)(FC + (size_t)pm * 256 * 512);
                    u.B = (const char*)(PROJ + (size_t)(si.row0 + pn * 256) * EVEN_IN + 6144 + g * 512);
                    u.ldc = 2 * si.S; u.row0 = 0; u.col0 = 0;
                    u.C = (char*)(VT + (size_t)4096 * si.row0 + (size_t)(g * 512 + (pm & 1) * 256) * (2 * si.S) + (size_t)(pm >> 1) * si.S + pn * 256);
                    return true; } };
            Sch S{F.G, (int)blockIdx.x, FC, PROJ, VT};
            gm::EpiBf16 E{nullptr, 1.0f};
            gm::gemm_phase(F.lds, F.wave, 512, 512, EVEN_IN, S, E);
        }
#if DFT_HERM
        {
            unsigned char* outb = (unsigned char*)KOUT(); bf16* WSP = (bf16*)(outb + DO_WSP); float* WS2 = (float*)(outb + DO_WS2);
            const int lane = lane_id_opaque(), gw = F.vcu * 8 + F.wave, NGW = F.G * 8;
            for (int tok = gw; tok < NTOK; tok += NGW) {
                const bf16* ur = PROJ + (size_t)tok * EVEN_IN + 6144 + lane * 8; float acc4[4];
#pragma unroll
                for (int g = 0; g < 4; ++g) { const u32x4 v = *(const u32x4*)(ur + g * 512); float a = 0.f;
#pragma unroll
                    for (int e = 0; e < 4; ++e) a += __uint_as_float(v[e] << 16) - __uint_as_float(v[e] & 0xffff0000u);
                    acc4[g] = wave_sum(a); }
                if (lane < 4) { const float wv = lane == 0 ? acc4[0] : lane == 1 ? acc4[1] : lane == 2 ? acc4[2] : acc4[3];
                    if (tok < NTOK_P) { const int q = tok >> 13, s_ = tok & 8191; WSP[((size_t)(q * 4 + (s_ >> 11)) * 256 + lane) * 4096 + (s_ & 2047)] = (bf16)(cvt_pk_bf16(wv, 0.f) & 0xffffu); }
                    else { const int t2 = tok - NTOK_P; WS2[((t2 >> 11) * 4 + lane) * 2048 + (t2 & 2047)] = wv; } }
            }
        }
#endif
        {
            const int w = F.wave, rsel = w >> 2, hh = (w >> 1) & 1, c0 = 32 * (w & 1);
            LAS float* tab = (LAS float*)(F.lds + EX_TAB);
            LAS float* wsl = (LAS float*)(F.lds + EX_WS) + w * 64;
            const int upw = 1536 / F.G;
            const bool chunked = upw * F.G == 1536;
            for (int U = chunked ? F.vcu * upw : F.vcu; U < (chunked ? (F.vcu + 1) * upw : 1536); U += chunked ? 1 : F.G) {
                int q, hp, rp;
                if (U < 1024) { q = U >> 9; const int t = U & 511; hp = t >> 6; rp = t & 63; } else { const int t2 = U - 1024; q = 2 + (t2 >> 7); const int t = t2 & 127; hp = t >> 4; rp = t & 15; }
                const SeqInfo si = seq_info(q); const int rows = si.S >> 6;
                const int lane = lane_id_opaque(), tid = w * 64 + lane, r32 = lane & 31, hi = lane >> 5;
                const int r0 = 2 * rp, r = r0 + rsel;
                int rs0 = r0 - 4; rs0 = rs0 < 0 ? 0 : (rs0 > rows - 8 ? rows - 8 : rs0);
                int rs1 = r0 - 3; rs1 = rs1 < 0 ? 0 : (rs1 > rows - 8 ? rows - 8 : rs1);
                const int rsw = rsel ? rs1 : rs0, nrow = rs1 + 8 - rs0;
                const int h = 2 * hp + hh;
                __syncthreads();
                for (int e = tid; e < 2 * 2 * 8 * 32; e += 512) { const int dc = e & 31, i = (e >> 5) & 7, hd = (e >> 8) & 1, rsl = e >> 9; const int dr = (rsl ? rs1 : rs0) + i - (r0 + rsl) + 7;
                    tab[e] = dc < 31 ? rpb_na[((size_t)(2 * hp + hd) * 15 + dr) * 31 + dc] * LOG2E : 0.f; }
                bf16x8 qr[8];
                { const bf16* Qw = PROJ + (size_t)(si.row0 + r * 64 + c0 + r32) * EVEN_IN + h * 128 + hi * 8;
#pragma unroll
                  for (int d0 = 0; d0 < 8; ++d0) qr[d0] = *(const bf16x8*)(Qw + d0 * 16); }
                float m_reg = -1e30f, l_reg = 0.f; f32x16 o[4];
#pragma unroll
                for (int d = 0; d < 4; ++d) o[d] = (f32x16){0.f, 0.f, 0.f, 0.f, 0.f, 0.f, 0.f, 0.f, 0.f, 0.f, 0.f, 0.f, 0.f, 0.f, 0.f, 0.f};
                const int c = c0 + r32; int cs = c - 8; cs = cs < 0 ? 0 : (cs > 48 ? 48 : cs);
                constexpr unsigned LDE = EVEN_IN * 2;
                unsigned offA, offB;
                if (w < 4) { offA = (unsigned)(lane >> 4) * LDE + (unsigned)(((lane & 15) ^ ((lane >> 4) & 7)) << 4); offB = (unsigned)(lane >> 4) * LDE + (unsigned)(((lane & 15) ^ ((4 + (lane >> 4)) & 7)) << 4); }
                else { const int t = (lane & 31) >> 2; offA = (unsigned)((t & 3) + 8 * (t >> 2)) * LDE + (unsigned)(32 * hi + 8 * (lane & 3)) * 2u; offB = offA; }
                const char* kvb = (const char*)(PROJ + (size_t)si.row0 * EVEN_IN + (w < 4 ? 2048 : 4096) + (2 * hp + ((w >> 1) & 1)) * 128);
#define NA_DMA(kr_, bs_) do { const char* tb_ = kvb + (size_t)((kr_) * 64) * LDE; LAS unsigned char* dst_ = F.lds + (bs_) * 65536 + (w >> 1) * 16384 + (w & 1) * 8192; \
                if (w < 4) { _Pragma("unroll") for (int j_ = 0; j_ < 8; ++j_) glds16(tb_ + (size_t)(4 * (8 * (w & 1) + j_)) * LDE + ((j_ & 1) ? offB : offA), dst_ + j_ * 1024); } \
                else { _Pragma("unroll") for (int j_ = 0; j_ < 8; ++j_) { const int pi_ = 8 * (w & 1) + j_; glds16(tb_ + (size_t)(4 * ((pi_ >> 1) & 1) + 16 * (pi_ >> 2)) * LDE + 128 * (pi_ & 1) + offA, dst_ + j_ * 1024); } } } while (0)
                NA_DMA(rs0, 0);
                for (int t = 0; t < nrow; ++t) {
                    asm volatile("s_waitcnt vmcnt(0) lgkmcnt(0)" ::: "memory"); __builtin_amdgcn_s_barrier(); asm volatile("" ::: "memory");
                    if (t + 1 < nrow) NA_DMA(rs0 + t + 1, (t + 1) & 1);
                    const int i = rs0 + t - rsw;
                    if (i >= 0 && i < 8) {
                        const LAS unsigned char* Kl = F.lds + (t & 1) * 65536 + hh * 16384; const unsigned vb = (unsigned)(uintptr_t)(F.lds + (t & 1) * 65536 + 32768 + hh * 16384) + v_rd_base(lane);
                        f32x16 p0, p1; LDS_WAIT(); qkt(p0, p1, Kl, qr, r32, hi);
                        const LAS float* tb = tab + ((rsel * 2 + hh) * 8 + i) * 32;
#pragma unroll
                        for (int rr = 0; rr < 16; ++rr) {
                            { const int kc = crow(rr, hi); const bool ok = (unsigned)(kc - cs) < 16u; const int dc = kc - c + 15; const float bv = tb[ok ? dc : 0];
                              p0[rr] = ok ? fmaf(p0[rr], ATT_C, bv) : -1e30f; }
                            { const int kc = 32 + crow(rr, hi); const bool ok = (unsigned)(kc - cs) < 16u; const int dc = kc - c + 15; const float bv = tb[ok ? dc : 0];
                              p1[rr] = ok ? fmaf(p1[rr], ATT_C, bv) : -1e30f; }
                        }
                        float alpha; bf16x8 pa0, pa1, pa2, pa3;
                        softmax_tile(p0, p1, m_reg, l_reg, alpha, pa0, pa1, pa2, pa3);
                        if (__any(alpha < 1.f)) {
                            if (hi == 0) wsl[r32] = alpha; LDS_WAIT();
#pragma unroll
                            for (int d = 0; d < 4; ++d)
#pragma unroll
                                for (int rr = 0; rr < 16; ++rr) o[d][rr] *= wsl[crow(rr, hi)];
                        }
                        pv_one<0, 4>(o[0], vb, pa0, pa1, pa2, pa3); pv_one<1, 4>(o[1], vb, pa0, pa1, pa2, pa3); pv_one<2, 4>(o[2], vb, pa0, pa1, pa2, pa3); pv_one<3, 4>(o[3], vb, pa0, pa1, pa2, pa3);
                    }
                }
#undef NA_DMA
                if (hi == 0) wsl[32 + r32] = l_reg; LDS_WAIT();
                __syncthreads();
                LAS unsigned short* img = (LAS unsigned short*)(F.lds + w * 8192);
#pragma unroll
                for (int rr = 0; rr < 16; ++rr) { const int orow = crow(rr, hi); const float rl = __builtin_amdgcn_rcpf(wsl[32 + orow]);
#pragma unroll
                    for (int d = 0; d < 4; ++d) img[orow * 128 + d * 32 + r32] = (unsigned short)(cvt_pk_bf16(o[d][rr] * rl, 0.f) & 0xffffu); }
                LDS_WAIT();
                bf16* Ob = MIX + (size_t)(si.row0 + r * 64 + c0) * LDX + h * 128;
#pragma unroll
                for (int i2 = 0; i2 < 8; ++i2) { const int row = 4 * i2 + (lane >> 4); const u32x4 v = *(const LAS u32x4*)(img + row * 128 + (lane & 15) * 8);
                    *(u32x4*)(Ob + (size_t)row * LDX + (lane & 15) * 8) = v; }
            }
            __syncthreads();
        }
    }
    SEAM(2);

#if DFT_HERM
    if (IN(3)) REPS(3) {
        unsigned char* ws = KWS(); bf16* VT = (bf16*)(ws + WS_VT);
        unsigned char* outb = (unsigned char*)KOUT(); bf16* T8 = (bf16*)(outb + DO_T8); bf16* T2 = (bf16*)(outb + DO_T2); bf16* PQ8 = (bf16*)(outb + DO_PQ8); bf16* PQ2 = (bf16*)(outb + DO_PQ2);
        bf16* T8S = (bf16*)(outb + DO_T8S); bf16* WSP = (bf16*)(outb + DO_WSP); bf16* P256 = (bf16*)(outb + DO_P256);
        {
            struct Sch { int G, c; const bf16* T8; const bf16* VT; bf16* PQ;
                __device__ __forceinline__ bool next(int i, gm::Unit& u) const {
                    int q, wh, pm, g;
                    if (G == 256) { if (i >= 1) return false; const int x = c & 7, j = c >> 3; q = x >> 2; wh = (x >> 1) & 1; pm = (x & 1) * 8 + (j >> 2); g = j & 3; }
                    else { const int L = i * G + c; if (L >= 256) return false; q = L >> 7; wh = (L >> 6) & 1; pm = (L >> 2) & 15; g = L & 3; }
                    u.A = (const char*)(T8 + ((size_t)wh * 4096 + pm * 256) * 8192); u.B = (const char*)(VT + (size_t)4096 * (q * 8192) + (size_t)(2 * g) * 256 * 16384 + wh * 8192);
                    u.ldc = 2048; u.row0 = 0; u.col0 = 0; u.C = (char*)(PQ + ((size_t)(q * 2 + wh) * 4096 + pm * 256) * 2048 + (2 * g) * 256); return true; } };
            Sch S{F.G, (int)blockIdx.x, T8, VT, PQ8};
            gm::EpiBf16 E{nullptr, 1.0f / 2048.0f};
            gm::gemm_phase(F.lds, F.wave, 8192, 8192, 16384, S, E);
        }
        {
            struct Sch { int G, c; const bf16* T2; const bf16* VT; bf16* PQ; const bf16* T8S; const bf16* WSP; bf16* P256;
                __device__ __forceinline__ bool next(int i, gm::Unit& u) const {
                    const int L = i * G + c; if (L >= 256) return false;
                    u.row0 = 0; u.col0 = 0;
                    if (L < 128) { const int q = L >> 5, wh = (L >> 4) & 1, pm = (L >> 2) & 3, g = L & 3; const int row0 = NTOK_P + q * 2048;
                        u.A = (const char*)(T2 + ((size_t)wh * 1024 + pm * 256) * 2048); u.B = (const char*)(VT + (size_t)4096 * row0 + (size_t)(2 * g) * 256 * 4096 + wh * 2048);
                        u.ldc = 2048; u.C = (char*)(PQ + ((size_t)(q * 2 + wh) * 1024 + pm * 256) * 2048 + (2 * g) * 256); }
                    else { const int l2 = L - 128, q = l2 >> 6, pm = (l2 >> 2) & 15, kc = l2 & 3;
                        u.A = (const char*)(T8S + ((size_t)kc * 4096 + pm * 256) * 2048); u.B = (const char*)(WSP + (size_t)(q * 4 + kc) * 256 * 4096);
                        u.ldc = 256; u.C = (char*)(P256 + ((size_t)(q * 4 + kc) * 4096 + pm * 256) * 256); }
                    return true; } };
            Sch S{F.G, (int)blockIdx.x, T2, VT, PQ2, T8S, WSP, P256};
            gm::EpiBf16 E{nullptr, 1.0f / 1024.0f};
            gm::gemm_phase(F.lds, F.wave, 2048, 2048, 4096, S, E);
        }
    }
    SEAMX(3, 13);
    if (IN(13)) REPS(13) {
        unsigned char* ws = KWS(); const bf16* VT = (const bf16*)(ws + WS_VT); bf16* MIX = (bf16*)(ws + WS_MIX);
        unsigned char* outb = (unsigned char*)KOUT(); const bf16* PQ8 = (const bf16*)(outb + DO_PQ8); const bf16* PQ2 = (const bf16*)(outb + DO_PQ2);
        const bf16* T2 = (const bf16*)(outb + DO_T2); const bf16* WSP = (const bf16*)(outb + DO_WSP); const bf16* P256 = (const bf16*)(outb + DO_P256); const float* WS2 = (const float*)(outb + DO_WS2);
        const int lane = lane_id_opaque(), gw = F.vcu * 8 + F.wave, NGW = F.G * 8;
        for (int it = gw; it < NTOK * 4; it += NGW) {
            const int tok = it >> 2, g = it & 3;
            int q, row; if (tok < NTOK_P) { q = tok >> 13; row = tok & 8191; } else { const int t2 = tok - NTOK_P; q = 2 + (t2 >> 11); row = t2 & 2047; }
            const SeqInfo si = seq_info(q); const int Sh = si.S >> 1;
            if (row == Sh) continue;
            const bool fk = row > Sh; const int kp = fk ? si.S - row : row;
            const bf16* Pp = (q < 2 ? PQ8 + (size_t)q * 2 * 4096 * 2048 : PQ2 + (size_t)(q - 2) * 2 * 1024 * 2048) + (size_t)kp * 2048 + g * 512;
            const bf16* Qp = Pp + (size_t)Sh * 2048;
            float sp;
            if (q < 2) { float a = 0.f;
#pragma unroll
                for (int kc = 0; kc < 4; ++kc) a += __uint_as_float((unsigned)P256[((size_t)(q * 4 + kc) * 4096 + kp) * 256 + g] << 16);
                sp = 0.5f * a; }
            else { const bf16* tr = T2 + (size_t)kp * 2048 + lane * 32; const float* wr_ = WS2 + ((q - 2) * 4 + g) * 2048 + lane * 32; float a = 0.f;
#pragma unroll
                for (int e = 0; e < 4; ++e) { const u32x4 tv = *(const u32x4*)(tr + e * 8); const f32x4 w0 = *(const f32x4*)(wr_ + e * 8), w1 = *(const f32x4*)(wr_ + e * 8 + 4);
                    a += __uint_as_float(tv[0] << 16) * w0[0] + __uint_as_float(tv[0] & 0xffff0000u) * w0[1] + __uint_as_float(tv[1] << 16) * w0[2] + __uint_as_float(tv[1] & 0xffff0000u) * w0[3]
                       + __uint_as_float(tv[2] << 16) * w1[0] + __uint_as_float(tv[2] & 0xffff0000u) * w1[1] + __uint_as_float(tv[3] << 16) * w1[2] + __uint_as_float(tv[3] & 0xffff0000u) * w1[3]; }
                sp = wave_sum(a) * (1.0f / 1024.0f); }
            const int l0 = lane * 8; float pv[8], qv[8];
            if (lane < 32) { const u32x4 a = *(const u32x4*)(Pp + l0), b = *(const u32x4*)(Qp + l0);
#pragma unroll
                for (int e = 0; e < 4; ++e) { pv[2 * e] = __uint_as_float(a[e] << 16); pv[2 * e + 1] = __uint_as_float(a[e] & 0xffff0000u); qv[2 * e] = __uint_as_float(b[e] << 16); qv[2 * e + 1] = __uint_as_float(b[e] & 0xffff0000u); } }
            else {
                const u32x4 a = *(const u32x4*)(Pp + 504 - l0), b = *(const u32x4*)(Qp + 504 - l0); float ta[8], tb[8];
#pragma unroll
                for (int e = 0; e < 4; ++e) { ta[2 * e] = __uint_as_float(a[e] << 16); ta[2 * e + 1] = __uint_as_float(a[e] & 0xffff0000u); tb[2 * e] = __uint_as_float(b[e] << 16); tb[2 * e + 1] = __uint_as_float(b[e] & 0xffff0000u); }
#pragma unroll
                for (int j = 1; j < 8; ++j) { pv[j] = ta[8 - j]; qv[j] = -tb[8 - j]; }
                if (lane == 32) { pv[0] = sp; qv[0] = 0.f; }
                else { pv[0] = __uint_as_float((unsigned)Pp[512 - l0] << 16); qv[0] = -__uint_as_float((unsigned)Qp[512 - l0] << 16); } }
            float o8[8];
#pragma unroll
            for (int j = 0; j < 8; ++j) o8[j] = fk ? pv[j] + qv[j] : pv[j] - qv[j];
            u32x4 w; w.x = cvt_pk_bf16(o8[0], o8[1]); w.y = cvt_pk_bf16(o8[2], o8[3]); w.z = cvt_pk_bf16(o8[4], o8[5]); w.w = cvt_pk_bf16(o8[6], o8[7]);
            *(u32x4*)(MIX + (size_t)tok * LDX + 2048 + g * 512 + l0) = w;
        }
        for (int it = gw; it < 6 * 4 * 257; it += NGW) {
            const int q = it / (4 * 257), r = it % (4 * 257), g = r / 257, lp = r % 257; const SeqInfo si = seq_info(q);
            float acc = 0.f;
            if (lp < 256) { const bf16* vr = VT + (size_t)4096 * si.row0 + (size_t)(g * 512 + lp) * (2 * si.S);
                for (int s0 = lane * 8; s0 < si.S; s0 += 512) { const u32x4 v = *(const u32x4*)(vr + s0);
#pragma unroll
                    for (int e = 0; e < 4; ++e) acc += __uint_as_float(v[e] << 16) - __uint_as_float(v[e] & 0xffff0000u); } }
            else if (q < 2) { for (int s0 = lane * 8; s0 < 8192; s0 += 512) { const u32x4 v = *(const u32x4*)(WSP + ((size_t)(q * 4 + (s0 >> 11)) * 256 + g) * 4096 + (s0 & 2047));
#pragma unroll
                    for (int e = 0; e < 4; ++e) acc += __uint_as_float(v[e] << 16) - __uint_as_float(v[e] & 0xffff0000u); } }
            else { const float* wr_ = WS2 + ((q - 2) * 4 + g) * 2048; for (int s0 = lane * 4; s0 < 2048; s0 += 256) { const f32x4 v = *(const f32x4*)(wr_ + s0); acc += (v[0] - v[1]) + (v[2] - v[3]); } }
            acc = wave_sum(acc) * (si.S == 8192 ? 1.0f / 2048.0f : 1.0f / 1024.0f);
            if (lane == 0) { bf16* orow = MIX + (size_t)(si.row0 + (si.S >> 1)) * LDX + 2048 + g * 512; const bf16 hv = (bf16)(cvt_pk_bf16(acc, 0.f) & 0xffffu);
                orow[lp] = hv; if (lp > 0 && lp < 256) orow[512 - lp] = hv; }
        }
    }
#else
    if (IN(3)) REPS(3) {
        unsigned char* ws = KWS(); bf16* VT = (bf16*)(ws + WS_VT);
        unsigned char* outb = (unsigned char*)KOUT(); bf16* T8 = (bf16*)(outb + DO_T8); bf16* T2 = (bf16*)(outb + DO_T2); bf16* PQ8 = (bf16*)(outb + DO_PQ8); bf16* PQ2 = (bf16*)(outb + DO_PQ2);
        {
            struct Sch { int G, c; const bf16* T8; const bf16* VT; bf16* PQ;
                __device__ __forceinline__ bool next(int i, gm::Unit& u) const {
                    int q, wh, pm, pn;
                    if (G == 256) { if (i >= 2) return false; const int xcd = c & 7, j = c >> 3; q = i; wh = xcd >> 2; pm = (xcd & 3) * 4 + (j >> 3); pn = j & 7; }
                    else { const int L = i * G + c; if (L >= 512) return false; q = L >> 8; wh = (L >> 7) & 1; pm = (L >> 3) & 15; pn = L & 7; }
                    u.A = (const char*)(T8 + ((size_t)wh * 4096 + pm * 256) * 8192); u.B = (const char*)(VT + (size_t)4096 * (q * 8192) + (size_t)pn * 256 * 16384 + wh * 8192);
                    u.ldc = 2048; u.row0 = 0; u.col0 = 0; u.C = (char*)(PQ + ((size_t)(q * 2 + wh) * 4096 + pm * 256) * 2048 + pn * 256); return true; } };
            Sch S{F.G, (int)blockIdx.x, T8, VT, PQ8};
            gm::EpiBf16 E{nullptr, 1.0f / 2048.0f};
            gm::gemm_phase(F.lds, F.wave, 8192, 8192, 16384, S, E);
        }
        {
            struct Sch { int G, c; const bf16* T2; const bf16* VT; bf16* PQ;
                __device__ __forceinline__ bool next(int i, gm::Unit& u) const {
                    int q, wh, pm, pn;
                    if (G == 256) { if (i >= 1) return false; const int xcd = c & 7, j = c >> 3; q = xcd >> 1; wh = xcd & 1; pm = j >> 3; pn = j & 7; }
                    else { const int L = i * G + c; if (L >= 256) return false; q = L >> 6; wh = (L >> 5) & 1; pm = (L >> 3) & 3; pn = L & 7; }
                    const int row0 = NTOK_P + q * 2048;
                    u.A = (const char*)(T2 + ((size_t)wh * 1024 + pm * 256) * 2048); u.B = (const char*)(VT + (size_t)4096 * row0 + (size_t)pn * 256 * 4096 + wh * 2048);
                    u.ldc = 2048; u.row0 = 0; u.col0 = 0; u.C = (char*)(PQ + ((size_t)(q * 2 + wh) * 1024 + pm * 256) * 2048 + pn * 256); return true; } };
            Sch S{F.G, (int)blockIdx.x, T2, VT, PQ2};
            gm::EpiBf16 E{nullptr, 1.0f / 1024.0f};
            gm::gemm_phase(F.lds, F.wave, 2048, 2048, 4096, S, E);
        }
    }
    SEAMX(3, 13);
    if (IN(13)) REPS(13) {
        unsigned char* ws = KWS(); const bf16* VT = (const bf16*)(ws + WS_VT); bf16* MIX = (bf16*)(ws + WS_MIX);
        unsigned char* outb = (unsigned char*)KOUT(); const bf16* PQ8 = (const bf16*)(outb + DO_PQ8); const bf16* PQ2 = (const bf16*)(outb + DO_PQ2);
        const int lane = lane_id_opaque(), gw = F.vcu * 8 + F.wave, NGW = F.G * 8;
        for (int it = gw; it < 2 * 4096 * 4 + 4 * 1024 * 4; it += NGW) {
            int q, k, qt, Sh; const bf16* PQ;
            if (it < 32768) { q = it >> 14; k = (it >> 2) & 4095; qt = it & 3; Sh = 4096; PQ = PQ8 + (size_t)q * 2 * 4096 * 2048; }
            else { const int i2 = it - 32768; q = i2 >> 12; k = (i2 >> 2) & 1023; qt = i2 & 3; Sh = 1024; PQ = PQ2 + (size_t)q * 2 * 1024 * 2048; q += 2; }
            const SeqInfo si = seq_info(q); const int col = qt * 512 + lane * 8;
            const u32x4 pv = *(const u32x4*)(PQ + (size_t)k * 2048 + col), qv = *(const u32x4*)(PQ + ((size_t)Sh + k) * 2048 + col);
            u32x4 d, a;
#pragma unroll
            for (int e = 0; e < 4; ++e) { const float p0 = __uint_as_float(pv[e] << 16), p1 = __uint_as_float(pv[e] & 0xffff0000u), q0 = __uint_as_float(qv[e] << 16), q1 = __uint_as_float(qv[e] & 0xffff0000u);
                d[e] = cvt_pk_bf16(p0 - q0, p1 - q1); a[e] = cvt_pk_bf16(p0 + q0, p1 + q1); }
            *(u32x4*)(MIX + (size_t)(si.row0 + k) * LDX + 2048 + col) = d;
            if (k) *(u32x4*)(MIX + (size_t)(si.row0 + si.S - k) * LDX + 2048 + col) = a;
        }
        for (int it = gw; it < 6 * 2048; it += NGW) {
            const int q = it >> 11, c = it & 2047; const SeqInfo si = seq_info(q);
            const bf16* vr = VT + (size_t)4096 * si.row0 + (size_t)c * (2 * si.S);
            float acc = 0.f;
            for (int s0 = lane * 8; s0 < si.S; s0 += 512) { const u32x4 v = *(const u32x4*)(vr + s0);
#pragma unroll
                for (int e = 0; e < 4; ++e) acc += __uint_as_float(v[e] << 16) - __uint_as_float(v[e] & 0xffff0000u); }
            acc = wave_sum(acc) * (si.S == 8192 ? 1.0f / 2048.0f : 1.0f / 1024.0f);
            if (lane == 0) MIX[(size_t)(si.row0 + (si.S >> 1)) * LDX + 2048 + c] = (bf16)(cvt_pk_bf16(acc, 0.f) & 0xffffu);
        }
    }
#endif
    SEAMX(13, 4);

    if (IN(4)) REPS(4) {
        unsigned char* ws = KWS(); float* ssq = (float*)(ws + WS_CTL + CTL_SSQ); bf16* XB = (bf16*)(ws + WS_XB); bf16* MIX = (bf16*)(ws + WS_MIX); bf16* HMID = (bf16*)(ws + WS_PROJ); bf16* PROJ = HMID;
        float* X = KOUT(); const float* x_prompt = KIN(0); const float* x_sample = KIN(1);
        bf16* WOE = (bf16*)(ws + WS_WOE); bf16* WIO = (bf16*)(ws + WS_WIO); bf16* WOO = (bf16*)(ws + WS_WOO);
        bf16* WGU0 = (bf16*)(ws + WS_WGU0); bf16* WGU1 = (bf16*)(ws + WS_WGU1); bf16* WD0 = (bf16*)(ws + WS_WD0); bf16* WD1 = (bf16*)(ws + WS_WD1);
        (void)ssq; (void)XB; (void)MIX; (void)HMID; (void)PROJ; (void)X; (void)x_prompt; (void)x_sample; (void)WOE; (void)WIO; (void)WOO; (void)WGU0; (void)WGU1; (void)WD0; (void)WD1;
        gm::GridOrder S; S.init(NTOK, DM, F.G, (int)blockIdx.x, MIX, (size_t)LDX * 2, WOE, (size_t)LDX * 2, X, DM, 4); S.sh48 = (ORD48 & 2) != 0;
        gm::EpiResid E{x_prompt, x_sample, 1, X, XB, ssq + NTOK, 1};
        gm::gemm_phase(F.lds, F.wave, DM, LDX, LDX, S, E);
    }
    SEAM(4);
    if (IN(5)) REPS(5) {
        unsigned char* ws = KWS(); float* ssq = (float*)(ws + WS_CTL + CTL_SSQ); bf16* XB = (bf16*)(ws + WS_XB); bf16* MIX = (bf16*)(ws + WS_MIX); bf16* HMID = (bf16*)(ws + WS_PROJ); bf16* PROJ = HMID;
        float* X = KOUT(); const float* x_prompt = KIN(0); const float* x_sample = KIN(1);
        bf16* WOE = (bf16*)(ws + WS_WOE); bf16* WIO = (bf16*)(ws + WS_WIO); bf16* WOO = (bf16*)(ws + WS_WOO);
        bf16* WGU0 = (bf16*)(ws + WS_WGU0); bf16* WGU1 = (bf16*)(ws + WS_WGU1); bf16* WD0 = (bf16*)(ws + WS_WD0); bf16* WD1 = (bf16*)(ws + WS_WD1);
        (void)ssq; (void)XB; (void)MIX; (void)HMID; (void)PROJ; (void)X; (void)x_prompt; (void)x_sample; (void)WOE; (void)WIO; (void)WOO; (void)WGU0; (void)WGU1; (void)WD0; (void)WD1;
        gm::GridOrder S; S.init(NTOK, 2 * FF, F.G, (int)blockIdx.x, XB, (size_t)LDX * 2, WGU0, (size_t)LDX * 2, HMID, FF, 2);
        gm::EpiSwiglu E{ssq + NTOK, HMID};
        gm::gemm_phase(F.lds, F.wave, DM, LDX, LDX, S, E);
    }
    SEAM(5);
    if (IN(6)) REPS(6) {
        unsigned char* ws = KWS(); float* ssq = (float*)(ws + WS_CTL + CTL_SSQ); bf16* XB = (bf16*)(ws + WS_XB); bf16* MIX = (bf16*)(ws + WS_MIX); bf16* HMID = (bf16*)(ws + WS_PROJ); bf16* PROJ = HMID;
        float* X = KOUT(); const float* x_prompt = KIN(0); const float* x_sample = KIN(1);
        bf16* WOE = (bf16*)(ws + WS_WOE); bf16* WIO = (bf16*)(ws + WS_WIO); bf16* WOO = (bf16*)(ws + WS_WOO);
        bf16* WGU0 = (bf16*)(ws + WS_WGU0); bf16* WGU1 = (bf16*)(ws + WS_WGU1); bf16* WD0 = (bf16*)(ws + WS_WD0); bf16* WD1 = (bf16*)(ws + WS_WD1);
        (void)ssq; (void)XB; (void)MIX; (void)HMID; (void)PROJ; (void)X; (void)x_prompt; (void)x_sample; (void)WOE; (void)WIO; (void)WOO; (void)WGU0; (void)WGU1; (void)WD0; (void)WD1;
        gm::GridOrder S; S.init(NTOK, DM, F.G, (int)blockIdx.x, HMID, (size_t)FF * 2, WD0, (size_t)FF * 2, X, DM, 4); S.sh48 = (ORD48 & 1) != 0;
        gm::EpiResid E{x_prompt, x_sample, 0, X, XB, ssq + 2 * NTOK, 1};
        gm::gemm_phase(F.lds, F.wave, FF, FF, FF, S, E);
    }
    SEAM(6);
    if (IN(7)) REPS(7) {
        unsigned char* ws = KWS(); float* ssq = (float*)(ws + WS_CTL + CTL_SSQ); bf16* XB = (bf16*)(ws + WS_XB); bf16* MIX = (bf16*)(ws + WS_MIX); bf16* HMID = (bf16*)(ws + WS_PROJ); bf16* PROJ = HMID;
        float* X = KOUT(); const float* x_prompt = KIN(0); const float* x_sample = KIN(1);
        bf16* WOE = (bf16*)(ws + WS_WOE); bf16* WIO = (bf16*)(ws + WS_WIO); bf16* WOO = (bf16*)(ws + WS_WOO);
        bf16* WGU0 = (bf16*)(ws + WS_WGU0); bf16* WGU1 = (bf16*)(ws + WS_WGU1); bf16* WD0 = (bf16*)(ws + WS_WD0); bf16* WD1 = (bf16*)(ws + WS_WD1);
        (void)ssq; (void)XB; (void)MIX; (void)HMID; (void)PROJ; (void)X; (void)x_prompt; (void)x_sample; (void)WOE; (void)WIO; (void)WOO; (void)WGU0; (void)WGU1; (void)WD0; (void)WD1;
        gm::GridOrder S; S.init(NTOK, ODD_IN, F.G, (int)blockIdx.x, XB, (size_t)LDX * 2, WIO, (size_t)LDX * 2, PROJ, ODD_IN, 2);
        gm::EpiBf16 E{ssq + 2 * NTOK, 1.0f};
        gm::gemm_phase(F.lds, F.wave, DM, LDX, LDX, S, E);
    }
    SEAM(7);

    if (IN(8)) REPS(8) {
        unsigned char* ws = KWS(); bf16* PROJ = (bf16*)(ws + WS_PROJ); bf16* MIX = (bf16*)(ws + WS_MIX); const unsigned* ctl = (const unsigned*)ws;
        const float* subln_w = KIN(12); const float* t5_bias = KIN(14);
        const int w = F.wave, mp = w >> 2, wq = w & 3;
        LAS float* tab = (LAS float*)(F.lds + EX_TAB);
        LAS float* wsl = (LAS float*)(F.lds + EX_WS) + w * 64;
        const int NU = 3072;
        for (int uix = 0; ; ++uix) {
            int q, h, qb;
            if (F.G == 256) {
                if (uix >= 12) break;
                const int xv = F.vcu >> 5, lw = F.vcu & 31;
                if (uix < 8) { const int pair = xv * 4 + (uix >> 1); q = pair >> 4; h = pair & 15; qb = lw * 2 + (uix & 1); }
                else { const int pair = xv * 8 + (uix - 8) * 2 + (lw >> 4); q = 2 + (pair >> 4); h = pair & 15; qb = lw & 15; }
            } else {
                const int U = uix * F.G + F.vcu; if (U >= NU) break;
                if (U < 2048) { q = U >> 10; const int t = U & 1023; h = t >> 6; qb = t & 63; } else { const int t2 = U - 2048; q = 2 + (t2 >> 8); const int t = t2 & 255; h = t >> 4; qb = t & 15; }
            }
            const SeqInfo si = seq_info(q); const int NT = si.S >> 6;
            const int lane = lane_id_opaque(), tid = w * 64 + lane, r32 = lane & 31, hi = lane >> 5;
            __syncthreads();
            for (int e = tid; e < 257; e += 512) { const int rel = e - 128; const int n = rel < 0 ? -rel : rel; int bk = rel > 0 ? 16 : 0;
                if (n < 8) bk += n; else { int lg = 2 + (31 - __builtin_clz((unsigned)(n * n))); bk += lg > 15 ? 15 : lg; }
                tab[e] = t5_bias[bk * 16 + h] * LOG2E; }
            const int qpos0 = 128 * qb + 32 * wq;
            bf16x8 qr[8];
            { const bf16* Qw = PROJ + (size_t)(si.row0 + qpos0 + r32) * ODD_IN + h * 256 + mp * 128 + hi * 8;
#pragma unroll
              for (int d0 = 0; d0 < 8; ++d0) qr[d0] = *(const bf16x8*)(Qw + d0 * 16); }
            float m_reg = -1e30f, l_reg = 0.f; f32x16 o[8];
#pragma unroll
            for (int d = 0; d < 8; ++d) o[d] = (f32x16){0.f, 0.f, 0.f, 0.f, 0.f, 0.f, 0.f, 0.f, 0.f, 0.f, 0.f, 0.f, 0.f, 0.f, 0.f, 0.f};
            constexpr unsigned LDB = ODD_IN * 2;
            unsigned offA;
            if (w < 4) offA = (unsigned)(lane >> 4) * LDB + (unsigned)(((lane & 15) ^ ((lane >> 4) & 7)) << 4);
            else { const int t = (lane & 31) >> 2; offA = (unsigned)((t & 3) + 8 * (t >> 2)) * LDB + (unsigned)(32 * hi + 8 * (lane & 3)) * 2u; }
            const char* kvbase = (const char*)(PROJ + (size_t)si.row0 * ODD_IN + h * 256);
            const int NS = si.S >> 5;
            struct DmaHook { const char* kvbase; LAS unsigned char* ldsb; unsigned offA; int w, NS, step;
                __device__ __forceinline__ void operator()(int j_) const {
                    const int st_ = step < NS ? step : NS - 1; const char* tb_ = kvbase + (size_t)(st_ * 32) * (ODD_IN * 2); LAS unsigned char* dst_ = ldsb + (step & 3) * 32768 + w * 4096 + j_ * 1024;
                    if (w < 4) glds16(tb_ + (size_t)(4 * (w & 1)) * 4 * (ODD_IN * 2) + (4096 + (w >> 1) * 128) * 2 + (size_t)j_ * 4 * (ODD_IN * 2) + ((j_ & 1) ? (offA ^ 64u) : offA), dst_);
                    else glds16(tb_ + (size_t)(4 * ((w - 4) & 1) + 16 * ((w - 4) >> 1)) * (ODD_IN * 2) + 8192 * 2 + 128 * j_ + offA, dst_); } };
#define DA_DMA(step) do { const int st_ = (step) < NS ? (step) : NS - 1;      \
            const char* tb_ = kvbase + (size_t)(st_ * 32) * LDB; LAS unsigned char* dst_ = F.lds + ((step) & 3) * 32768 + w * 4096; \
            if (w < 4) { const char* t2_ = tb_ + (size_t)(4 * (w & 1)) * 4 * LDB + (4096 + (w >> 1) * 128) * 2; \
                _Pragma("unroll") for (int j_ = 0; j_ < 4; ++j_) glds16(t2_ + (size_t)j_ * 4 * LDB + ((j_ & 1) ? (offA ^ 64u) : offA), dst_ + j_ * 1024); } \
            else { const char* t2_ = tb_ + (size_t)(4 * ((w - 4) & 1) + 16 * ((w - 4) >> 1)) * LDB + 8192 * 2; \
                _Pragma("unroll") for (int j_ = 0; j_ < 4; ++j_) glds16(t2_ + 128 * j_ + offA, dst_ + j_ * 1024); } } while (0)
#ifndef ATT_PIPE
#define ATT_PIPE 0
#endif
            DA_DMA(0); DA_DMA(1);
#if ATT_PIPE
            DA_DMA(2);
#endif
            __syncthreads();
            const float bfarL = __builtin_bit_cast(float, __builtin_amdgcn_readfirstlane(__builtin_bit_cast(int, tab[0])));
            const float bfarR = __builtin_bit_cast(float, __builtin_amdgcn_readfirstlane(__builtin_bit_cast(int, tab[256])));
#define DA_QK(s_, P_) do { LDS_WAIT(); qkt_h(P_, F.lds + ((s_) & 3) * 32768 + mp * 8192, qr, r32, hi); } while (0)
#define DA_SM(s_, P_) do { \
                const int relmin = 32 * (s_) - (qpos0 + 31), relmax = 32 * (s_) + 31 - qpos0;     \
                SBAR(); \
                if (relmax <= -128 || relmin >= 128) { softmax_far_h(P_, relmax <= -128 ? bfarL : bfarR, m_reg, l_reg, alpha, pa0, pa1); } \
                else { const int relb = 32 * (s_) - (qpos0 + r32) + 128 + 4 * hi; \
                    _Pragma("unroll") for (int g4 = 0; g4 < 2; ++g4) { \
                        _Pragma("unroll") for (int r8 = 0; r8 < 8; ++r8) { const int rr = g4 * 8 + r8; int ix = relb + (rr & 3) + 8 * (rr >> 2); ix = ix < 0 ? 0 : (ix > 256 ? 256 : ix); P_[rr] = fmaf(P_[rr], ATT_C, tab[ix]); } \
                        SBAR(); } \
                    softmax_near_h(P_, m_reg, l_reg, alpha, pa0, pa1); } \
                SBAR(); \
                if (__any(alpha < 1.f)) { \
                    if (hi == 0) wsl[r32] = alpha; LDS_WAIT(); \
                    _Pragma("unroll") for (int g4 = 0; g4 < 4; ++g4) { \
                        _Pragma("unroll") for (int r4 = 0; r4 < 4; ++r4) { const int rr = g4 * 4 + r4; const float a = wsl[crow(rr, hi)]; \
                            _Pragma("unroll") for (int d = 0; d < 8; ++d) o[d][rr] *= a; } \
                        SBAR(); } } \
                SBAR(); } while (0)
#define DA_PV(s_) do { LDS_WAIT(); pv_half8<0>(o, (unsigned)(uintptr_t)(F.lds + ((s_) & 3) * 32768 + 16384) + v_rd_base(lane), pa0, pa1); } while (0)
#define DA_PVD(s_, dstep_) do { LDS_WAIT(); const DmaHook hk_{kvbase, F.lds, offA, w, NS, (dstep_)}; pv_half8<0>(o, (unsigned)(uintptr_t)(F.lds + ((s_) & 3) * 32768 + 16384) + v_rd_base(lane), pa0, pa1, hk_); } while (0)
#define DA_SYNC() do { asm volatile("s_waitcnt vmcnt(4)" ::: "memory"); __builtin_amdgcn_s_barrier(); asm volatile("" ::: "memory"); } while (0)
            float alpha; bf16x8 pa0, pa1;
#if ATT_PIPE
            f32x16 pA, pB;
            asm volatile("s_waitcnt vmcnt(8)" ::: "memory"); __builtin_amdgcn_s_barrier(); asm volatile("" ::: "memory");
            DA_QK(0, pA);
            for (int s_ = 0; s_ < NS; s_ += 2) {
                DA_SYNC();
                DA_QK(s_ + 1, pB); SBAR();
                DA_SM(s_, pA); DA_PVD(s_, s_ + 3);
                DA_SYNC();
                if (s_ + 2 < NS) { DA_QK(s_ + 2, pA); } SBAR();
                DA_SM(s_ + 1, pB); DA_PVD(s_ + 1, s_ + 4);
            }
#else
            if (ATT_SPRIO && mp == 1) __builtin_amdgcn_s_setprio(1);
#ifndef ATT_CUT
#define ATT_CUT 1
#endif
#if ATT_CUT
            if (mp == 0) {
                DA_SYNC(); DA_DMA(2);
                { f32x16 p; DA_QK(0, p); DA_SM(0, p); }
                for (int s_ = 1; s_ < NS; ++s_) {
                    DA_SYNC();
                    { f32x16 p; DA_QK(s_, p); SBAR(); DA_PVD(s_ - 1, s_ + 2); SBAR(); DA_SM(s_, p); }
                }
                DA_SYNC();
                DA_PV(NS - 1);
            } else {
                f32x16 p;
                DA_SYNC(); DA_DMA(2);
                DA_QK(0, p);
                for (int s_ = 1; s_ < NS; ++s_) {
                    DA_SYNC();
                    DA_SM(s_ - 1, p); DA_PVD(s_ - 1, s_ + 2); SBAR(); DA_QK(s_, p);
                }
                DA_SYNC();
                DA_SM(NS - 1, p); DA_PV(NS - 1);
            }
#else
            if (mp == 0) {
                for (int s_ = 0; s_ < NS; ++s_) {
                    DA_SYNC();
                    { f32x16 p; DA_QK(s_, p); DA_SM(s_, p); } DA_PVD(s_, s_ + 2);
                }
            } else {
                DA_SYNC(); DA_DMA(2);
                { f32x16 p; DA_QK(0, p); DA_SM(0, p); }
                for (int s_ = 1; s_ < NS; ++s_) {
                    DA_SYNC();
                    DA_PVD(s_ - 1, s_ + 2); SBAR(); { f32x16 p; DA_QK(s_, p); DA_SM(s_, p); }
                }
                DA_PV(NS - 1);
            }
#endif
            if (ATT_SPRIO) __builtin_amdgcn_s_setprio(0);
#endif
            VM_WAIT(); __syncthreads();
#undef DA_QK
#undef DA_SM
#undef DA_PV
#undef DA_PVD
#undef DA_SYNC
#undef DA_DMA
            if (hi == 0) wsl[32 + r32] = l_reg; LDS_WAIT();
            LAS float* xch = (LAS float*)(F.lds + wq * 32768);
            const float lsc = mp ? ((const float*)ctl)[CW_LAM] : 1.0f;
#pragma unroll
            for (int rr = 0; rr < 16; ++rr) { const float rl = __builtin_amdgcn_rcpf(wsl[32 + crow(rr, hi)]) * lsc;
#pragma unroll
                for (int d = 0; d < 8; ++d) o[d][rr] *= rl;
                if ((rr & 3) == 3) SBAR(); }
            if (mp == 1) {
#pragma unroll
                for (int d = 0; d < 8; ++d) {
#pragma unroll
                    for (int rr = 0; rr < 16; ++rr) xch[(d * 16 + rr) * 64 + lane] = o[d][rr];
                    SBAR(); }
            }
            __syncthreads();
            if (mp == 0) {
#pragma unroll
                for (int d = 0; d < 8; ++d) {
#pragma unroll
                    for (int rr = 0; rr < 16; ++rr) o[d][rr] -= xch[(d * 16 + rr) * 64 + lane];
                    SBAR(); }
                float gw_[8];
#pragma unroll
                for (int d = 0; d < 8; ++d) gw_[d] = subln_w[d * 32 + r32] * (1.0f - LAM_INIT);
                LAS unsigned short* img = (LAS unsigned short*)(F.lds + wq * 32768);
#pragma unroll
                for (int rr = 0; rr < 16; ++rr) { float s = 0.f;
#pragma unroll
                    for (int d = 0; d < 8; ++d) s += o[d][rr] * o[d][rr];
                    s = sum_rows16(sum_row16(s));
                    const float rs_ = __builtin_amdgcn_rsqf(s * (1.0f / 256.0f) + SUBLN_EPS);
#pragma unroll
                    for (int d = 0; d < 8; ++d) img[crow(rr, hi) * 256 + d * 32 + r32] = (unsigned short)(cvt_pk_bf16(o[d][rr] * rs_ * gw_[d], 0.f) & 0xffffu);
                    if ((rr & 3) == 3) SBAR(); }
                LDS_WAIT();
                bf16* Ob = MIX + (size_t)(si.row0 + qpos0) * LDX + h * 256;
#pragma unroll
                for (int i = 0; i < 16; ++i) { const int row = 2 * i + hi; const u32x4 v = *(const LAS u32x4*)(img + row * 256 + r32 * 8);
                    *(u32x4*)(Ob + (size_t)row * LDX + r32 * 8) = v; }
            }
        }
        __syncthreads();
    }
    SEAM(8);

    if (IN(9)) REPS(9) {
        unsigned char* ws = KWS(); float* ssq = (float*)(ws + WS_CTL + CTL_SSQ); bf16* XB = (bf16*)(ws + WS_XB); bf16* MIX = (bf16*)(ws + WS_MIX); bf16* HMID = (bf16*)(ws + WS_PROJ); bf16* PROJ = HMID;
        float* X = KOUT(); const float* x_prompt = KIN(0); const float* x_sample = KIN(1);
        bf16* WOE = (bf16*)(ws + WS_WOE); bf16* WIO = (bf16*)(ws + WS_WIO); bf16* WOO = (bf16*)(ws + WS_WOO);
        bf16* WGU0 = (bf16*)(ws + WS_WGU0); bf16* WGU1 = (bf16*)(ws + WS_WGU1); bf16* WD0 = (bf16*)(ws + WS_WD0); bf16* WD1 = (bf16*)(ws + WS_WD1);
        (void)ssq; (void)XB; (void)MIX; (void)HMID; (void)PROJ; (void)X; (void)x_prompt; (void)x_sample; (void)WOE; (void)WIO; (void)WOO; (void)WGU0; (void)WGU1; (void)WD0; (void)WD1;
        gm::GridOrder S; S.init(NTOK, DM, F.G, (int)blockIdx.x, MIX, (size_t)LDX * 2, WOO, (size_t)LDX * 2, X, DM, 4); S.sh48 = (ORD48 & 2) != 0;
        gm::EpiResid E{x_prompt, x_sample, 0, X, XB, ssq + 3 * NTOK, 1};
        gm::gemm_phase(F.lds, F.wave, DM, LDX, LDX, S, E);
    }
    SEAM(9);
    if (IN(10)) REPS(10) {
        unsigned char* ws = KWS(); float* ssq = (float*)(ws + WS_CTL + CTL_SSQ); bf16* XB = (bf16*)(ws + WS_XB); bf16* MIX = (bf16*)(ws + WS_MIX); bf16* HMID = (bf16*)(ws + WS_PROJ); bf16* PROJ = HMID;
        float* X = KOUT(); const float* x_prompt = KIN(0); const float* x_sample = KIN(1);
        bf16* WOE = (bf16*)(ws + WS_WOE); bf16* WIO = (bf16*)(ws + WS_WIO); bf16* WOO = (bf16*)(ws + WS_WOO);
        bf16* WGU0 = (bf16*)(ws + WS_WGU0); bf16* WGU1 = (bf16*)(ws + WS_WGU1); bf16* WD0 = (bf16*)(ws + WS_WD0); bf16* WD1 = (bf16*)(ws + WS_WD1);
        (void)ssq; (void)XB; (void)MIX; (void)HMID; (void)PROJ; (void)X; (void)x_prompt; (void)x_sample; (void)WOE; (void)WIO; (void)WOO; (void)WGU0; (void)WGU1; (void)WD0; (void)WD1;
        gm::GridOrder S; S.init(NTOK, 2 * FF, F.G, (int)blockIdx.x, XB, (size_t)LDX * 2, WGU1, (size_t)LDX * 2, HMID, FF, 2);
        gm::EpiSwiglu E{ssq + 3 * NTOK, HMID};
        gm::gemm_phase(F.lds, F.wave, DM, LDX, LDX, S, E);
    }
    SEAM(10);
    if (IN(11)) REPS(11) {
        unsigned char* ws = KWS(); float* ssq = (float*)(ws + WS_CTL + CTL_SSQ); bf16* XB = (bf16*)(ws + WS_XB); bf16* MIX = (bf16*)(ws + WS_MIX); bf16* HMID = (bf16*)(ws + WS_PROJ); bf16* PROJ = HMID;
        float* X = KOUT(); const float* x_prompt = KIN(0); const float* x_sample = KIN(1);
        bf16* WOE = (bf16*)(ws + WS_WOE); bf16* WIO = (bf16*)(ws + WS_WIO); bf16* WOO = (bf16*)(ws + WS_WOO);
        bf16* WGU0 = (bf16*)(ws + WS_WGU0); bf16* WGU1 = (bf16*)(ws + WS_WGU1); bf16* WD0 = (bf16*)(ws + WS_WD0); bf16* WD1 = (bf16*)(ws + WS_WD1);
        (void)ssq; (void)XB; (void)MIX; (void)HMID; (void)PROJ; (void)X; (void)x_prompt; (void)x_sample; (void)WOE; (void)WIO; (void)WOO; (void)WGU0; (void)WGU1; (void)WD0; (void)WD1;
        gm::GridOrder S; S.init(NTOK, DM, F.G, (int)blockIdx.x, HMID, (size_t)FF * 2, WD1, (size_t)FF * 2, X, DM, 4); S.sh48 = (ORD48 & 1) != 0;
        gm::EpiResid E{x_prompt, x_sample, 0, X, XB, ssq + 4 * NTOK, 0};
        gm::gemm_phase(F.lds, F.wave, FF, FF, FF, S, E);
    }
    SEAM(11);
    if (IN(12)) REPS(12) {
        float* X = KOUT(); const float* norm_final = KIN(18); float* ssq = (float*)(KWS() + WS_CTL + CTL_SSQ);
        const int gw = F.vcu * 8 + F.wave, NGW = F.G * 8, fl = lane_id_opaque();
        for (int m = gw; m < NTOK; m += NGW) {
            const float rs = __builtin_amdgcn_rsqf(ssq[4 * NTOK + m] * (1.0f / DM) + RMS_EPS);
            float* xr = X + (size_t)m * DM;
#pragma unroll 4
            for (int j = 0; j < 16; ++j) { const int cidx = j * 256 + fl * 4; const f32x4 v = *(const f32x4*)(xr + cidx); const f32x4 g = *(const f32x4*)(norm_final + cidx);
                *(f32x4*)(xr + cidx) = v * rs * g; }
        }
    }
#undef IN
#undef SEAM
}

extern "C" void kernel_launch(void* const* d_in, const int* in_sizes, int n_in, void* d_out, int out_size, void* d_ws, size_t ws_size, hipStream_t stream) {
    static int grid = 0;
    if (grid == 0) {
        if (n_in != 19 || out_size != NTOK * DM || ws_size < WS_END) { fprintf(stderr, "kernel_launch: unexpected shapes: n_in %d out %d ws %zu (need %zu)\n", n_in, out_size, ws_size, (size_t)WS_END); grid = -1; return; }
        int dev = 0, cus = 0, per_cu = 0;
        if (hipGetDevice(&dev) != hipSuccess || hipDeviceGetAttribute(&cus, hipDeviceAttributeMultiprocessorCount, dev) != hipSuccess) { grid = -1; return; }
        if (hipFuncSetAttribute((const void*)mega_fwd, hipFuncAttributeMaxDynamicSharedMemorySize, LDS_BYTES) != hipSuccess) { fprintf(stderr, "kernel_launch: hipFuncSetAttribute failed\n"); grid = -1; return; }
        if (hipOccupancyMaxActiveBlocksPerMultiprocessor(&per_cu, (const void*)mega_fwd, 512, LDS_BYTES) != hipSuccess || per_cu < 1)
            fprintf(stderr, "kernel_launch: occupancy query reports %d\n", per_cu);
        (void)hipGetLastError();
        grid = cus;
    }
    if (grid < 0) return;
    (void)hipMemsetAsync((char*)d_ws + WS_CTL, 0, CTL_ZERO_BYTES, stream);
    Args a{};
    for (int i = 0; i < 19; ++i) a.in[i] = (const float*)d_in[i];
    a.out = (float*)d_out; a.ws = (unsigned char*)d_ws;
    hipLaunchKernelGGL(mega_fwd, dim3(grid), dim3(512), LDS_BYTES, stream, a);
    const hipError_t le = hipPeekAtLastError();
    if (le != hipSuccess) fprintf(stderr, "kernel_launch: launch failed: %s\n", hipGetErrorName(le));
}
```
